# Optimizing an MI355X kernel written in HIP

```python
import jax, jax.numpy as jnp
from jax import lax
import numpy as np

D_MODEL = 2048
BATCH = 4
SEQ = 2048
DEPTH = 4

D_MIX = D_MODEL
HEAD_DIM = 128
ATTN_WIDTH = D_MIX // 2
N_ATTN_HEADS = ATTN_WIDTH // HEAD_DIM
GMLP_WIDTH = D_MIX // 4
N_GMLP_HEADS = 4
GMLP_HEAD_DIM = GMLP_WIDTH // N_GMLP_HEADS
POOL_WIDTH = D_MIX - ATTN_WIDTH - GMLP_WIDTH
N_POOL_GROUPS = 4
POOL_GROUP_DIM = POOL_WIDTH // N_POOL_GROUPS
POOL_WINDOWS = (2, 4, 8, 16)
CHUNK = 128
Q_BLOCK = 128
D_PLE = 256
D_FF = -(-8 * D_MODEL // (3 * 256)) * 256
EPS = 1e-6

PROJ_SIZES = (ATTN_WIDTH, ATTN_WIDTH, ATTN_WIDTH, N_ATTN_HEADS, GMLP_WIDTH, GMLP_WIDTH, POOL_WIDTH)
D_PROJ = 3 * ATTN_WIDTH + N_ATTN_HEADS + 2 * GMLP_WIDTH + POOL_WIDTH
SPLIT_POINTS = (
    ATTN_WIDTH,
    2 * ATTN_WIDTH,
    3 * ATTN_WIDTH,
    3 * ATTN_WIDTH + N_ATTN_HEADS,
    3 * ATTN_WIDTH + N_ATTN_HEADS + GMLP_WIDTH,
    3 * ATTN_WIDTH + N_ATTN_HEADS + 2 * GMLP_WIDTH,
)

kernel_name = "hybrid_parallel_fox_gmlp_pool_block"


def rms_norm(x, gain):
    xf = x.astype(jnp.float32)
    y = xf * lax.rsqrt(jnp.mean(xf * xf, axis=-1, keepdims=True) + EPS)
    return (y * gain.astype(jnp.float32)).astype(x.dtype)


def fox_attention(q, k, v, log_f):
    B, S, H, Dh = q.shape
    nb = S // Q_BLOCK
    c = jnp.cumsum(log_f, axis=1)
    q_blocks = q.reshape(B, nb, Q_BLOCK, H, Dh).transpose(1, 0, 3, 2, 4)
    cq_blocks = c.reshape(B, nb, Q_BLOCK, H).transpose(1, 0, 3, 2)
    pos_blocks = jnp.arange(S, dtype=jnp.int32).reshape(nb, Q_BLOCK)
    kh = k.transpose(0, 2, 1, 3)
    vh = v.transpose(0, 2, 1, 3)
    ck = c.transpose(0, 2, 1)
    kpos = jnp.arange(S, dtype=jnp.int32)
    scale = Dh ** -0.5

    def one_block(args):
        q_blk, cq_blk, qpos = args
        s = jnp.einsum('bhqd,bhkd->bhqk', q_blk, kh, preferred_element_type=jnp.float32) * scale
        s = s + (cq_blk[..., :, None] - ck[:, :, None, :])
        s = jnp.where(qpos[:, None] >= kpos[None, :], s, -jnp.inf)
        w = jax.nn.softmax(s, axis=-1)
        return jnp.einsum('bhqk,bhkd->bhqd', w.astype(vh.dtype), vh)

    out = lax.map(one_block, (q_blocks, cq_blocks, pos_blocks))
    return out.transpose(1, 0, 3, 2, 4).reshape(B, S, H * Dh)


def gmlp_mixer(u, v, v_gain, w_s, b_s):
    B, S, _ = u.shape
    nc = S // CHUNK
    u = jax.nn.gelu(u)
    v = jax.nn.gelu(v).reshape(B, S, N_GMLP_HEADS, GMLP_HEAD_DIM)
    v = rms_norm(v, v_gain).reshape(B, nc, CHUNK, N_GMLP_HEADS, GMLP_HEAD_DIM)
    w = w_s * jnp.tril(jnp.ones((CHUNK, CHUNK), w_s.dtype))[None]
    mixed = jnp.einsum('gts,bnsgc->bntgc', w, v) + b_s.T[None, None, :, :, None]
    return u * mixed.reshape(B, S, GMLP_WIDTH)


def pool_mixer(xp, w_pool, scale):
    B, S, _ = xp.shape
    x4 = xp.reshape(B, S, N_POOL_GROUPS, POOL_GROUP_DIM)
    cs = jnp.cumsum(x4.astype(jnp.float32), axis=1)
    cpad = jnp.concatenate([jnp.zeros((B, 1, N_POOL_GROUPS, POOL_GROUP_DIM), jnp.float32), cs], axis=1)
    t = jnp.arange(S, dtype=jnp.int32)[:, None]
    win = jnp.asarray(POOL_WINDOWS, dtype=jnp.int32)[None, :]
    lo = jnp.maximum(t + 1 - win, 0)
    cnt = (t + 1 - lo).astype(jnp.float32)
    g_idx = jnp.arange(N_POOL_GROUPS, dtype=jnp.int32)[None, :]
    window_sum = cs - cpad[:, lo, g_idx, :]
    d = (window_sum / cnt[None, :, :, None] - x4.astype(jnp.float32)).astype(xp.dtype)
    y = jnp.einsum('bsgc,gcd->bsgd', d, w_pool)
    return y.reshape(B, S, POOL_WIDTH) * scale


def setup_inputs(seed: int = 0) -> dict:
    key = jax.random.key(seed)
    ks = jax.random.split(key, 20)
    f32 = jnp.float32

    def nrm(k, shape, s):
        return jax.random.normal(k, shape, f32) * s

    def gain(k, shape):
        return 1.0 + 0.05 * jax.random.normal(k, shape, f32)

    return {
        "x": jax.random.normal(ks[0], (BATCH, SEQ, D_MODEL), f32),
        "p": jax.random.normal(ks[1], (DEPTH, BATCH, SEQ, D_PLE), f32),
        "norm_mix": gain(ks[2], (DEPTH, D_MODEL)),
        "w_in": nrm(ks[3], (DEPTH, D_MODEL, D_PROJ), D_MODEL ** -0.5),
        "q_norm": gain(ks[4], (DEPTH, HEAD_DIM)),
        "k_norm": gain(ks[5], (DEPTH, HEAD_DIM)),
        "forget_bias": 3.0 + 0.5 * jax.random.normal(ks[6], (DEPTH, N_ATTN_HEADS), f32),
        "gmlp_v_norm": gain(ks[7], (DEPTH, N_GMLP_HEADS, GMLP_HEAD_DIM)),
        "gmlp_w_s": nrm(ks[8], (DEPTH, N_GMLP_HEADS, CHUNK, CHUNK), CHUNK ** -0.5),
        "gmlp_b_s": 1.0 + 0.1 * jax.random.normal(ks[9], (DEPTH, N_GMLP_HEADS, CHUNK), f32),
        "pool_w": nrm(ks[10], (DEPTH, N_POOL_GROUPS, POOL_GROUP_DIM, POOL_GROUP_DIM), POOL_GROUP_DIM ** -0.5),
        "pool_scale": 1.0 + 0.1 * jax.random.normal(ks[11], (DEPTH, POOL_WIDTH), f32),
        "w_out": nrm(ks[12], (DEPTH, D_MIX, D_MODEL), D_MIX ** -0.5),
        "norm_ffn": gain(ks[13], (DEPTH, D_MODEL)),
        "w_ffn_gate": nrm(ks[14], (DEPTH, D_MODEL, D_FF), D_MODEL ** -0.5),
        "w_ffn_up": nrm(ks[15], (DEPTH, D_MODEL, D_FF), D_MODEL ** -0.5),
        "w_ffn_down": nrm(ks[16], (DEPTH, D_FF, D_MODEL), D_FF ** -0.5),
        "norm_ple": gain(ks[17], (DEPTH, D_MODEL)),
        "w_ple_gate": nrm(ks[18], (DEPTH, D_MODEL, D_MODEL), D_MODEL ** -0.5),
        "w_ple_proj": nrm(ks[19], (DEPTH, D_PLE, D_MODEL), D_PLE ** -0.5),
    }


def reference(x, p, norm_mix, w_in, q_norm, k_norm, forget_bias, gmlp_v_norm, gmlp_w_s, gmlp_b_s,
              pool_w, pool_scale, w_out, norm_ffn, w_ffn_gate, w_ffn_up, w_ffn_down,
              norm_ple, w_ple_gate, w_ple_proj):
    B, S, _ = x.shape
    h = x
    for i in range(DEPTH):
        xn = rms_norm(h, norm_mix[i])
        proj = xn @ w_in[i]
        q, k, v, f_logit, gu, gv, xp = jnp.split(proj, SPLIT_POINTS, axis=-1)
        q = rms_norm(q.reshape(B, S, N_ATTN_HEADS, HEAD_DIM), q_norm[i])
        k = rms_norm(k.reshape(B, S, N_ATTN_HEADS, HEAD_DIM), k_norm[i])
        v = v.reshape(B, S, N_ATTN_HEADS, HEAD_DIM)
        log_f = jax.nn.log_sigmoid((f_logit + forget_bias[i]).astype(jnp.float32))
        y_attn = fox_attention(q, k, v, log_f)
        y_gmlp = gmlp_mixer(gu, gv, gmlp_v_norm[i], gmlp_w_s[i], gmlp_b_s[i])
        y_pool = pool_mixer(xp, pool_w[i], pool_scale[i])
        mix = jnp.concatenate([y_attn, y_gmlp, y_pool], axis=-1)
        h = h + mix @ w_out[i]
        xn = rms_norm(h, norm_ffn[i])
        h = h + (jax.nn.silu(xn @ w_ffn_gate[i]) * (xn @ w_ffn_up[i])) @ w_ffn_down[i]
        gate = jax.nn.sigmoid(rms_norm(h, norm_ple[i]) @ w_ple_gate[i])
        h = h + (p[i] @ w_ple_proj[i]) * gate
    return h
```

```cpp
#include <hip/hip_runtime.h>
#include <hip/hip_cooperative_groups.h>
#include <cstdio>
#include <cstdint>
namespace cg = cooperative_groups;
namespace pg8 {
#define PG8_LAS __attribute__((address_space(3)))
typedef unsigned short bf16_t;
typedef short bf16x8 __attribute__((ext_vector_type(8)));
typedef float f32x4 __attribute__((ext_vector_type(4)));
typedef unsigned u32x4 __attribute__((ext_vector_type(4)));
constexpr int BM = 256, BK = 64, HALF = 128, HTB = HALF * BK * 2  , STAGE_BYTES = 8 * HTB, NXCD = 8, WGM = 8;

__host__ __device__ __forceinline__ int lds_byte(int r, int c) { const int st = (r >> 4) * 2 + (c >> 5), rr = r & 15, cc = c & 31, ob = rr * 64 + cc * 2; return st * 1024 + (ob ^ (((ob >> 9) & 1) << 5)); }
__host__ __device__ __forceinline__ void stage_rc(int b, int& R, int& C) { const int st = b / 1024, sb = b % 1024, swz = sb ^ (((sb >> 9) & 1) << 5); R = (st >> 1) * 16 + swz / 64; C = (st & 1) * 32 + (swz % 64) / 2; }
__host__ __device__ __forceinline__ int perm32(int rho) { const int n = rho >> 4, i = rho & 15; return 8 * (i >> 2) + 4 * n + (i & 3); }

struct Unit { int pm, pn; };
struct Gemm { const bf16_t* A; const bf16_t* Bt; int M, N, K; };

struct StaticOrder {
    int nM, nN, nwg, G, c;
    __host__ __device__ void init(int M, int N, int G_, int c_) { nM = M / BM; nN = N / BM; nwg = nM * nN; G = G_; c = c_; }
    __host__ __device__ bool next(int i, Unit& u) const {
        const long L = (long)i * G + c; if (L >= nwg) return false;
        int wgid = (int)L; { const int q = nwg / NXCD, r = nwg % NXCD, xcd = wgid % NXCD, off = wgid / NXCD; wgid = (xcd < r ? xcd * (q + 1) : r * (q + 1) + (xcd - r) * q) + off; }
        const int nig = WGM * nN, gid = wgid / nig, fm = gid * WGM, gsz = (nM - fm) < WGM ? (nM - fm) : WGM;
        u.pm = fm + ((wgid % nig) % gsz); u.pn = (wgid % nig) / gsz; return true;
    }
    __device__ __forceinline__ void a_ready(const Unit&) const {}
    __device__ __forceinline__ void done(const Unit&) const {}
};

__device__ __forceinline__ unsigned cvt_pk_bf16(float lo, float hi) { unsigned r; asm volatile("v_cvt_pk_bf16_f32 %0, %1, %2" : "=v"(r) : "v"(lo), "v"(hi)); return r; }
typedef float f32x2 __attribute__((ext_vector_type(2)));
__device__ __forceinline__ f32x2 gelu_pk(f32x2 v) {
    const f32x2 av = __builtin_elementwise_abs(v), d = av * 0.2316418882f + 1.0f;
    f32x2 t; t.x = __builtin_amdgcn_rcpf(d.x); t.y = __builtin_amdgcn_rcpf(d.y);
    f32x2 q = t * 0.5307027145f + (-0.7265760135f); q = q * t + 0.7107068705f; q = q * t + (-0.142248368f); q = q * t + 0.127414796f; q = q * t;
    const f32x2 s = (v * v) * (-0.72134752044f);
    f32x2 e; e.x = __builtin_amdgcn_exp2f(s.x); e.y = __builtin_amdgcn_exp2f(s.y);
    const f32x2 m = v * (q * e), r = v - m;
    f32x2 o; o.x = v.x < 0.f ? m.x : r.x; o.y = v.y < 0.f ? m.y : r.y; return o;
}

template <int ACT  > struct EpiBf16 {
    static constexpr bool PERM = true, AFTER_DRAIN = false; static_assert(ACT == 0 || ACT == 1, "EpiBf16: ACT is 0 (none) or 1 (gelu_pk)");
    bf16_t* O; int ldc; const float* bias; int split_cols; size_t split_stride; float scale0;
    __device__ __forceinline__ void operator()(const f32x4 (&acc)[2][2][4][2], const Unit& u, int wr, int wc, int fr, int fq) const {
        const int row0 = u.pm * BM + wr * 64 + fr; int colt = u.pn * BM; bf16_t* base = O;
        float sc = 1.f; if (split_cols) { const int t = colt / split_cols; base += (size_t)t * split_stride; colt -= t * split_cols; if (t == 0) sc = scale0; }
        const int col0 = colt + wc * 32 + 8 * fq, bcol0 = u.pn * BM + wc * 32 + 8 * fq;
        f32x4 bv[2][2];
#pragma unroll
        for (int bj = 0; bj < 2; ++bj)
#pragma unroll
            for (int n = 0; n < 2; ++n) bv[bj][n] = bias ? *(const f32x4*)(bias + bcol0 + bj * HALF + 4 * n) : (f32x4){0.f, 0.f, 0.f, 0.f};
#pragma unroll
        for (int ai = 0; ai < 2; ++ai)
#pragma unroll
            for (int m = 0; m < 4; ++m) { bf16_t* rowp = base + (size_t)(row0 + ai * HALF + m * 16) * ldc + col0;
#pragma unroll
                for (int bj = 0; bj < 2; ++bj) { f32x4 v0 = acc[ai][bj][m][0] + bv[bj][0], v1 = acc[ai][bj][m][1] + bv[bj][1];
                    if (ACT == 1) { f32x2 a = gelu_pk((f32x2){v0[0], v0[1]}), b = gelu_pk((f32x2){v0[2], v0[3]}), c = gelu_pk((f32x2){v1[0], v1[1]}), d = gelu_pk((f32x2){v1[2], v1[3]});
                        v0 = (f32x4){a.x, a.y, b.x, b.y}; v1 = (f32x4){c.x, c.y, d.x, d.y}; }
                    v0 = v0 * sc; v1 = v1 * sc; u32x4 w; w.x = cvt_pk_bf16(v0[0], v0[1]); w.y = cvt_pk_bf16(v0[2], v0[3]); w.z = cvt_pk_bf16(v1[0], v1[1]); w.w = cvt_pk_bf16(v1[2], v1[3]);
                    *(u32x4*)(rowp + bj * HALF) = w; } }
    }
};
typedef unsigned u32x2 __attribute__((ext_vector_type(2)));
__device__ __forceinline__ float bf_lo(unsigned w) { return __uint_as_float(w << 16); }
__device__ __forceinline__ float bf_hi(unsigned w) { return __uint_as_float(w & 0xffff0000u); }
__device__ __forceinline__ float sigmoidf_(float x) { return 1.0f / (1.0f + __expf(-x)); }
struct EpiRes {
    static constexpr bool PERM = false, AFTER_DRAIN = false;
    const float* base; float* out; int ldc;
    __device__ __forceinline__ void operator()(const f32x4 (&acc)[2][2][4][2], const Unit& u, int wr, int wc, int fr, int fq) const {
        const int col0 = u.pn * BM + wc * 32 + 4 * fq;
#pragma unroll
        for (int ai = 0; ai < 2; ++ai)
#pragma unroll
            for (int m = 0; m < 4; ++m) { const size_t off = (size_t)(u.pm * BM + ai * HALF + wr * 64 + m * 16 + fr) * ldc + col0;
#pragma unroll
                for (int bj = 0; bj < 2; ++bj)
#pragma unroll
                    for (int n = 0; n < 2; ++n) { const f32x4 bs = *(const f32x4*)(base + off + bj * HALF + n * 16); *(f32x4*)(out + off + bj * HALF + n * 16) = bs + acc[ai][bj][m][n]; }
                asm volatile("" ::: "memory"); }
    }
};
struct EpiPle {
    static constexpr bool PERM = false, AFTER_DRAIN = false;
    const float* base; float* out; const bf16_t* pp; int ldc;
    __device__ __forceinline__ void operator()(const f32x4 (&acc)[2][2][4][2], const Unit& u, int wr, int wc, int fr, int fq) const {
        const int col0 = u.pn * BM + wc * 32 + 4 * fq;
#pragma unroll
        for (int ai = 0; ai < 2; ++ai)
#pragma unroll
            for (int m = 0; m < 4; ++m) { const size_t off = (size_t)(u.pm * BM + ai * HALF + wr * 64 + m * 16 + fr) * ldc + col0;
#pragma unroll
                for (int bj = 0; bj < 2; ++bj)
#pragma unroll
                    for (int n = 0; n < 2; ++n) { const f32x4 bs = *(const f32x4*)(base + off + bj * HALF + n * 16); const u32x2 pw = *(const u32x2*)(pp + off + bj * HALF + n * 16);
                        const f32x4 a = acc[ai][bj][m][n]; f32x4 o;
                        o[0] = bs[0] + bf_lo(pw.x) * sigmoidf_(a[0]); o[1] = bs[1] + bf_hi(pw.x) * sigmoidf_(a[1]);
                        o[2] = bs[2] + bf_lo(pw.y) * sigmoidf_(a[2]); o[3] = bs[3] + bf_hi(pw.y) * sigmoidf_(a[3]);
                        *(f32x4*)(out + off + bj * HALF + n * 16) = o; }
                asm volatile("" ::: "memory"); }
    }
};
struct EpiSwiglu {
    static constexpr bool PERM = true, AFTER_DRAIN = false;
    bf16_t* O; int ldc;
    __device__ __forceinline__ void operator()(const f32x4 (&acc)[2][2][4][2], const Unit& u, int wr, int wc, int fr, int fq) const {
        const int col0 = u.pn * HALF + wc * 32 + 8 * fq;
#pragma unroll
        for (int ai = 0; ai < 2; ++ai)
#pragma unroll
            for (int m = 0; m < 4; ++m) { bf16_t* rowp = O + (size_t)(u.pm * BM + ai * HALF + wr * 64 + m * 16 + fr) * ldc + col0;
                float r[8];
#pragma unroll
                for (int n = 0; n < 2; ++n)
#pragma unroll
                    for (int j = 0; j < 4; ++j) { const float g = acc[ai][0][m][n][j], up = acc[ai][1][m][n][j]; r[n * 4 + j] = g * sigmoidf_(g) * up; }
                u32x4 w; w.x = cvt_pk_bf16(r[0], r[1]); w.y = cvt_pk_bf16(r[2], r[3]); w.z = cvt_pk_bf16(r[4], r[5]); w.w = cvt_pk_bf16(r[6], r[7]);
                *(u32x4*)rowp = w; asm volatile("" ::: "memory"); }
    }
};
template <class Epi, class Sched, bool ALIGN_EPI = false, bool SP2 = false>
__device__ __forceinline__ void gemm_phase(PG8_LAS unsigned char* lds, const Gemm g, const Sched& S, const Epi& E) {
    int tid_ = threadIdx.x; asm volatile("" : "+v"(tid_));
    const int tid = tid_, wid = __builtin_amdgcn_readfirstlane(tid >> 6), lane = tid & 63, wr = wid >> 2, wc = wid & 3, fr = lane & 15, fq = lane >> 4;
    const int K = g.K, nt = K / BK;
    unsigned voffA[2], voffB[2];
#pragma unroll
    for (int i = 0; i < 2; ++i) { int R, C; stage_rc(tid * 16 + i * 8192, R, C); const int Rb = Epi::PERM ? ((R & ~31) + perm32(R & 31)) : R;
        voffA[i] = (unsigned)(R * K + C) * 2u; voffB[i] = (unsigned)(Rb * K + C) * 2u; }
    const size_t kstep = (size_t)(BK * 2);
    const size_t hstep = (size_t)HALF * K * 2;
    const size_t tstep = 2 * hstep;
    const unsigned ldsw = (unsigned)wid * 1024u;
    const int aoff = lds_byte(wr * 64 + fr, fq * 8), boff = lds_byte(wc * 32 + fr, fq * 8);
#define PG8_SA(b, h) (((b) * 2 + (h)) * HTB)
#define PG8_SB(b, h) ((4 + (b) * 2 + (h)) * HTB)
#define PG8_STAGE(bufoff, gbase, voff) do { _Pragma("unroll") for (int _i = 0; _i < 2; ++_i) \
        __builtin_amdgcn_global_load_lds((const unsigned*)((const char*)(gbase) + (voff)[_i]), (PG8_LAS unsigned*)(lds + (bufoff) + ldsw + _i * 8192), 16, 0, 0); } while (0)
#define PG8_LDA(dst, b, h) do { _Pragma("unroll") for (int m = 0; m < 4; ++m) _Pragma("unroll") for (int k = 0; k < 2; ++k) dst[m][k] = *(const PG8_LAS bf16x8*)(lds + PG8_SA(b, h) + aoff + m * 2048 + k * 1024); } while (0)
#define PG8_LDB(dst, b, h) do { _Pragma("unroll") for (int n = 0; n < 2; ++n) _Pragma("unroll") for (int k = 0; k < 2; ++k) dst[n][k] = *(const PG8_LAS bf16x8*)(lds + PG8_SB(b, h) + boff + n * 2048 + k * 1024); } while (0)
#define PG8_MMA(ai, bj, At, Bt) do { __builtin_amdgcn_s_setprio(1); _Pragma("unroll") for (int m = 0; m < 4; ++m) _Pragma("unroll") for (int n = 0; n < 2; ++n) _Pragma("unroll") for (int k = 0; k < 2; ++k) \
        acc[ai][bj][m][n] = __builtin_amdgcn_mfma_f32_16x16x32_bf16(Bt[n][k], At[m][k], acc[ai][bj][m][n], 0, 0, 0); __builtin_amdgcn_s_setprio(0); } while (0)
#define PG8_WAIT_V(n) asm volatile("s_waitcnt vmcnt(" #n ")" ::: "memory")
#define PG8_WAIT_L(n) asm volatile("s_waitcnt lgkmcnt(" #n ")" ::: "memory")
#define PG8_BAR __builtin_amdgcn_s_barrier()
#define PG8_SCHED __builtin_amdgcn_sched_barrier(0)
    Unit cur, nxt; int ui = 0;
    if (!S.next(0, cur)) return;
    f32x4 acc[2][2][4][2];
#pragma unroll
    for (int a = 0; a < 2; ++a)
#pragma unroll
        for (int b = 0; b < 2; ++b)
#pragma unroll
            for (int m = 0; m < 4; ++m)
#pragma unroll
                for (int n = 0; n < 2; ++n) acc[a][b][m][n] = (f32x4){0.f, 0.f, 0.f, 0.f};
    bf16x8 At[4][2], B0[2][2], B1[2][2];
    const char* cA = (const char*)g.A + (size_t)cur.pm * tstep; const char* cB = (const char*)g.Bt + (size_t)cur.pn * tstep;
    S.a_ready(cur);
    if constexpr (SP2) {
        PG8_STAGE(PG8_SB(0, 0), cB, voffB); PG8_STAGE(PG8_SB(0, 1), cB + hstep, voffB); PG8_STAGE(PG8_SA(0, 0), cA, voffA); PG8_STAGE(PG8_SA(0, 1), cA + hstep, voffA);
        if (wr == 1) PG8_BAR;
        PG8_WAIT_V(2); PG8_BAR;
        PG8_STAGE(PG8_SB(1, 0), cB + kstep, voffB); PG8_STAGE(PG8_SA(1, 0), cA + kstep, voffA); PG8_STAGE(PG8_SB(1, 1), cB + hstep + kstep, voffB);
        PG8_WAIT_V(6); PG8_BAR;
    } else {
        PG8_STAGE(PG8_SB(0, 0), cB, voffB); PG8_STAGE(PG8_SA(0, 0), cA, voffA); PG8_STAGE(PG8_SB(0, 1), cB + hstep, voffB); PG8_STAGE(PG8_SA(0, 1), cA + hstep, voffA);
        if (wr == 1) PG8_BAR;
        PG8_WAIT_V(4); PG8_BAR;
        PG8_STAGE(PG8_SB(1, 0), cB + kstep, voffB); PG8_STAGE(PG8_SA(1, 0), cA + kstep, voffA); PG8_STAGE(PG8_SB(1, 1), cB + hstep + kstep, voffB);
        PG8_WAIT_V(6); PG8_BAR;
    }
    for (;;) {
        const bool has_next = S.next(ui + 1, nxt);
        const char* nA = has_next ? (const char*)g.A + (size_t)nxt.pm * tstep : cA; const char* nB = has_next ? (const char*)g.Bt + (size_t)nxt.pn * tstep : cB;
        for (int t = 0; t < nt; t += 2) {
            const bool last = (t == nt - 2);
            const char* a1 = cA + (size_t)(t + 1) * kstep;
            const char* a2 = last ? nA : cA + (size_t)(t + 2) * kstep; const char* b2 = last ? nB : cB + (size_t)(t + 2) * kstep;
            const char* a3 = a2 + kstep; const char* b3 = b2 + kstep;
            if (last && has_next) S.a_ready(nxt);
            if constexpr (SP2) {
            PG8_LDB(B0, 0, 0); PG8_LDB(B1, 0, 1); PG8_SCHED; PG8_LDA(At, 0, 0); PG8_STAGE(PG8_SA(1, 1), a1 + hstep, voffA);
            PG8_WAIT_V(8); PG8_WAIT_L(0); PG8_BAR; PG8_MMA(0, 0, At, B0); PG8_MMA(0, 1, At, B1); PG8_BAR; PG8_SCHED;
            PG8_LDA(At, 0, 1); PG8_STAGE(PG8_SB(0, 0), b2, voffB); PG8_STAGE(PG8_SB(0, 1), b2 + hstep, voffB); PG8_STAGE(PG8_SA(0, 0), a2, voffA);
            PG8_WAIT_V(8); PG8_WAIT_L(0); PG8_BAR; PG8_MMA(1, 0, At, B0); PG8_MMA(1, 1, At, B1); PG8_BAR; PG8_SCHED;
            PG8_LDB(B0, 1, 0); PG8_LDB(B1, 1, 1); PG8_SCHED; PG8_LDA(At, 1, 0); PG8_STAGE(PG8_SA(0, 1), a2 + hstep, voffA);
            PG8_WAIT_V(8); PG8_WAIT_L(0); PG8_BAR; PG8_MMA(0, 0, At, B0); PG8_MMA(0, 1, At, B1); PG8_BAR; PG8_SCHED;
            PG8_LDA(At, 1, 1); PG8_STAGE(PG8_SB(1, 0), b3, voffB); PG8_STAGE(PG8_SB(1, 1), b3 + hstep, voffB); PG8_STAGE(PG8_SA(1, 0), a3, voffA);
            PG8_WAIT_V(8); PG8_WAIT_L(0); PG8_BAR; PG8_MMA(1, 0, At, B0); PG8_MMA(1, 1, At, B1); PG8_BAR; PG8_SCHED;
            } else {
            PG8_LDB(B0, 0, 0); PG8_SCHED; PG8_LDA(At, 0, 0); PG8_STAGE(PG8_SA(1, 1), a1 + hstep, voffA);
            PG8_WAIT_L(8); PG8_BAR; PG8_WAIT_L(0); PG8_MMA(0, 0, At, B0); PG8_BAR; PG8_SCHED;
            PG8_LDB(B1, 0, 1); PG8_STAGE(PG8_SB(0, 0), b2, voffB);
            PG8_BAR; PG8_WAIT_L(0); PG8_MMA(0, 1, At, B1); PG8_BAR;
            PG8_LDA(At, 0, 1); PG8_STAGE(PG8_SA(0, 0), a2, voffA);
            PG8_BAR; PG8_WAIT_L(0); PG8_MMA(1, 0, At, B0); PG8_BAR; PG8_SCHED;
            PG8_STAGE(PG8_SB(0, 1), b2 + hstep, voffB);
            PG8_WAIT_V(6); PG8_BAR; PG8_MMA(1, 1, At, B1); PG8_BAR;
            PG8_LDB(B0, 1, 0); PG8_SCHED; PG8_LDA(At, 1, 0); PG8_STAGE(PG8_SA(0, 1), a2 + hstep, voffA);
            PG8_WAIT_L(8); PG8_BAR; PG8_WAIT_L(0); PG8_MMA(0, 0, At, B0); PG8_BAR; PG8_SCHED;
            PG8_LDB(B1, 1, 1); PG8_STAGE(PG8_SB(1, 0), b3, voffB);
            PG8_BAR; PG8_WAIT_L(0); PG8_MMA(0, 1, At, B1); PG8_BAR;
            PG8_LDA(At, 1, 1); PG8_STAGE(PG8_SA(1, 0), a3, voffA);
            PG8_BAR; PG8_WAIT_L(0); PG8_MMA(1, 0, At, B0); PG8_BAR; PG8_SCHED;
            PG8_STAGE(PG8_SB(1, 1), b3 + hstep, voffB);
            PG8_WAIT_V(6); PG8_BAR; PG8_MMA(1, 1, At, B1); PG8_BAR;
            }
        }
        if constexpr (ALIGN_EPI) { if (wr == 0) PG8_BAR; }
        if constexpr (!Epi::AFTER_DRAIN) { E(acc, cur, wr, wc, fr, fq); S.done(cur); }
        if (!has_next) break;
#pragma unroll
        for (int a = 0; a < 2; ++a)
#pragma unroll
            for (int b = 0; b < 2; ++b)
#pragma unroll
                for (int m = 0; m < 4; ++m)
#pragma unroll
                    for (int n = 0; n < 2; ++n) acc[a][b][m][n] = (f32x4){0.f, 0.f, 0.f, 0.f};
        cur = nxt; cA = nA; cB = nB; ++ui;
        if constexpr (ALIGN_EPI) { if (wr == 1) PG8_BAR; }
    }
    PG8_WAIT_V(0);
    if constexpr (!ALIGN_EPI) { if (wr == 0) PG8_BAR; }
    PG8_BAR;
    if constexpr (Epi::AFTER_DRAIN) { E.fused(acc, cur, wr, wc, fr, fq, lds, wid, lane); S.done(cur); }
#undef PG8_SA
#undef PG8_SB
#undef PG8_STAGE
#undef PG8_LDA
#undef PG8_LDB
#undef PG8_MMA
#undef PG8_WAIT_V
#undef PG8_WAIT_L
#undef PG8_BAR
#undef PG8_SCHED
}
}

constexpr int M = 8192, DM = 2048, SEQ = 2048, NPROJ = 4608, DPROJ_SRC = 4616, DFF = 5632, NGU = 11264, DPLE = 256, DEPTH = 4;
constexpr size_t SZ_WIN = (size_t)NPROJ * DM * 2, SZ_WOUT = (size_t)DM * DM * 2, SZ_WGU = (size_t)NGU * DM * 2, SZ_WDN = (size_t)DM * DFF * 2, SZ_WPG = SZ_WOUT, SZ_WPP = (size_t)DM * DPLE * 2;
constexpr size_t OFF_WIN = 0, OFF_WOUT = OFF_WIN + SZ_WIN, OFF_WGU = OFF_WOUT + SZ_WOUT, OFF_WDN = OFF_WGU + SZ_WGU, OFF_WPG = OFF_WDN + SZ_WDN, OFF_WPP = OFF_WPG + SZ_WPG, SZ_LAYER = OFF_WPP + SZ_WPP;
constexpr size_t WS_W = 1u << 20, WS_XN = WS_W + DEPTH * SZ_LAYER, WS_PROJ = WS_XN + (size_t)M * DM * 2, WS_MIX = WS_PROJ + (size_t)M * NPROJ * 2, WS_ACT = WS_MIX + (size_t)M * DM * 2,
                 WS_PP = WS_ACT + (size_t)M * DFF * 2, WS_PBF = WS_PP + (size_t)M * DM * 2, WS_LOGF = WS_PBF + (size_t)DEPTH * M * DPLE * 2, WS_CUM = WS_LOGF + (size_t)M * 8 * 4, WS_END = WS_CUM + (size_t)M * 8 * 4;
constexpr int LDS_BYTES = 147456;
constexpr float EPS = 1e-6f;

typedef unsigned short bf16;
typedef unsigned v4u __attribute__((ext_vector_type(4)));
typedef unsigned v2u __attribute__((ext_vector_type(2)));
typedef float f32x4 __attribute__((ext_vector_type(4)));
#define LAS __attribute__((address_space(3)))
#define LDS_WAIT() asm volatile("s_waitcnt lgkmcnt(0)" ::: "memory")
#define OPAQUE_TID() int tid; { int t_ = threadIdx.x; asm volatile("" : "+v"(t_)); tid = t_; } const int lane = tid & 63, wave = __builtin_amdgcn_readfirstlane(tid >> 6); (void)lane; (void)wave

__device__ __forceinline__ unsigned f2bf(float f) { unsigned u = __builtin_bit_cast(unsigned, f); return (u + 0x7fffu + ((u >> 16) & 1u)) >> 16; }
__device__ __forceinline__ unsigned pk2(float lo, float hi) { return f2bf(lo) | (f2bf(hi) << 16); }
__device__ __forceinline__ float bflo(unsigned w) { return __uint_as_float(w << 16); }
__device__ __forceinline__ float bfhi(unsigned w) { return __uint_as_float(w & 0xffff0000u); }
__device__ __forceinline__ float bf2f(bf16 v) { return __uint_as_float((unsigned)v << 16); }
__device__ __forceinline__ float wave_sum(float v) {
#pragma unroll
    for (int o = 1; o < 64; o <<= 1) v += __shfl_xor(v, o);
    return v;
}
__device__ __forceinline__ float gelu_tanh(float x) { const float y = 0.7978845608028654f * (x + 0.044715f * x * x * x); return 0.5f * x * (1.0f + tanhf(y)); }
__device__ __forceinline__ float log_sigmoid(float x) { return fminf(x, 0.f) - log1pf(expf(-fabsf(x))); }

struct Args { const float* in[20]; float* out; unsigned char* ws; };
enum { I_X = 0, I_P, I_NORM_MIX, I_W_IN, I_Q_NORM, I_K_NORM, I_FBIAS, I_GV_NORM, I_G_WS, I_G_BS, I_POOL_W, I_POOL_SCALE, I_W_OUT, I_NORM_FFN, I_W_GATE, I_W_UP, I_W_DOWN, I_NORM_PLE, I_W_PG, I_W_PP };

__device__ __forceinline__ void transpose_item(const float* W, int ldw, bf16* WT, int K, int k0, LAS float* scr, int lane) {
#pragma unroll 8
    for (int i = 0; i < 32; ++i) { const int kk = 2 * i + (lane >> 5); scr[kk * 33 + (lane & 31)] = W[(size_t)(k0 + kk) * ldw + (lane & 31)]; }
    LDS_WAIT(); asm volatile("" ::: "memory");
    const int c = lane & 7;
#pragma unroll
    for (int j = 0; j < 4; ++j) { const int n = (lane >> 3) + 8 * j; const LAS float* s = scr + (8 * c) * 33 + n;
        v4u o; o.x = pk2(s[0 * 33], s[1 * 33]); o.y = pk2(s[2 * 33], s[3 * 33]); o.z = pk2(s[4 * 33], s[5 * 33]); o.w = pk2(s[6 * 33], s[7 * 33]);
        *(v4u*)(WT + (size_t)n * K + k0 + 8 * c) = o; }
    LDS_WAIT(); asm volatile("" ::: "memory");
}

__device__ __forceinline__ void prologue_weights(const Args& a, LAS unsigned char* lds) {
    OPAQUE_TID();
    LAS float* scr = (LAS float*)(lds + wave * 16384);
    const int gw = blockIdx.x * 8 + wave, NGW = gridDim.x * 8;
    constexpr int I_IN = 32 * 144, I_OUT = 32 * 64, I_GU = 32 * 352, I_DN = 88 * 64, I_PG = 32 * 64, I_PPN = 4 * 64, I_L = I_IN + I_OUT + I_GU + I_DN + I_PG + I_PPN;
    for (int it = gw; it < DEPTH * I_L; it += NGW) {
        const int L = it / I_L; int r = it - L * I_L;
        unsigned char* wl = a.ws + WS_W + (size_t)L * SZ_LAYER;
        const float* src; int ldw, K, k0; bf16* dst;
        if (r < I_IN) { const int kb = r / 144, nb = r - kb * 144, n0 = nb * 32, c0 = n0 < 3072 ? n0 : n0 + 8;
            src = a.in[I_W_IN] + (size_t)L * DM * DPROJ_SRC + c0; ldw = DPROJ_SRC; K = DM; k0 = kb * 64; dst = (bf16*)(wl + OFF_WIN) + (size_t)n0 * DM; }
        else if ((r -= I_IN) < I_OUT) { const int kb = r / 64, nb = r - kb * 64, n0 = nb * 32;
            src = a.in[I_W_OUT] + (size_t)L * DM * DM + n0; ldw = DM; K = DM; k0 = kb * 64; dst = (bf16*)(wl + OFF_WOUT) + (size_t)n0 * DM; }
        else if ((r -= I_OUT) < I_GU) { const int kb = r / 352, nb = r - kb * 352, n0 = nb * 32, t = n0 >> 8, within = n0 & 255, half = within >> 7, j0 = within & 127;
            src = (half ? a.in[I_W_UP] : a.in[I_W_GATE]) + (size_t)L * DM * DFF + t * 128 + j0; ldw = DFF; K = DM; k0 = kb * 64; dst = (bf16*)(wl + OFF_WGU) + (size_t)n0 * DM; }
        else if ((r -= I_GU) < I_DN) { const int kb = r / 64, nb = r - kb * 64, n0 = nb * 32;
            src = a.in[I_W_DOWN] + (size_t)L * DFF * DM + n0; ldw = DM; K = DFF; k0 = kb * 64; dst = (bf16*)(wl + OFF_WDN) + (size_t)n0 * DFF; }
        else if ((r -= I_DN) < I_PG) { const int kb = r / 64, nb = r - kb * 64, n0 = nb * 32;
            src = a.in[I_W_PG] + (size_t)L * DM * DM + n0; ldw = DM; K = DM; k0 = kb * 64; dst = (bf16*)(wl + OFF_WPG) + (size_t)n0 * DM; }
        else { r -= I_PG; const int kb = r / 64, nb = r - kb * 64, n0 = nb * 32;
            src = a.in[I_W_PP] + (size_t)L * DPLE * DM + n0; ldw = DM; K = DPLE; k0 = kb * 64; dst = (bf16*)(wl + OFF_WPP) + (size_t)n0 * DPLE; }
        transpose_item(src, ldw, dst, K, k0, scr, lane);
    }
    { const size_t n8 = (size_t)DEPTH * M * DPLE / 8; const float* p = a.in[I_P]; bf16* pb = (bf16*)(a.ws + WS_PBF);
      for (size_t i = (size_t)blockIdx.x * 512 + tid; i < n8; i += (size_t)gridDim.x * 512) {
          const f32x4 x0 = *(const f32x4*)(p + i * 8), x1 = *(const f32x4*)(p + i * 8 + 4);
          v4u o; o.x = pk2(x0[0], x0[1]); o.y = pk2(x0[2], x0[3]); o.z = pk2(x1[0], x1[1]); o.w = pk2(x1[2], x1[3]);
          *(v4u*)(pb + i * 8) = o; } }
}

__device__ __forceinline__ void norm_phase(const float* h, const float* gain, bf16* xn, bool with_f, const float* win_l, const float* fbias, float* logf,
                                           unsigned char* lds) {
    OPAQUE_TID();
    float* wf = (float*)lds;
    if (with_f) {
        for (int c = tid; c < DM; c += 512) {
            const f32x4 x0 = *(const f32x4*)(win_l + (size_t)c * DPROJ_SRC + 3072), x1 = *(const f32x4*)(win_l + (size_t)c * DPROJ_SRC + 3076);
            wf[0 * DM + c] = x0[0]; wf[1 * DM + c] = x0[1]; wf[2 * DM + c] = x0[2]; wf[3 * DM + c] = x0[3];
            wf[4 * DM + c] = x1[0]; wf[5 * DM + c] = x1[1]; wf[6 * DM + c] = x1[2]; wf[7 * DM + c] = x1[3]; }
        __syncthreads();
    }
    const int gw = blockIdx.x * 8 + wave, NGW = gridDim.x * 8;
    f32x4 g[8];
#pragma unroll
    for (int j = 0; j < 8; ++j) g[j] = *(const f32x4*)(gain + 4 * lane + 256 * j);
    for (int row = gw; row < M; row += NGW) {
        const f32x4* xr = (const f32x4*)(h + (size_t)row * DM) + lane;
        f32x4 v[8]; float ss = 0.f;
#pragma unroll
        for (int j = 0; j < 8; ++j) { v[j] = xr[64 * j]; ss += (v[j][0] * v[j][0] + v[j][1] * v[j][1]) + (v[j][2] * v[j][2] + v[j][3] * v[j][3]); }
        ss = wave_sum(ss);
        const float rinv = 1.0f / sqrtf(ss * (1.0f / DM) + EPS);
        v2u* o8 = (v2u*)(xn + (size_t)row * DM) + lane;
#pragma unroll
        for (int j = 0; j < 8; ++j) { v[j] = v[j] * rinv * g[j]; v2u w; w.x = pk2(v[j][0], v[j][1]); w.y = pk2(v[j][2], v[j][3]); o8[64 * j] = w; }
        if (with_f) {
            float f[8];
#pragma unroll
            for (int hh = 0; hh < 8; ++hh) { float s = 0.f;
#pragma unroll
                for (int j = 0; j < 8; ++j) { const f32x4 w = *(const f32x4*)(wf + hh * DM + 4 * lane + 256 * j); s += (v[j][0] * w[0] + v[j][1] * w[1]) + (v[j][2] * w[2] + v[j][3] * w[3]); }
                f[hh] = wave_sum(s); asm volatile("" ::: "memory"); }
            float mine = f[0];
#pragma unroll
            for (int hh = 1; hh < 8; ++hh) mine = (lane == hh) ? f[hh] : mine;
            if (lane < 8) logf[(size_t)row * 8 + lane] = log_sigmoid(mine + fbias[lane]);
        }
    }
    if (with_f) __syncthreads();
}

__device__ __forceinline__ void post_phase(bf16* proj, const float* qg, const float* kg, const float* logf, float* cum) {
    OPAQUE_TID();
    const int gw = blockIdx.x * 8 + wave, NGW = gridDim.x * 8;
    const int d0 = 8 * (lane & 15);
    float gq[8], gk[8];
#pragma unroll
    for (int e = 0; e < 8; ++e) { gq[e] = qg[d0 + e]; gk[e] = kg[d0 + e]; }
    for (int row = gw; row < M; row += NGW) {
        v4u* pr = (v4u*)(proj + (size_t)row * NPROJ);
#pragma unroll
        for (int j = 0; j < 4; ++j) {
            const v4u w = pr[lane + 64 * j];
            float x[8] = {bflo(w.x), bfhi(w.x), bflo(w.y), bfhi(w.y), bflo(w.z), bfhi(w.z), bflo(w.w), bfhi(w.w)};
            float ss = 0.f;
#pragma unroll
            for (int e = 0; e < 8; ++e) ss += x[e] * x[e];
            ss += __shfl_xor(ss, 1); ss += __shfl_xor(ss, 2); ss += __shfl_xor(ss, 4); ss += __shfl_xor(ss, 8);
            const float rinv = 1.0f / sqrtf(ss * (1.0f / 128.0f) + EPS);
#pragma unroll
            for (int e = 0; e < 8; ++e) x[e] = x[e] * rinv * (j < 2 ? gq[e] : gk[e]);
            v4u o; o.x = pk2(x[0], x[1]); o.y = pk2(x[2], x[3]); o.z = pk2(x[4], x[5]); o.w = pk2(x[6], x[7]);
            pr[lane + 64 * j] = o;
        }
    }
    for (int bh = blockIdx.x; bh < 32; bh += gridDim.x) if (wave == 0) {
        const int b = bh >> 3, hh = bh & 7;
        float loc[32]; float run = 0.f;
#pragma unroll
        for (int i = 0; i < 32; ++i) { run += logf[((size_t)(b * SEQ + lane * 32 + i)) * 8 + hh]; loc[i] = run; }
        float inc = run;
#pragma unroll
        for (int o = 1; o < 64; o <<= 1) { const float t = __shfl_up(inc, o); if (lane >= o) inc += t; }
        const float excl = inc - run;
#pragma unroll
        for (int i = 0; i < 32; ++i) cum[(size_t)bh * SEQ + lane * 32 + i] = excl + loc[i];
    }
}

__device__ __forceinline__ void attn_naive(const bf16* proj, const float* cum, bf16* mix) {
    OPAQUE_TID();
    const int gw = blockIdx.x * 8 + wave, NGW = gridDim.x * 8;
    const int g = lane >> 4, li = lane & 15;
    const float SCALE = 0.08838834764831845f;
    for (int id = gw; id < 32 * SEQ; id += NGW) {
        const int bh = id / SEQ, tt = id - bh * SEQ, t = (bh & 1) ? (SEQ - 1 - tt) : tt;
        const int b = bh >> 3, hh = bh & 7;
        const v4u qw = *(const v4u*)(proj + (size_t)(b * SEQ + t) * NPROJ + hh * 128 + 8 * li);
        const float q[8] = {bflo(qw.x), bfhi(qw.x), bflo(qw.y), bfhi(qw.y), bflo(qw.z), bfhi(qw.z), bflo(qw.w), bfhi(qw.w)};
        const float* cb = cum + (size_t)bh * SEQ;
        const float ct = cb[t];
        float m = -1e30f, l = 0.f, o[8];
#pragma unroll
        for (int e = 0; e < 8; ++e) o[e] = 0.f;
        const bf16* kbase = proj + (size_t)(b * SEQ) * NPROJ + 1024 + hh * 128 + 8 * li;
        const bf16* vbase = kbase + 1024;
        for (int s0 = 0; s0 <= t; s0 += 4) {
            const int s = s0 + g; const bool valid = s <= t; const int sa = valid ? s : t;
            const v4u kw = *(const v4u*)(kbase + (size_t)sa * NPROJ);
            const v4u vw = *(const v4u*)(vbase + (size_t)sa * NPROJ);
            float d = (q[0] * bflo(kw.x) + q[1] * bfhi(kw.x)) + (q[2] * bflo(kw.y) + q[3] * bfhi(kw.y)) + (q[4] * bflo(kw.z) + q[5] * bfhi(kw.z)) + (q[6] * bflo(kw.w) + q[7] * bfhi(kw.w));
            d += __shfl_xor(d, 1); d += __shfl_xor(d, 2); d += __shfl_xor(d, 4); d += __shfl_xor(d, 8);
            const float sc = valid ? d * SCALE + (ct - cb[sa]) : -__builtin_inff();
            const float mn = fmaxf(m, sc), al = __expf(m - mn), p = __expf(sc - mn);
            l = l * al + p;
            const float v[8] = {bflo(vw.x), bfhi(vw.x), bflo(vw.y), bfhi(vw.y), bflo(vw.z), bfhi(vw.z), bflo(vw.w), bfhi(vw.w)};
#pragma unroll
            for (int e = 0; e < 8; ++e) o[e] = o[e] * al + p * v[e];
            m = mn;
        }
        float mall = fmaxf(m, __shfl_xor(m, 16)); mall = fmaxf(mall, __shfl_xor(mall, 32));
        const float w = __expf(m - mall);
        l *= w; l += __shfl_xor(l, 16); l += __shfl_xor(l, 32);
#pragma unroll
        for (int e = 0; e < 8; ++e) { o[e] *= w; o[e] += __shfl_xor(o[e], 16); o[e] += __shfl_xor(o[e], 32); }
        if (g == 0) { const float inv = 1.0f / l; v4u ow; ow.x = pk2(o[0] * inv, o[1] * inv); ow.y = pk2(o[2] * inv, o[3] * inv); ow.z = pk2(o[4] * inv, o[5] * inv); ow.w = pk2(o[6] * inv, o[7] * inv);
            *(v4u*)(mix + (size_t)(b * SEQ + t) * DM + hh * 128 + 8 * li) = ow; }
    }
}

__device__ __forceinline__ void gmlp_naive(const bf16* proj, const float* vgain, const float* wsp, const float* bs, bf16* mix, unsigned char* lds) {
    OPAQUE_TID();
    float* tile = (float*)lds;
    for (int item = blockIdx.x; item < 256; item += gridDim.x) {
        const int g = item & 3, n = (item >> 2) & 15, b = item >> 6;
        const size_t row0 = (size_t)b * SEQ + n * 128;
        for (int i = 0; i < 16; ++i) { const int s = wave * 16 + i;
            const unsigned w = *(const unsigned*)(proj + (row0 + s) * NPROJ + 3584 + g * 128 + 2 * lane);
            const float v0 = gelu_tanh(bflo(w)), v1 = gelu_tanh(bfhi(w));
            const float ss = wave_sum(v0 * v0 + v1 * v1); const float rinv = 1.0f / sqrtf(ss * (1.0f / 128.0f) + EPS);
            tile[s * 128 + 2 * lane] = v0 * rinv * vgain[g * 128 + 2 * lane]; tile[s * 128 + 2 * lane + 1] = v1 * rinv * vgain[g * 128 + 2 * lane + 1]; }
        __syncthreads();
        const int c = tid & 127, tq = tid >> 7;
        for (int i = 0; i < 32; ++i) { const int t = tq + 4 * i;
            const float* wr = wsp + (size_t)(g * 128 + t) * 128;
            float acc = 0.f;
            for (int s = 0; s <= t; ++s) acc += wr[s] * tile[s * 128 + c];
            const float mixed = acc + bs[g * 128 + t];
            const float u = bf2f(proj[(row0 + t) * NPROJ + 3072 + g * 128 + c]);
            mix[(row0 + t) * DM + 1024 + g * 128 + c] = (bf16)f2bf(gelu_tanh(u) * mixed); }
        __syncthreads();
    }
}

__device__ __forceinline__ void pool_naive(const bf16* proj, const float* pw, const float* pscale, bf16* mix, unsigned char* lds) {
    OPAQUE_TID();
    float* tile = (float*)lds;
    const int c = tid & 127, rq = tid >> 7;
    for (int item = blockIdx.x; item < 512; item += gridDim.x) {
        const int g = item & 3, tb = item >> 2; const size_t row0 = (size_t)tb * 64; const int sbase = (tb * 64) % SEQ; const size_t seq0 = row0 - sbase;
        const int win = 2 << g;
        for (int i = 0; i < 16; ++i) { const int r = rq + 4 * i, s = sbase + r; const int lo = (s + 1 - win) > 0 ? (s + 1 - win) : 0;
            float sum = 0.f;
            for (int j = lo; j <= s; ++j) sum += bf2f(proj[(seq0 + j) * NPROJ + 4096 + g * 128 + c]);
            const float xs = bf2f(proj[(seq0 + s) * NPROJ + 4096 + g * 128 + c]);
            tile[r * 128 + c] = sum / (float)(s + 1 - lo) - xs; }
        __syncthreads();
        float acc[16];
#pragma unroll
        for (int i = 0; i < 16; ++i) acc[i] = 0.f;
        const float* wg = pw + (size_t)g * 128 * 128;
        for (int cc = 0; cc < 128; ++cc) { const float w = wg[cc * 128 + c];
#pragma unroll
            for (int i = 0; i < 16; ++i) acc[i] += tile[(rq + 4 * i) * 128 + cc] * w; }
        const float sc = pscale[g * 128 + c];
#pragma unroll
        for (int i = 0; i < 16; ++i) mix[(row0 + rq + 4 * i) * DM + 1536 + g * 128 + c] = (bf16)f2bf(acc[i] * sc);
        __syncthreads();
    }
}

__global__ void __launch_bounds__(512, 2) fwd(Args a) {
    extern __shared__ __attribute__((aligned(16))) unsigned char lds[];
    cg::grid_group grid = cg::this_grid();
    unsigned char* ws = a.ws;
    bf16* XN = (bf16*)(ws + WS_XN); bf16* PROJ = (bf16*)(ws + WS_PROJ); bf16* MIX = (bf16*)(ws + WS_MIX); bf16* ACT = (bf16*)(ws + WS_ACT); bf16* PP = (bf16*)(ws + WS_PP);
    bf16* PBF = (bf16*)(ws + WS_PBF); float* LOGF = (float*)(ws + WS_LOGF); float* CUM = (float*)(ws + WS_CUM);
    float* H = a.out;
    PG8_LAS unsigned char* ring = (PG8_LAS unsigned char*)lds;
    const int G = gridDim.x, bx = blockIdx.x;

    prologue_weights(a, (LAS unsigned char*)lds);
    norm_phase(a.in[I_X], a.in[I_NORM_MIX], XN, true, a.in[I_W_IN], a.in[I_FBIAS], LOGF, lds);
    grid.sync();

#pragma unroll 1
    for (int L = 0; L < DEPTH; ++L) {
        unsigned char* wl = ws + WS_W + (size_t)L * SZ_LAYER;
        const bf16* Win = (const bf16*)(wl + OFF_WIN); const bf16* Wout = (const bf16*)(wl + OFF_WOUT); const bf16* Wgu = (const bf16*)(wl + OFF_WGU);
        const bf16* Wdn = (const bf16*)(wl + OFF_WDN); const bf16* Wpg = (const bf16*)(wl + OFF_WPG); const bf16* Wpp = (const bf16*)(wl + OFF_WPP);
        { pg8::Gemm g{XN, Win, M, NPROJ, DM}; pg8::StaticOrder S; S.init(M, NPROJ, G, bx);
          pg8::EpiBf16<0> E{PROJ, NPROJ, nullptr, 0, 0, 1.f};
          pg8::gemm_phase<pg8::EpiBf16<0>, pg8::StaticOrder, true, true>(ring, g, S, E); }
        { pg8::Gemm g{PBF + (size_t)L * M * DPLE, Wpp, M, DM, DPLE}; pg8::StaticOrder S; S.init(M, DM, G, bx);
          pg8::EpiBf16<0> E{PP, DM, nullptr, 0, 0, 1.f};
          pg8::gemm_phase<pg8::EpiBf16<0>, pg8::StaticOrder, true, true>(ring, g, S, E); }
        grid.sync();
        post_phase(PROJ, a.in[I_Q_NORM] + L * 128, a.in[I_K_NORM] + L * 128, LOGF, CUM);
        grid.sync();
        gmlp_naive(PROJ, a.in[I_GV_NORM] + L * 512, a.in[I_G_WS] + (size_t)L * 4 * 128 * 128, a.in[I_G_BS] + L * 512, MIX, lds);
        pool_naive(PROJ, a.in[I_POOL_W] + (size_t)L * 4 * 128 * 128, a.in[I_POOL_SCALE] + L * 512, MIX, lds);
        attn_naive(PROJ, CUM, MIX);
        grid.sync();
        { pg8::Gemm g{MIX, Wout, M, DM, DM}; pg8::StaticOrder S; S.init(M, DM, G, bx);
          pg8::EpiRes E{L == 0 ? a.in[I_X] : H, H, DM};
          pg8::gemm_phase<pg8::EpiRes, pg8::StaticOrder, true, true>(ring, g, S, E); }
        grid.sync();
        norm_phase(H, a.in[I_NORM_FFN] + L * DM, XN, false, nullptr, nullptr, nullptr, lds);
        grid.sync();
        { pg8::Gemm g{XN, Wgu, M, NGU, DM}; pg8::StaticOrder S; S.init(M, NGU, G, bx);
          pg8::EpiSwiglu E{ACT, DFF};
          pg8::gemm_phase<pg8::EpiSwiglu, pg8::StaticOrder, true, true>(ring, g, S, E); }
        grid.sync();
        { pg8::Gemm g{ACT, Wdn, M, DM, DFF}; pg8::StaticOrder S; S.init(M, DM, G, bx);
          pg8::EpiRes E{H, H, DM};
          pg8::gemm_phase<pg8::EpiRes, pg8::StaticOrder, true, true>(ring, g, S, E); }
        grid.sync();
        norm_phase(H, a.in[I_NORM_PLE] + L * DM, XN, false, nullptr, nullptr, nullptr, lds);
        grid.sync();
        { pg8::Gemm g{XN, Wpg, M, DM, DM}; pg8::StaticOrder S; S.init(M, DM, G, bx);
          pg8::EpiPle E{H, H, PP, DM};
          pg8::gemm_phase<pg8::EpiPle, pg8::StaticOrder, true, true>(ring, g, S, E); }
        if (L + 1 < DEPTH) {
            grid.sync();
            norm_phase(H, a.in[I_NORM_MIX] + (L + 1) * DM, XN, true, a.in[I_W_IN] + (size_t)(L + 1) * DM * DPROJ_SRC, a.in[I_FBIAS] + (L + 1) * 8, LOGF, lds);
            grid.sync();
        }
    }
}

extern "C" void kernel_launch(void* const* d_in, const int* in_sizes, int n_in, void* d_out, int out_size, void* d_ws, size_t ws_size, hipStream_t stream) {
    static int grid = 0;
    if (grid == 0) {
        if (n_in != 20 || out_size != M * DM || ws_size < WS_END) { fprintf(stderr, "kernel_launch: unexpected shapes (n_in %d out %d ws %zu, need %zu)\n", n_in, out_size, ws_size, (size_t)WS_END); grid = -1; return; }
        int dev = 0, cus = 0, per_cu = 0;
        (void)hipGetDevice(&dev); (void)hipDeviceGetAttribute(&cus, hipDeviceAttributeMultiprocessorCount, dev);
        if (hipFuncSetAttribute((const void*)fwd, hipFuncAttributeMaxDynamicSharedMemorySize, LDS_BYTES) != hipSuccess) fprintf(stderr, "kernel_launch: hipFuncSetAttribute failed\n");
        if (hipOccupancyMaxActiveBlocksPerMultiprocessor(&per_cu, (const void*)fwd, 512, LDS_BYTES) != hipSuccess || per_cu < 1) { fprintf(stderr, "kernel_launch: occupancy query gave %d\n", per_cu); per_cu = 1; }
        (void)hipGetLastError();
        if (cus <= 0) cus = 256;
        grid = cus * per_cu;
    }
    if (grid < 0) return;
    Args a{};
    for (int i = 0; i < 20; ++i) a.in[i] = (const float*)d_in[i];
    a.out = (float*)d_out; a.ws = (unsigned char*)d_ws;
    void* args[] = {&a};
    hipError_t e = hipLaunchCooperativeKernel((void*)fwd, dim3(grid), dim3(512), args, LDS_BYTES, stream);
    if (e != hipSuccess) fprintf(stderr, "cooperative launch failed: %s (grid %d)\n", hipGetErrorString(e), grid);
}
```

```cpp
#include <hip/hip_runtime.h>
#include <hip/hip_cooperative_groups.h>
#include <cstdio>
#include <cstdint>
namespace cg = cooperative_groups;
namespace pg8 {
#define PG8_LAS __attribute__((address_space(3)))
typedef unsigned short bf16_t;
typedef short bf16x8 __attribute__((ext_vector_type(8)));
typedef float f32x4 __attribute__((ext_vector_type(4)));
typedef unsigned u32x4 __attribute__((ext_vector_type(4)));
constexpr int BM = 256, BK = 64, HALF = 128, HTB = HALF * BK * 2  , STAGE_BYTES = 8 * HTB, NXCD = 8, WGM = 8;

__host__ __device__ __forceinline__ int lds_byte(int r, int c) { const int st = (r >> 4) * 2 + (c >> 5), rr = r & 15, cc = c & 31, ob = rr * 64 + cc * 2; return st * 1024 + (ob ^ (((ob >> 9) & 1) << 5)); }
__host__ __device__ __forceinline__ void stage_rc(int b, int& R, int& C) { const int st = b / 1024, sb = b % 1024, swz = sb ^ (((sb >> 9) & 1) << 5); R = (st >> 1) * 16 + swz / 64; C = (st & 1) * 32 + (swz % 64) / 2; }
__host__ __device__ __forceinline__ int perm32(int rho) { const int n = rho >> 4, i = rho & 15; return 8 * (i >> 2) + 4 * n + (i & 3); }

struct Unit { int pm, pn; };
struct Gemm { const bf16_t* A; const bf16_t* Bt; int M, N, K; };

struct StaticOrder {
    int nM, nN, nwg, G, c;
    __host__ __device__ void init(int M, int N, int G_, int c_) { nM = M / BM; nN = N / BM; nwg = nM * nN; G = G_; c = c_; }
    __host__ __device__ bool next(int i, Unit& u) const {
        const long L = (long)i * G + c; if (L >= nwg) return false;
        int wgid = (int)L; { const int q = nwg / NXCD, r = nwg % NXCD, xcd = wgid % NXCD, off = wgid / NXCD; wgid = (xcd < r ? xcd * (q + 1) : r * (q + 1) + (xcd - r) * q) + off; }
        const int nig = WGM * nN, gid = wgid / nig, fm = gid * WGM, gsz = (nM - fm) < WGM ? (nM - fm) : WGM;
        u.pm = fm + ((wgid % nig) % gsz); u.pn = (wgid % nig) / gsz; return true;
    }
    __device__ __forceinline__ void a_ready(const Unit&) const {}
    __device__ __forceinline__ void done(const Unit&) const {}
};

__device__ __forceinline__ unsigned cvt_pk_bf16(float lo, float hi) { unsigned r; asm volatile("v_cvt_pk_bf16_f32 %0, %1, %2" : "=v"(r) : "v"(lo), "v"(hi)); return r; }
typedef float f32x2 __attribute__((ext_vector_type(2)));
__device__ __forceinline__ f32x2 gelu_pk(f32x2 v) {
    const f32x2 av = __builtin_elementwise_abs(v), d = av * 0.2316418882f + 1.0f;
    f32x2 t; t.x = __builtin_amdgcn_rcpf(d.x); t.y = __builtin_amdgcn_rcpf(d.y);
    f32x2 q = t * 0.5307027145f + (-0.7265760135f); q = q * t + 0.7107068705f; q = q * t + (-0.142248368f); q = q * t + 0.127414796f; q = q * t;
    const f32x2 s = (v * v) * (-0.72134752044f);
    f32x2 e; e.x = __builtin_amdgcn_exp2f(s.x); e.y = __builtin_amdgcn_exp2f(s.y);
    const f32x2 m = v * (q * e), r = v - m;
    f32x2 o; o.x = v.x < 0.f ? m.x : r.x; o.y = v.y < 0.f ? m.y : r.y; return o;
}

template <int ACT  > struct EpiBf16 {
    static constexpr bool PERM = true, AFTER_DRAIN = false; static_assert(ACT == 0 || ACT == 1, "EpiBf16: ACT is 0 (none) or 1 (gelu_pk)");
    bf16_t* O; int ldc; const float* bias; int split_cols; size_t split_stride; float scale0;
    __device__ __forceinline__ void operator()(const f32x4 (&acc)[2][2][4][2], const Unit& u, int wr, int wc, int fr, int fq) const {
        const int row0 = u.pm * BM + wr * 64 + fr; int colt = u.pn * BM; bf16_t* base = O;
        float sc = 1.f; if (split_cols) { const int t = colt / split_cols; base += (size_t)t * split_stride; colt -= t * split_cols; if (t == 0) sc = scale0; }
        const int col0 = colt + wc * 32 + 8 * fq, bcol0 = u.pn * BM + wc * 32 + 8 * fq;
        f32x4 bv[2][2];
#pragma unroll
        for (int bj = 0; bj < 2; ++bj)
#pragma unroll
            for (int n = 0; n < 2; ++n) bv[bj][n] = bias ? *(const f32x4*)(bias + bcol0 + bj * HALF + 4 * n) : (f32x4){0.f, 0.f, 0.f, 0.f};
#pragma unroll
        for (int ai = 0; ai < 2; ++ai)
#pragma unroll
            for (int m = 0; m < 4; ++m) { bf16_t* rowp = base + (size_t)(row0 + ai * HALF + m * 16) * ldc + col0;
#pragma unroll
                for (int bj = 0; bj < 2; ++bj) { f32x4 v0 = acc[ai][bj][m][0] + bv[bj][0], v1 = acc[ai][bj][m][1] + bv[bj][1];
                    if (ACT == 1) { f32x2 a = gelu_pk((f32x2){v0[0], v0[1]}), b = gelu_pk((f32x2){v0[2], v0[3]}), c = gelu_pk((f32x2){v1[0], v1[1]}), d = gelu_pk((f32x2){v1[2], v1[3]});
                        v0 = (f32x4){a.x, a.y, b.x, b.y}; v1 = (f32x4){c.x, c.y, d.x, d.y}; }
                    v0 = v0 * sc; v1 = v1 * sc; u32x4 w; w.x = cvt_pk_bf16(v0[0], v0[1]); w.y = cvt_pk_bf16(v0[2], v0[3]); w.z = cvt_pk_bf16(v1[0], v1[1]); w.w = cvt_pk_bf16(v1[2], v1[3]);
                    *(u32x4*)(rowp + bj * HALF) = w; } }
    }
};
typedef unsigned u32x2 __attribute__((ext_vector_type(2)));
__device__ __forceinline__ float bf_lo(unsigned w) { return __uint_as_float(w << 16); }
__device__ __forceinline__ float bf_hi(unsigned w) { return __uint_as_float(w & 0xffff0000u); }
__device__ __forceinline__ float sigmoidf_(float x) { return 1.0f / (1.0f + __expf(-x)); }
struct EpiRes {
    static constexpr bool PERM = false, AFTER_DRAIN = false;
    const float* base; float* out; int ldc;
    __device__ __forceinline__ void operator()(const f32x4 (&acc)[2][2][4][2], const Unit& u, int wr, int wc, int fr, int fq) const {
        const int col0 = u.pn * BM + wc * 32 + 4 * fq;
#pragma unroll
        for (int ai = 0; ai < 2; ++ai)
#pragma unroll
            for (int m = 0; m < 4; ++m) { const size_t off = (size_t)(u.pm * BM + ai * HALF + wr * 64 + m * 16 + fr) * ldc + col0;
#pragma unroll
                for (int bj = 0; bj < 2; ++bj)
#pragma unroll
                    for (int n = 0; n < 2; ++n) { const f32x4 bs = *(const f32x4*)(base + off + bj * HALF + n * 16); *(f32x4*)(out + off + bj * HALF + n * 16) = bs + acc[ai][bj][m][n]; }
                asm volatile("" ::: "memory"); }
    }
};
struct EpiPle {
    static constexpr bool PERM = false, AFTER_DRAIN = false;
    const float* base; float* out; const bf16_t* pp; int ldc;
    __device__ __forceinline__ void operator()(const f32x4 (&acc)[2][2][4][2], const Unit& u, int wr, int wc, int fr, int fq) const {
        const int col0 = u.pn * BM + wc * 32 + 4 * fq;
#pragma unroll
        for (int ai = 0; ai < 2; ++ai)
#pragma unroll
            for (int m = 0; m < 4; ++m) { const size_t off = (size_t)(u.pm * BM + ai * HALF + wr * 64 + m * 16 + fr) * ldc + col0;
#pragma unroll
                for (int bj = 0; bj < 2; ++bj)
#pragma unroll
                    for (int n = 0; n < 2; ++n) { const f32x4 bs = *(const f32x4*)(base + off + bj * HALF + n * 16); const u32x2 pw = *(const u32x2*)(pp + off + bj * HALF + n * 16);
                        const f32x4 a = acc[ai][bj][m][n]; f32x4 o;
                        o[0] = bs[0] + bf_lo(pw.x) * sigmoidf_(a[0]); o[1] = bs[1] + bf_hi(pw.x) * sigmoidf_(a[1]);
                        o[2] = bs[2] + bf_lo(pw.y) * sigmoidf_(a[2]); o[3] = bs[3] + bf_hi(pw.y) * sigmoidf_(a[3]);
                        *(f32x4*)(out + off + bj * HALF + n * 16) = o; }
                asm volatile("" ::: "memory"); }
    }
};
struct EpiSwiglu {
    static constexpr bool PERM = true, AFTER_DRAIN = false;
    bf16_t* O; int ldc;
    __device__ __forceinline__ void operator()(const f32x4 (&acc)[2][2][4][2], const Unit& u, int wr, int wc, int fr, int fq) const {
        const int col0 = u.pn * HALF + wc * 32 + 8 * fq;
#pragma unroll
        for (int ai = 0; ai < 2; ++ai)
#pragma unroll
            for (int m = 0; m < 4; ++m) { bf16_t* rowp = O + (size_t)(u.pm * BM + ai * HALF + wr * 64 + m * 16 + fr) * ldc + col0;
                float r[8];
#pragma unroll
                for (int n = 0; n < 2; ++n)
#pragma unroll
                    for (int j = 0; j < 4; ++j) { const float g = acc[ai][0][m][n][j], up = acc[ai][1][m][n][j]; r[n * 4 + j] = g * sigmoidf_(g) * up; }
                u32x4 w; w.x = cvt_pk_bf16(r[0], r[1]); w.y = cvt_pk_bf16(r[2], r[3]); w.z = cvt_pk_bf16(r[4], r[5]); w.w = cvt_pk_bf16(r[6], r[7]);
                *(u32x4*)rowp = w; asm volatile("" ::: "memory"); }
    }
};
template <class Epi, class Sched, bool ALIGN_EPI = false, bool SP2 = false>
__device__ __forceinline__ void gemm_phase(PG8_LAS unsigned char* lds, const Gemm g, const Sched& S, const Epi& E) {
    int tid_ = threadIdx.x; asm volatile("" : "+v"(tid_));
    const int tid = tid_, wid = __builtin_amdgcn_readfirstlane(tid >> 6), lane = tid & 63, wr = wid >> 2, wc = wid & 3, fr = lane & 15, fq = lane >> 4;
    const int K = g.K, nt = K / BK;
    unsigned voffA[2], voffB[2];
#pragma unroll
    for (int i = 0; i < 2; ++i) { int R, C; stage_rc(tid * 16 + i * 8192, R, C); const int Rb = Epi::PERM ? ((R & ~31) + perm32(R & 31)) : R;
        voffA[i] = (unsigned)(R * K + C) * 2u; voffB[i] = (unsigned)(Rb * K + C) * 2u; }
    const size_t kstep = (size_t)(BK * 2);
    const size_t hstep = (size_t)HALF * K * 2;
    const size_t tstep = 2 * hstep;
    const unsigned ldsw = (unsigned)wid * 1024u;
    const int aoff = lds_byte(wr * 64 + fr, fq * 8), boff = lds_byte(wc * 32 + fr, fq * 8);
#define PG8_SA(b, h) (((b) * 2 + (h)) * HTB)
#define PG8_SB(b, h) ((4 + (b) * 2 + (h)) * HTB)
#define PG8_STAGE(bufoff, gbase, voff) do { _Pragma("unroll") for (int _i = 0; _i < 2; ++_i) \
        __builtin_amdgcn_global_load_lds((const unsigned*)((const char*)(gbase) + (voff)[_i]), (PG8_LAS unsigned*)(lds + (bufoff) + ldsw + _i * 8192), 16, 0, 0); } while (0)
#define PG8_LDA(dst, b, h) do { _Pragma("unroll") for (int m = 0; m < 4; ++m) _Pragma("unroll") for (int k = 0; k < 2; ++k) dst[m][k] = *(const PG8_LAS bf16x8*)(lds + PG8_SA(b, h) + aoff + m * 2048 + k * 1024); } while (0)
#define PG8_LDB(dst, b, h) do { _Pragma("unroll") for (int n = 0; n < 2; ++n) _Pragma("unroll") for (int k = 0; k < 2; ++k) dst[n][k] = *(const PG8_LAS bf16x8*)(lds + PG8_SB(b, h) + boff + n * 2048 + k * 1024); } while (0)
#define PG8_MMA(ai, bj, At, Bt) do { __builtin_amdgcn_s_setprio(1); _Pragma("unroll") for (int m = 0; m < 4; ++m) _Pragma("unroll") for (int n = 0; n < 2; ++n) _Pragma("unroll") for (int k = 0; k < 2; ++k) \
        acc[ai][bj][m][n] = __builtin_amdgcn_mfma_f32_16x16x32_bf16(Bt[n][k], At[m][k], acc[ai][bj][m][n], 0, 0, 0); __builtin_amdgcn_s_setprio(0); } while (0)
#define PG8_WAIT_V(n) asm volatile("s_waitcnt vmcnt(" #n ")" ::: "memory")
#define PG8_WAIT_L(n) asm volatile("s_waitcnt lgkmcnt(" #n ")" ::: "memory")
#define PG8_BAR __builtin_amdgcn_s_barrier()
#define PG8_SCHED __builtin_amdgcn_sched_barrier(0)
    Unit cur, nxt; int ui = 0;
    if (!S.next(0, cur)) return;
    f32x4 acc[2][2][4][2];
#pragma unroll
    for (int a = 0; a < 2; ++a)
#pragma unroll
        for (int b = 0; b < 2; ++b)
#pragma unroll
            for (int m = 0; m < 4; ++m)
#pragma unroll
                for (int n = 0; n < 2; ++n) acc[a][b][m][n] = (f32x4){0.f, 0.f, 0.f, 0.f};
    bf16x8 At[4][2], B0[2][2], B1[2][2];
    const char* cA = (const char*)g.A + (size_t)cur.pm * tstep; const char* cB = (const char*)g.Bt + (size_t)cur.pn * tstep;
    S.a_ready(cur);
    if constexpr (SP2) {
        PG8_STAGE(PG8_SB(0, 0), cB, voffB); PG8_STAGE(PG8_SB(0, 1), cB + hstep, voffB); PG8_STAGE(PG8_SA(0, 0), cA, voffA); PG8_STAGE(PG8_SA(0, 1), cA + hstep, voffA);
        if (wr == 1) PG8_BAR;
        PG8_WAIT_V(2); PG8_BAR;
        PG8_STAGE(PG8_SB(1, 0), cB + kstep, voffB); PG8_STAGE(PG8_SA(1, 0), cA + kstep, voffA); PG8_STAGE(PG8_SB(1, 1), cB + hstep + kstep, voffB);
        PG8_WAIT_V(6); PG8_BAR;
    } else {
        PG8_STAGE(PG8_SB(0, 0), cB, voffB); PG8_STAGE(PG8_SA(0, 0), cA, voffA); PG8_STAGE(PG8_SB(0, 1), cB + hstep, voffB); PG8_STAGE(PG8_SA(0, 1), cA + hstep, voffA);
        if (wr == 1) PG8_BAR;
        PG8_WAIT_V(4); PG8_BAR;
        PG8_STAGE(PG8_SB(1, 0), cB + kstep, voffB); PG8_STAGE(PG8_SA(1, 0), cA + kstep, voffA); PG8_STAGE(PG8_SB(1, 1), cB + hstep + kstep, voffB);
        PG8_WAIT_V(6); PG8_BAR;
    }
    for (;;) {
        const bool has_next = S.next(ui + 1, nxt);
        const char* nA = has_next ? (const char*)g.A + (size_t)nxt.pm * tstep : cA; const char* nB = has_next ? (const char*)g.Bt + (size_t)nxt.pn * tstep : cB;
        for (int t = 0; t < nt; t += 2) {
            const bool last = (t == nt - 2);
            const char* a1 = cA + (size_t)(t + 1) * kstep;
            const char* a2 = last ? nA : cA + (size_t)(t + 2) * kstep; const char* b2 = last ? nB : cB + (size_t)(t + 2) * kstep;
            const char* a3 = a2 + kstep; const char* b3 = b2 + kstep;
            if (last && has_next) S.a_ready(nxt);
            if constexpr (SP2) {
            PG8_LDB(B0, 0, 0); PG8_LDB(B1, 0, 1); PG8_SCHED; PG8_LDA(At, 0, 0); PG8_STAGE(PG8_SA(1, 1), a1 + hstep, voffA);
            PG8_WAIT_V(8); PG8_WAIT_L(0); PG8_BAR; PG8_MMA(0, 0, At, B0); PG8_MMA(0, 1, At, B1); PG8_BAR; PG8_SCHED;
            PG8_LDA(At, 0, 1); PG8_STAGE(PG8_SB(0, 0), b2, voffB); PG8_STAGE(PG8_SB(0, 1), b2 + hstep, voffB); PG8_STAGE(PG8_SA(0, 0), a2, voffA);
            PG8_WAIT_V(8); PG8_WAIT_L(0); PG8_BAR; PG8_MMA(1, 0, At, B0); PG8_MMA(1, 1, At, B1); PG8_BAR; PG8_SCHED;
            PG8_LDB(B0, 1, 0); PG8_LDB(B1, 1, 1); PG8_SCHED; PG8_LDA(At, 1, 0); PG8_STAGE(PG8_SA(0, 1), a2 + hstep, voffA);
            PG8_WAIT_V(8); PG8_WAIT_L(0); PG8_BAR; PG8_MMA(0, 0, At, B0); PG8_MMA(0, 1, At, B1); PG8_BAR; PG8_SCHED;
            PG8_LDA(At, 1, 1); PG8_STAGE(PG8_SB(1, 0), b3, voffB); PG8_STAGE(PG8_SB(1, 1), b3 + hstep, voffB); PG8_STAGE(PG8_SA(1, 0), a3, voffA);
            PG8_WAIT_V(8); PG8_WAIT_L(0); PG8_BAR; PG8_MMA(1, 0, At, B0); PG8_MMA(1, 1, At, B1); PG8_BAR; PG8_SCHED;
            } else {
            PG8_LDB(B0, 0, 0); PG8_SCHED; PG8_LDA(At, 0, 0); PG8_STAGE(PG8_SA(1, 1), a1 + hstep, voffA);
            PG8_WAIT_L(8); PG8_BAR; PG8_WAIT_L(0); PG8_MMA(0, 0, At, B0); PG8_BAR; PG8_SCHED;
            PG8_LDB(B1, 0, 1); PG8_STAGE(PG8_SB(0, 0), b2, voffB);
            PG8_BAR; PG8_WAIT_L(0); PG8_MMA(0, 1, At, B1); PG8_BAR;
            PG8_LDA(At, 0, 1); PG8_STAGE(PG8_SA(0, 0), a2, voffA);
            PG8_BAR; PG8_WAIT_L(0); PG8_MMA(1, 0, At, B0); PG8_BAR; PG8_SCHED;
            PG8_STAGE(PG8_SB(0, 1), b2 + hstep, voffB);
            PG8_WAIT_V(6); PG8_BAR; PG8_MMA(1, 1, At, B1); PG8_BAR;
            PG8_LDB(B0, 1, 0); PG8_SCHED; PG8_LDA(At, 1, 0); PG8_STAGE(PG8_SA(0, 1), a2 + hstep, voffA);
            PG8_WAIT_L(8); PG8_BAR; PG8_WAIT_L(0); PG8_MMA(0, 0, At, B0); PG8_BAR; PG8_SCHED;
            PG8_LDB(B1, 1, 1); PG8_STAGE(PG8_SB(1, 0), b3, voffB);
            PG8_BAR; PG8_WAIT_L(0); PG8_MMA(0, 1, At, B1); PG8_BAR;
            PG8_LDA(At, 1, 1); PG8_STAGE(PG8_SA(1, 0), a3, voffA);
            PG8_BAR; PG8_WAIT_L(0); PG8_MMA(1, 0, At, B0); PG8_BAR; PG8_SCHED;
            PG8_STAGE(PG8_SB(1, 1), b3 + hstep, voffB);
            PG8_WAIT_V(6); PG8_BAR; PG8_MMA(1, 1, At, B1); PG8_BAR;
            }
        }
        if constexpr (ALIGN_EPI) { if (wr == 0) PG8_BAR; }
        if constexpr (!Epi::AFTER_DRAIN) { E(acc, cur, wr, wc, fr, fq); S.done(cur); }
        if (!has_next) break;
#pragma unroll
        for (int a = 0; a < 2; ++a)
#pragma unroll
            for (int b = 0; b < 2; ++b)
#pragma unroll
                for (int m = 0; m < 4; ++m)
#pragma unroll
                    for (int n = 0; n < 2; ++n) acc[a][b][m][n] = (f32x4){0.f, 0.f, 0.f, 0.f};
        cur = nxt; cA = nA; cB = nB; ++ui;
        if constexpr (ALIGN_EPI) { if (wr == 1) PG8_BAR; }
    }
    PG8_WAIT_V(0);
    if constexpr (!ALIGN_EPI) { if (wr == 0) PG8_BAR; }
    PG8_BAR;
    if constexpr (Epi::AFTER_DRAIN) { E.fused(acc, cur, wr, wc, fr, fq, lds, wid, lane); S.done(cur); }
#undef PG8_SA
#undef PG8_SB
#undef PG8_STAGE
#undef PG8_LDA
#undef PG8_LDB
#undef PG8_MMA
#undef PG8_WAIT_V
#undef PG8_WAIT_L
#undef PG8_BAR
#undef PG8_SCHED
}
}

constexpr int M = 8192, DM = 2048, SEQ = 2048, NPROJ = 4608, DPROJ_SRC = 4616, DFF = 5632, NGU = 11264, DPLE = 256, DEPTH = 4;
constexpr size_t SZ_WIN = (size_t)NPROJ * DM * 2, SZ_WOUT = (size_t)DM * DM * 2, SZ_WGU = (size_t)NGU * DM * 2, SZ_WDN = (size_t)DM * DFF * 2, SZ_WPG = SZ_WOUT, SZ_WPP = (size_t)DM * DPLE * 2;
constexpr size_t OFF_WIN = 0, OFF_WOUT = OFF_WIN + SZ_WIN, OFF_WGU = OFF_WOUT + SZ_WOUT, OFF_WDN = OFF_WGU + SZ_WGU, OFF_WPG = OFF_WDN + SZ_WDN, OFF_WPP = OFF_WPG + SZ_WPG, SZ_LAYER = OFF_WPP + SZ_WPP;
constexpr size_t WS_W = 1u << 20, WS_XN = WS_W + DEPTH * SZ_LAYER, WS_PROJ = WS_XN + (size_t)M * DM * 2, WS_MIX = WS_PROJ + (size_t)M * NPROJ * 2, WS_ACT = WS_MIX + (size_t)M * DM * 2,
                 WS_PP = WS_ACT + (size_t)M * DFF * 2, WS_PBF = WS_PP + (size_t)M * DM * 2, WS_LOGF = WS_PBF + (size_t)DEPTH * M * DPLE * 2, WS_CUM = WS_LOGF + (size_t)M * 8 * 4, WS_END = WS_CUM + (size_t)M * 8 * 4;
constexpr int LDS_BYTES = 147456;
constexpr float EPS = 1e-6f;

typedef unsigned short bf16;
typedef unsigned v4u __attribute__((ext_vector_type(4)));
typedef unsigned v2u __attribute__((ext_vector_type(2)));
typedef float f32x4 __attribute__((ext_vector_type(4)));
#define LAS __attribute__((address_space(3)))
#define LDS_WAIT() asm volatile("s_waitcnt lgkmcnt(0)" ::: "memory")
#define OPAQUE_TID() int tid; { int t_ = threadIdx.x; asm volatile("" : "+v"(t_)); tid = t_; } const int lane = tid & 63, wave = __builtin_amdgcn_readfirstlane(tid >> 6); (void)lane; (void)wave

__device__ __forceinline__ unsigned f2bf(float f) { unsigned u = __builtin_bit_cast(unsigned, f); return (u + 0x7fffu + ((u >> 16) & 1u)) >> 16; }
__device__ __forceinline__ unsigned pk2(float lo, float hi) { return f2bf(lo) | (f2bf(hi) << 16); }
__device__ __forceinline__ float bflo(unsigned w) { return __uint_as_float(w << 16); }
__device__ __forceinline__ float bfhi(unsigned w) { return __uint_as_float(w & 0xffff0000u); }
__device__ __forceinline__ float bf2f(bf16 v) { return __uint_as_float((unsigned)v << 16); }
__device__ __forceinline__ float wave_sum(float v) {
#pragma unroll
    for (int o = 1; o < 64; o <<= 1) v += __shfl_xor(v, o);
    return v;
}
__device__ __forceinline__ float gelu_tanh(float x) { const float y = 0.7978845608028654f * (x + 0.044715f * x * x * x); return 0.5f * x * (1.0f + tanhf(y)); }
__device__ __forceinline__ float log_sigmoid(float x) { return fminf(x, 0.f) - log1pf(expf(-fabsf(x))); }

struct Args { const float* in[20]; float* out; unsigned char* ws; };
enum { I_X = 0, I_P, I_NORM_MIX, I_W_IN, I_Q_NORM, I_K_NORM, I_FBIAS, I_GV_NORM, I_G_WS, I_G_BS, I_POOL_W, I_POOL_SCALE, I_W_OUT, I_NORM_FFN, I_W_GATE, I_W_UP, I_W_DOWN, I_NORM_PLE, I_W_PG, I_W_PP };

__device__ __forceinline__ void transpose_item(const float* W, int ldw, bf16* WT, int K, int k0, LAS float* scr, int lane) {
#pragma unroll 8
    for (int i = 0; i < 32; ++i) { const int kk = 2 * i + (lane >> 5); scr[kk * 33 + (lane & 31)] = W[(size_t)(k0 + kk) * ldw + (lane & 31)]; }
    LDS_WAIT(); asm volatile("" ::: "memory");
    const int c = lane & 7;
#pragma unroll
    for (int j = 0; j < 4; ++j) { const int n = (lane >> 3) + 8 * j; const LAS float* s = scr + (8 * c) * 33 + n;
        v4u o; o.x = pk2(s[0 * 33], s[1 * 33]); o.y = pk2(s[2 * 33], s[3 * 33]); o.z = pk2(s[4 * 33], s[5 * 33]); o.w = pk2(s[6 * 33], s[7 * 33]);
        *(v4u*)(WT + (size_t)n * K + k0 + 8 * c) = o; }
    LDS_WAIT(); asm volatile("" ::: "memory");
}

__device__ __forceinline__ void prologue_weights(const Args& a, LAS unsigned char* lds) {
    OPAQUE_TID();
    LAS float* scr = (LAS float*)(lds + wave * 16384);
    const int gw = blockIdx.x * 8 + wave, NGW = gridDim.x * 8;
    constexpr int I_IN = 32 * 144, I_OUT = 32 * 64, I_GU = 32 * 352, I_DN = 88 * 64, I_PG = 32 * 64, I_PPN = 4 * 64, I_L = I_IN + I_OUT + I_GU + I_DN + I_PG + I_PPN;
    for (int it = gw; it < DEPTH * I_L; it += NGW) {
        const int L = it / I_L; int r = it - L * I_L;
        unsigned char* wl = a.ws + WS_W + (size_t)L * SZ_LAYER;
        const float* src; int ldw, K, k0; bf16* dst;
        if (r < I_IN) { const int kb = r / 144, nb = r - kb * 144, n0 = nb * 32, c0 = n0 < 3072 ? n0 : n0 + 8;
            src = a.in[I_W_IN] + (size_t)L * DM * DPROJ_SRC + c0; ldw = DPROJ_SRC; K = DM; k0 = kb * 64; dst = (bf16*)(wl + OFF_WIN) + (size_t)n0 * DM; }
        else if ((r -= I_IN) < I_OUT) { const int kb = r / 64, nb = r - kb * 64, n0 = nb * 32;
            src = a.in[I_W_OUT] + (size_t)L * DM * DM + n0; ldw = DM; K = DM; k0 = kb * 64; dst = (bf16*)(wl + OFF_WOUT) + (size_t)n0 * DM; }
        else if ((r -= I_OUT) < I_GU) { const int kb = r / 352, nb = r - kb * 352, n0 = nb * 32, t = n0 >> 8, within = n0 & 255, half = within >> 7, j0 = within & 127;
            src = (half ? a.in[I_W_UP] : a.in[I_W_GATE]) + (size_t)L * DM * DFF + t * 128 + j0; ldw = DFF; K = DM; k0 = kb * 64; dst = (bf16*)(wl + OFF_WGU) + (size_t)n0 * DM; }
        else if ((r -= I_GU) < I_DN) { const int kb = r / 64, nb = r - kb * 64, n0 = nb * 32;
            src = a.in[I_W_DOWN] + (size_t)L * DFF * DM + n0; ldw = DM; K = DFF; k0 = kb * 64; dst = (bf16*)(wl + OFF_WDN) + (size_t)n0 * DFF; }
        else if ((r -= I_DN) < I_PG) { const int kb = r / 64, nb = r - kb * 64, n0 = nb * 32;
            src = a.in[I_W_PG] + (size_t)L * DM * DM + n0; ldw = DM; K = DM; k0 = kb * 64; dst = (bf16*)(wl + OFF_WPG) + (size_t)n0 * DM; }
        else { r -= I_PG; const int kb = r / 64, nb = r - kb * 64, n0 = nb * 32;
            src = a.in[I_W_PP] + (size_t)L * DPLE * DM + n0; ldw = DM; K = DPLE; k0 = kb * 64; dst = (bf16*)(wl + OFF_WPP) + (size_t)n0 * DPLE; }
        transpose_item(src, ldw, dst, K, k0, scr, lane);
    }
    { const size_t n8 = (size_t)DEPTH * M * DPLE / 8; const float* p = a.in[I_P]; bf16* pb = (bf16*)(a.ws + WS_PBF);
      for (size_t i = (size_t)blockIdx.x * 512 + tid; i < n8; i += (size_t)gridDim.x * 512) {
          const f32x4 x0 = *(const f32x4*)(p + i * 8), x1 = *(const f32x4*)(p + i * 8 + 4);
          v4u o; o.x = pk2(x0[0], x0[1]); o.y = pk2(x0[2], x0[3]); o.z = pk2(x1[0], x1[1]); o.w = pk2(x1[2], x1[3]);
          *(v4u*)(pb + i * 8) = o; } }
}

__device__ __forceinline__ void norm_phase(const float* h, const float* gain, bf16* xn, bool with_f, const float* win_l, const float* fbias, float* logf,
                                           unsigned char* lds) {
    OPAQUE_TID();
    float* wf = (float*)lds;
    if (with_f) {
        for (int c = tid; c < DM; c += 512) {
            const f32x4 x0 = *(const f32x4*)(win_l + (size_t)c * DPROJ_SRC + 3072), x1 = *(const f32x4*)(win_l + (size_t)c * DPROJ_SRC + 3076);
            wf[0 * DM + c] = x0[0]; wf[1 * DM + c] = x0[1]; wf[2 * DM + c] = x0[2]; wf[3 * DM + c] = x0[3];
            wf[4 * DM + c] = x1[0]; wf[5 * DM + c] = x1[1]; wf[6 * DM + c] = x1[2]; wf[7 * DM + c] = x1[3]; }
        __syncthreads();
    }
    const int gw = blockIdx.x * 8 + wave, NGW = gridDim.x * 8;
    f32x4 g[8];
#pragma unroll
    for (int j = 0; j < 8; ++j) g[j] = *(const f32x4*)(gain + 4 * lane + 256 * j);
    for (int row = gw; row < M; row += NGW) {
        const f32x4* xr = (const f32x4*)(h + (size_t)row * DM) + lane;
        f32x4 v[8]; float ss = 0.f;
#pragma unroll
        for (int j = 0; j < 8; ++j) { v[j] = xr[64 * j]; ss += (v[j][0] * v[j][0] + v[j][1] * v[j][1]) + (v[j][2] * v[j][2] + v[j][3] * v[j][3]); }
        ss = wave_sum(ss);
        const float rinv = 1.0f / sqrtf(ss * (1.0f / DM) + EPS);
        v2u* o8 = (v2u*)(xn + (size_t)row * DM) + lane;
#pragma unroll
        for (int j = 0; j < 8; ++j) { v[j] = v[j] * rinv * g[j]; v2u w; w.x = pk2(v[j][0], v[j][1]); w.y = pk2(v[j][2], v[j][3]); o8[64 * j] = w; }
        if (with_f) {
            float f[8];
#pragma unroll
            for (int hh = 0; hh < 8; ++hh) { float s = 0.f;
#pragma unroll
                for (int j = 0; j < 8; ++j) { const f32x4 w = *(const f32x4*)(wf + hh * DM + 4 * lane + 256 * j); s += (v[j][0] * w[0] + v[j][1] * w[1]) + (v[j][2] * w[2] + v[j][3] * w[3]); }
                f[hh] = wave_sum(s); asm volatile("" ::: "memory"); }
            float mine = f[0];
#pragma unroll
            for (int hh = 1; hh < 8; ++hh) mine = (lane == hh) ? f[hh] : mine;
            if (lane < 8) logf[(size_t)row * 8 + lane] = log_sigmoid(mine + fbias[lane]);
        }
    }
    if (with_f) __syncthreads();
}

__device__ __forceinline__ void post_phase(bf16* proj, const float* qg, const float* kg, const float* logf, float* cum) {
    OPAQUE_TID();
    const int gw = blockIdx.x * 8 + wave, NGW = gridDim.x * 8;
    const int d0 = 8 * (lane & 15);
    float gq[8], gk[8];
#pragma unroll
    for (int e = 0; e < 8; ++e) { gq[e] = qg[d0 + e]; gk[e] = kg[d0 + e]; }
    for (int row = gw; row < M; row += NGW) {
        v4u* pr = (v4u*)(proj + (size_t)row * NPROJ);
#pragma unroll
        for (int j = 0; j < 4; ++j) {
            const v4u w = pr[lane + 64 * j];
            float x[8] = {bflo(w.x), bfhi(w.x), bflo(w.y), bfhi(w.y), bflo(w.z), bfhi(w.z), bflo(w.w), bfhi(w.w)};
            float ss = 0.f;
#pragma unroll
            for (int e = 0; e < 8; ++e) ss += x[e] * x[e];
            ss += __shfl_xor(ss, 1); ss += __shfl_xor(ss, 2); ss += __shfl_xor(ss, 4); ss += __shfl_xor(ss, 8);
            const float rinv = 1.0f / sqrtf(ss * (1.0f / 128.0f) + EPS);
#pragma unroll
            for (int e = 0; e < 8; ++e) x[e] = x[e] * rinv * (j < 2 ? gq[e] : gk[e]);
            v4u o; o.x = pk2(x[0], x[1]); o.y = pk2(x[2], x[3]); o.z = pk2(x[4], x[5]); o.w = pk2(x[6], x[7]);
            pr[lane + 64 * j] = o;
        }
    }
    for (int bh = blockIdx.x; bh < 32; bh += gridDim.x) if (wave == 0) {
        const int b = bh >> 3, hh = bh & 7;
        float loc[32]; float run = 0.f;
#pragma unroll
        for (int i = 0; i < 32; ++i) { run += logf[((size_t)(b * SEQ + lane * 32 + i)) * 8 + hh]; loc[i] = run; }
        float inc = run;
#pragma unroll
        for (int o = 1; o < 64; o <<= 1) { const float t = __shfl_up(inc, o); if (lane >= o) inc += t; }
        const float excl = inc - run;
#pragma unroll
        for (int i = 0; i < 32; ++i) cum[(size_t)bh * SEQ + lane * 32 + i] = excl + loc[i];
    }
}

__device__ __forceinline__ void attn_naive(const bf16* proj, const float* cum, bf16* mix) {
    OPAQUE_TID();
    const int gw = blockIdx.x * 8 + wave, NGW = gridDim.x * 8;
    const int g = lane >> 4, li = lane & 15;
    const float SCALE = 0.08838834764831845f;
    for (int id = gw; id < 32 * SEQ; id += NGW) {
        const int bh = id / SEQ, tt = id - bh * SEQ, t = (bh & 1) ? (SEQ - 1 - tt) : tt;
        const int b = bh >> 3, hh = bh & 7;
        const v4u qw = *(const v4u*)(proj + (size_t)(b * SEQ + t) * NPROJ + hh * 128 + 8 * li);
        const float q[8] = {bflo(qw.x), bfhi(qw.x), bflo(qw.y), bfhi(qw.y), bflo(qw.z), bfhi(qw.z), bflo(qw.w), bfhi(qw.w)};
        const float* cb = cum + (size_t)bh * SEQ;
        const float ct = cb[t];
        float m = -1e30f, l = 0.f, o[8];
#pragma unroll
        for (int e = 0; e < 8; ++e) o[e] = 0.f;
        const bf16* kbase = proj + (size_t)(b * SEQ) * NPROJ + 1024 + hh * 128 + 8 * li;
        const bf16* vbase = kbase + 1024;
        for (int s0 = 0; s0 <= t; s0 += 4) {
            const int s = s0 + g; const bool valid = s <= t; const int sa = valid ? s : t;
            const v4u kw = *(const v4u*)(kbase + (size_t)sa * NPROJ);
            const v4u vw = *(const v4u*)(vbase + (size_t)sa * NPROJ);
            float d = (q[0] * bflo(kw.x) + q[1] * bfhi(kw.x)) + (q[2] * bflo(kw.y) + q[3] * bfhi(kw.y)) + (q[4] * bflo(kw.z) + q[5] * bfhi(kw.z)) + (q[6] * bflo(kw.w) + q[7] * bfhi(kw.w));
            d += __shfl_xor(d, 1); d += __shfl_xor(d, 2); d += __shfl_xor(d, 4); d += __shfl_xor(d, 8);
            const float sc = valid ? d * SCALE + (ct - cb[sa]) : -__builtin_inff();
            const float mn = fmaxf(m, sc), al = __expf(m - mn), p = __expf(sc - mn);
            l = l * al + p;
            const float v[8] = {bflo(vw.x), bfhi(vw.x), bflo(vw.y), bfhi(vw.y), bflo(vw.z), bfhi(vw.z), bflo(vw.w), bfhi(vw.w)};
#pragma unroll
            for (int e = 0; e < 8; ++e) o[e] = o[e] * al + p * v[e];
            m = mn;
        }
        float mall = fmaxf(m, __shfl_xor(m, 16)); mall = fmaxf(mall, __shfl_xor(mall, 32));
        const float w = __expf(m - mall);
        l *= w; l += __shfl_xor(l, 16); l += __shfl_xor(l, 32);
#pragma unroll
        for (int e = 0; e < 8; ++e) { o[e] *= w; o[e] += __shfl_xor(o[e], 16); o[e] += __shfl_xor(o[e], 32); }
        if (g == 0) { const float inv = 1.0f / l; v4u ow; ow.x = pk2(o[0] * inv, o[1] * inv); ow.y = pk2(o[2] * inv, o[3] * inv); ow.z = pk2(o[4] * inv, o[5] * inv); ow.w = pk2(o[6] * inv, o[7] * inv);
            *(v4u*)(mix + (size_t)(b * SEQ + t) * DM + hh * 128 + 8 * li) = ow; }
    }
}

__device__ __forceinline__ void gmlp_naive(const bf16* proj, const float* vgain, const float* wsp, const float* bs, bf16* mix, unsigned char* lds) {
    OPAQUE_TID();
    float* tile = (float*)lds;
    for (int item = blockIdx.x; item < 256; item += gridDim.x) {
        const int g = item & 3, n = (item >> 2) & 15, b = item >> 6;
        const size_t row0 = (size_t)b * SEQ + n * 128;
        for (int i = 0; i < 16; ++i) { const int s = wave * 16 + i;
            const unsigned w = *(const unsigned*)(proj + (row0 + s) * NPROJ + 3584 + g * 128 + 2 * lane);
            const float v0 = gelu_tanh(bflo(w)), v1 = gelu_tanh(bfhi(w));
            const float ss = wave_sum(v0 * v0 + v1 * v1); const float rinv = 1.0f / sqrtf(ss * (1.0f / 128.0f) + EPS);
            tile[s * 128 + 2 * lane] = v0 * rinv * vgain[g * 128 + 2 * lane]; tile[s * 128 + 2 * lane + 1] = v1 * rinv * vgain[g * 128 + 2 * lane + 1]; }
        __syncthreads();
        const int c = tid & 127, tq = tid >> 7;
        for (int i = 0; i < 32; ++i) { const int t = tq + 4 * i;
            const float* wr = wsp + (size_t)(g * 128 + t) * 128;
            float acc = 0.f;
            for (int s = 0; s <= t; ++s) acc += wr[s] * tile[s * 128 + c];
            const float mixed = acc + bs[g * 128 + t];
            const float u = bf2f(proj[(row0 + t) * NPROJ + 3072 + g * 128 + c]);
            mix[(row0 + t) * DM + 1024 + g * 128 + c] = (bf16)f2bf(gelu_tanh(u) * mixed); }
        __syncthreads();
    }
}

__device__ __forceinline__ void pool_naive(const bf16* proj, const float* pw, const float* pscale, bf16* mix, unsigned char* lds) {
    OPAQUE_TID();
    float* tile = (float*)lds;
    const int c = tid & 127, rq = tid >> 7;
    for (int item = blockIdx.x; item < 512; item += gridDim.x) {
        const int g = item & 3, tb = item >> 2; const size_t row0 = (size_t)tb * 64; const int sbase = (tb * 64) % SEQ; const size_t seq0 = row0 - sbase;
        const int win = 2 << g;
        for (int i = 0; i < 16; ++i) { const int r = rq + 4 * i, s = sbase + r; const int lo = (s + 1 - win) > 0 ? (s + 1 - win) : 0;
            float sum = 0.f;
            for (int j = lo; j <= s; ++j) sum += bf2f(proj[(seq0 + j) * NPROJ + 4096 + g * 128 + c]);
            const float xs = bf2f(proj[(seq0 + s) * NPROJ + 4096 + g * 128 + c]);
            tile[r * 128 + c] = sum / (float)(s + 1 - lo) - xs; }
        __syncthreads();
        float acc[16];
#pragma unroll
        for (int i = 0; i < 16; ++i) acc[i] = 0.f;
        const float* wg = pw + (size_t)g * 128 * 128;
        for (int cc = 0; cc < 128; ++cc) { const float w = wg[cc * 128 + c];
#pragma unroll
            for (int i = 0; i < 16; ++i) acc[i] += tile[(rq + 4 * i) * 128 + cc] * w; }
        const float sc = pscale[g * 128 + c];
#pragma unroll
        for (int i = 0; i < 16; ++i) mix[(row0 + rq + 4 * i) * DM + 1536 + g * 128 + c] = (bf16)f2bf(acc[i] * sc);
        __syncthreads();
    }
}

namespace fa {
constexpr int D = 128;
constexpr float THR = 8.f;
constexpr bool WSKIP = false;
constexpr int KVP = 4608, QP = 4608, OP = 2048;
constexpr float SCALE = 0.08838834764831845f;
constexpr int NW = 8, QBLK = 32, KVBLK = 64, QB = NW * QBLK;
constexpr int SHM_V = KVBLK * D * 2, SHM_K = KVBLK * D * 2;
constexpr int BIAS_OFF = 2 * SHM_V + 2 * SHM_K + NW * 64 * 4;
constexpr int Q_OFF = BIAS_OFF + 2048 * 4;
constexpr int FA_LDS_BYTES = Q_OFF + 8 * 8192;

typedef short bf16x8 __attribute__((ext_vector_type(8)));
typedef short s16x4 __attribute__((ext_vector_type(4)));
typedef float f32x16 __attribute__((ext_vector_type(16)));
typedef float f32x4 __attribute__((ext_vector_type(4)));
typedef unsigned u32x4 __attribute__((ext_vector_type(4)));
template <class A, class Bt> struct same_t { static constexpr bool v = false; };
template <class A> struct same_t<A, A> { static constexpr bool v = true; };

#define KSWZ(row, colB) ((row) * 256 + ((colB) ^ (((row) & 7) << 4)))
#define SBAR() __builtin_amdgcn_sched_barrier(0)
__device__ __forceinline__ int v_st(int k, int c) { const int kk = (k & ~0xC) | ((k & 4) << 1) | ((k & 8) >> 1); return ((kk >> 3) * 4 + (c >> 5)) * 512 + ((kk & 7) * 32 + (c & 31)) * 2; }
__device__ __forceinline__ int v_rd_base(int lane) { return ((lane & 3) << 3) | (((lane >> 2) & 3) << 6) | (((lane >> 4) & 1) << 5) | (((lane >> 5) & 1) << 8); }
constexpr int v_rd_off(int d0, int ks, int half) { return d0 * 512 + ks * 4096 + half * 2048; }
__device__ __forceinline__ int crow(int r, int hi) { return (r & 3) + 8 * (r >> 2) + 4 * hi; }
__device__ __forceinline__ unsigned cvtpk(float lo, float hi) {
    unsigned r; asm volatile("v_cvt_pk_bf16_f32 %0, %1, %2" : "=v"(r) : "v"(lo), "v"(hi)); return r;
}
__device__ __forceinline__ bf16x8 pack8(f32x4 a, f32x4 b) {
    u32x4 w = {cvtpk(a[0], a[1]), cvtpk(a[2], a[3]), cvtpk(b[0], b[1]), cvtpk(b[2], b[3])};
    return *reinterpret_cast<bf16x8*>(&w);
}
template <class T> __device__ __forceinline__ bf16x8 load8(const T* p) {
    if constexpr (same_t<T, float>::v) { return pack8(*(const f32x4*)p, *(const f32x4*)(p + 4)); }
    else { return *reinterpret_cast<const bf16x8*>(p); }
}
__device__ __forceinline__ void mask_tile(f32x16& p0, f32x16& p1, int dq, unsigned W) {
    const float NEG = -__builtin_inff();
#pragma unroll
    for (int r = 0; r < 16; ++r) {
        const int c = (r & 3) + 8 * (r >> 2);
        if ((unsigned)(dq - c) >= W) p0[r] = NEG;
        if ((unsigned)(dq - c - 32) >= W) p1[r] = NEG;
    }
}
__device__ __forceinline__ void partialSM(f32x16& p0, f32x16& p1, float& m_reg, float& mn, float& alpha) {
    float pmax = p0[0]; for (int r = 1; r < 16; ++r) pmax = fmaxf(pmax, p0[r]); for (int r = 0; r < 16; ++r) pmax = fmaxf(pmax, p1[r]);
    { auto rr = __builtin_amdgcn_permlane32_swap(__float_as_uint(pmax), __float_as_uint(pmax), false, false);
      pmax = fmaxf(__uint_as_float(rr[0]), __uint_as_float(rr[1])); }
    constexpr float C2 = 1.4426950408889634f * SCALE;
    if (__builtin_expect(__all((pmax - m_reg) * SCALE <= THR), 1)) { mn = m_reg; alpha = 1.f; }
    else { mn = fmaxf(m_reg, pmax); alpha = __builtin_amdgcn_exp2f((m_reg - mn) * C2); m_reg = mn; }
    const float mnL = -mn * C2;
    for (int r = 0; r < 16; ++r) p0[r] = fmaf(p0[r], C2, mnL); for (int r = 0; r < 16; ++r) p1[r] = fmaf(p1[r], C2, mnL);
    for (int r = 0; r < 16; ++r) p0[r] = __builtin_amdgcn_exp2f(p0[r]);
}
__device__ __forceinline__ void finishSM(f32x16& p0, f32x16& p1, float alpha, float& l_reg, bf16x8& pa0, bf16x8& pa1, bf16x8& pa2, bf16x8& pa3) {
    for (int r = 0; r < 16; ++r) p1[r] = __builtin_amdgcn_exp2f(p1[r]);
    float ps = 0; for (int r = 0; r < 16; ++r) ps += p0[r]; for (int r = 0; r < 16; ++r) ps += p1[r];
    { auto rr = __builtin_amdgcn_permlane32_swap(__float_as_uint(ps), __float_as_uint(ps), false, false);
      ps = __uint_as_float(rr[0]) + __uint_as_float(rr[1]); }
    l_reg = l_reg * alpha + ps;
#define PK4(P, B_, OUT) do { unsigned a0 = cvtpk(P[B_+0], P[B_+1]), a1 = cvtpk(P[B_+2], P[B_+3]);                          \
        unsigned b0 = cvtpk(P[B_+4], P[B_+5]), b1 = cvtpk(P[B_+6], P[B_+7]);                                             \
        auto r0 = __builtin_amdgcn_permlane32_swap(a0, b0, false, false); auto r1 = __builtin_amdgcn_permlane32_swap(a1, b1, false, false); \
        u32x4 w = {r0[0], r1[0], r0[1], r1[1]}; OUT = *reinterpret_cast<bf16x8*>(&w); } while (0)
    PK4(p0, 0, pa0); PK4(p0, 8, pa1); PK4(p1, 0, pa2); PK4(p1, 8, pa3);
#undef PK4
}
template <int KB, bool SK>
__device__ __forceinline__ void qkt(f32x16& p0, f32x16& p1, const char* K_lds, int r32, int hi, const char* Qw, bool act, const float* bt) {
    if (SK && !act) { const float NEG = -__builtin_inff();
#pragma unroll
        for (int r = 0; r < 16; ++r) { p0[r] = NEG; p1[r] = NEG; } return; }
#pragma unroll
    for (int g_ = 0; g_ < 4; ++g_) { const f32x4 b0_ = *(const f32x4*)(bt + 8 * g_), b1_ = *(const f32x4*)(bt + 32 + 8 * g_);
#pragma unroll
        for (int j_ = 0; j_ < 4; ++j_) { p0[4 * g_ + j_] = b0_[j_]; p1[4 * g_ + j_] = b1_[j_]; } }
    const char* kb[4];
#pragma unroll
    for (int dd = 0; dd < 4; ++dd) kb[dd] = K_lds + KB * SHM_K + KSWZ(r32, (dd * 16 + hi * 8) * 2);
#pragma unroll
    for (int d0 = 0; d0 < 8; ++d0) { const char* a = kb[d0 & 3] + (d0 >> 2) * 128;
        bf16x8 b0 = *reinterpret_cast<const bf16x8*>(a);
        bf16x8 b1 = *reinterpret_cast<const bf16x8*>(a + 32 * 256);
        const bf16x8 q_ = *reinterpret_cast<const bf16x8*>(Qw + KSWZ(r32, ((d0 & 3) * 16 + hi * 8) * 2) + (d0 >> 2) * 128);
        p0 = __builtin_amdgcn_mfma_f32_32x32x16_bf16(b0, q_, p0, 0, 0, 0);
        p1 = __builtin_amdgcn_mfma_f32_32x32x16_bf16(b1, q_, p1, 0, 0, 0); }
}
template <int VB, bool SK>
__device__ __forceinline__ void pv_tile(f32x16* o, int vb0, bf16x8 pa0, bf16x8 pa1, bf16x8 pa2, bf16x8 pa3, bool act) {
    if (SK && !act) return;
#define TRRD(dst, off) asm volatile("ds_read_b64_tr_b16 %0, %1 offset:%2" : "=&v"(dst) : "v"(vb0), "i"(off) : "memory")
#define PV_D0(d0) do { s16x4 l0, l1, l2, l3, h0, h1, h2, h3; constexpr int b_ = VB * SHM_V + v_rd_off(d0, 0, 0);     \
        TRRD(l0, b_); TRRD(h0, b_ + 2048); TRRD(l1, b_ + 4096); TRRD(h1, b_ + 6144); TRRD(l2, b_ + 8192); TRRD(h2, b_ + 10240); TRRD(l3, b_ + 12288); TRRD(h3, b_ + 14336); \
        asm volatile("s_waitcnt lgkmcnt(0)" ::: "memory"); SBAR();                 \
        o[d0] = __builtin_amdgcn_mfma_f32_32x32x16_bf16(pa0, (bf16x8){l0[0], l0[1], l0[2], l0[3], h0[0], h0[1], h0[2], h0[3]}, o[d0], 0, 0, 0);   \
        o[d0] = __builtin_amdgcn_mfma_f32_32x32x16_bf16(pa1, (bf16x8){l1[0], l1[1], l1[2], l1[3], h1[0], h1[1], h1[2], h1[3]}, o[d0], 0, 0, 0);   \
        o[d0] = __builtin_amdgcn_mfma_f32_32x32x16_bf16(pa2, (bf16x8){l2[0], l2[1], l2[2], l2[3], h2[0], h2[1], h2[2], h2[3]}, o[d0], 0, 0, 0);   \
        o[d0] = __builtin_amdgcn_mfma_f32_32x32x16_bf16(pa3, (bf16x8){l3[0], l3[1], l3[2], l3[3], h3[0], h3[1], h3[2], h3[3]}, o[d0], 0, 0, 0); } while (0)
    PV_D0(0); PV_D0(1); PV_D0(2); PV_D0(3);
#undef PV_D0
#undef TRRD
}

template <class TIn, class TOut> struct BlockRef { const TIn* Q; const TIn* K; const TIn* V; TOut* O; int P0; };
template <class TIn> struct Seam {
    bf16x8 st_v0, st_v1, st_k0, st_k1; f32x4 sf0, sf1, sf2, sf3;
    f32x4 tq[16];
};
__device__ __forceinline__ int swa_jlo(int P0, int W) { const int lowk = P0 - W + 1; return lowk > 0 ? lowk / KVBLK : 0; }
#define ROW(p, k0, rr) ((p) + (size_t)((k0) + (rr)) * KVP + sc)
#define VMW() asm volatile("s_waitcnt vmcnt(0)" ::: "memory")
#define VMWN(n) asm volatile("s_waitcnt vmcnt(%0)" :: "i"(n) : "memory")
#define SLOAD_H(Kp, Vp, k0) do { S.st_v0 = load8<TIn>(ROW(Vp, k0, sr)); S.st_v1 = load8<TIn>(ROW(Vp, k0, 32 + sr));              \
                         S.st_k0 = load8<TIn>(ROW(Kp, k0, sr)); S.st_k1 = load8<TIn>(ROW(Kp, k0, 32 + sr)); } while (0)
#define SWRITE_HK(bf) do { *(bf16x8*)(K_lds + (bf) * SHM_K + kws) = S.st_k0; *(bf16x8*)(K_lds + (bf) * SHM_K + kws + 32 * 256) = S.st_k1; } while (0)
#define SWRITE_HV(bf) do { *(bf16x8*)(V_lds + (bf) * SHM_V + vst0) = S.st_v0; *(bf16x8*)(V_lds + (bf) * SHM_V + vst1) = S.st_v1; } while (0)
#define SWRITE_H(bf) do { SWRITE_HV(bf); SWRITE_HK(bf); } while (0)
#define SLOAD_F(p, k0) do { S.sf0 = *(const f32x4*)ROW(p, k0, sr); S.sf1 = *(const f32x4*)(ROW(p, k0, sr) + 4);                \
                            S.sf2 = *(const f32x4*)ROW(p, k0, 32 + sr); S.sf3 = *(const f32x4*)(ROW(p, k0, 32 + sr) + 4); } while (0)
#define SWRITE_KF(bf) do { *(bf16x8*)(K_lds + (bf) * SHM_K + kws) = pack8(S.sf0, S.sf1); *(bf16x8*)(K_lds + (bf) * SHM_K + kws + 32 * 256) = pack8(S.sf2, S.sf3); } while (0)
#define SWRITE_VF(bf) do { *(bf16x8*)(V_lds + (bf) * SHM_V + vst0) = pack8(S.sf0, S.sf1); *(bf16x8*)(V_lds + (bf) * SHM_V + vst1) = pack8(S.sf2, S.sf3); } while (0)
template <class TIn, class TOut>
__device__ __forceinline__ void causal_swa_prime(const BlockRef<TIn, TOut>& cur, int W, char* lds, Seam<TIn>& S, int tid_in) {
    constexpr bool F32 = same_t<TIn, float>::v;
    const int tid = tid_in, wid = __builtin_amdgcn_readfirstlane(tid >> 6), lane = tid & 63, r32 = lane & 31, hi = lane >> 5;
    const int sr = tid >> 4, sc = (tid & 15) * 8, kws = KSWZ(sr, sc * 2); char* K_lds = lds + 2 * SHM_V;
    const int kb0 = swa_jlo(cur.P0, W) * KVBLK;
    { char* Qw_ = lds + Q_OFF + wid * 8192;
#pragma unroll
      for (int d0 = 0; d0 < 8; ++d0) *(bf16x8*)(Qw_ + KSWZ(r32, ((d0 & 3) * 16 + hi * 8) * 2) + (d0 >> 2) * 128) = load8<TIn>(cur.Q + (size_t)(wid * QBLK + r32) * QP + d0 * 16 + hi * 8); }
    if constexpr (F32) { SLOAD_F((const float*)cur.K, kb0); VMW(); SWRITE_KF(0); SBAR(); SLOAD_F((const float*)cur.V, kb0); }
    else { SLOAD_H(cur.K, cur.V, kb0); VMW(); SWRITE_HK(0); }
    __syncthreads();
}
template <class TIn, class TOut>
__device__ __forceinline__ void causal_swa_block(const BlockRef<TIn, TOut>& cur, const BlockRef<TIn, TOut>& nxt, int skv, int W, char* lds, Seam<TIn>& S, int tid_in) {
    constexpr bool F32 = same_t<TIn, float>::v;
    const int tid = tid_in, wid = __builtin_amdgcn_readfirstlane(tid >> 6), lane = tid & 63, r32 = lane & 31, hi = lane >> 5;
    const int j_lo = swa_jlo(cur.P0, W);
    int j_hi = (cur.P0 + QB - 1) / KVBLK + 1; if (j_hi > skv / KVBLK) j_hi = skv / KVBLK;
    const int NT = j_hi - j_lo;
    const int kbn = swa_jlo(nxt.P0, W) * KVBLK;
    const int qlo = cur.P0 + wid * QBLK, qm = qlo + r32 - 4 * hi;
    char* V_lds = lds; char* K_lds = lds + 2 * SHM_V;
    float* ws = (float*)(lds + 2 * SHM_V + 2 * SHM_K) + wid * 64; float* li_l = ws, * al_l = ws + 32;
    const float* bias_l = (const float*)(lds + BIAS_OFF) + 4 * hi;
    const char* Qw_lds = lds + Q_OFF + wid * 8192;
    float m_reg = -1e30f, l_reg = 0; f32x16 o[4] = {};
    const int sr = tid >> 4, sc = (tid & 15) * 8, vst0 = v_st(sr, sc), vst1 = v_st(32 + sr, sc), kws = KSWZ(sr, sc * 2);
    const int vb0 = (int)(uintptr_t)V_lds + v_rd_base(lane);
    const TIn* Kh = cur.K; const TIn* Vh = cur.V;
#define RESC(a) do { if (__any((a) < 1.f)) { if (hi == 0) al_l[r32] = (a); asm volatile("s_waitcnt lgkmcnt(0)" ::: "memory");              \
                     for (int d_ = 0; d_ < 4; ++d_) for (int r = 0; r < 16; ++r) o[d_][r] *= al_l[crow(r, hi)]; } } while (0)
#define KBASE(t) ((j_lo + (t)) * KVBLK)
#define ACT(t) (KBASE(t) <= qlo + QBLK - 1 && KBASE(t) + KVBLK - 1 >= qlo - W + 1)
#define MASKT(P0_, P1_, t) do { const int kb_ = KBASE(t); if ((!SK || ACT(t)) && (kb_ + KVBLK - 1 > qlo || kb_ <= qlo + QBLK - 1 - W)) mask_tile(P0_, P1_, qm - kb_, (unsigned)W); } while (0)
    constexpr int NQL = F32 ? 16 : 0;
    constexpr bool SK = WSKIP && !F32;
#define SEAM_K0() do { VMWN(NQL); if constexpr (F32) { SWRITE_KF(0); SBAR(); SLOAD_F((const float*)nxt.V, kbn); } else { SWRITE_HK(0); } SBAR(); } while (0)
    f32x16 pA0, pA1, pB0, pB1; float mnA, mnB, alA, alB; bf16x8 pa0, pa1, pa2, pa3;
    if constexpr (F32) { VMW(); SWRITE_VF(0); SBAR(); } else { SWRITE_HV(0); SBAR(); }
    if (NT > 1) { if constexpr (F32) SLOAD_F((const float*)Kh, KBASE(1)); else SLOAD_H(Kh, Vh, KBASE(1)); }
    SBAR(); qkt<0, SK>(pA0, pA1, K_lds, r32, hi, Qw_lds, ACT(0), bias_l + KBASE(0));
    if constexpr (F32) { if (NT > 1) { VMW(); SWRITE_KF(1); SBAR(); SLOAD_F((const float*)Vh, KBASE(1)); } }
    MASKT(pA0, pA1, 0); partialSM(pA0, pA1, m_reg, mnA, alA);
    if (NT > 1) { VMW(); if constexpr (F32) { SWRITE_VF(1); SBAR(); if (NT > 2) SLOAD_F((const float*)Kh, KBASE(2)); } else SWRITE_H(1); }
    __syncthreads();
#define HALF_STEP(PX0, PX1, mnX, alX, PY0, PY1, alY, t, KB, VB, SB) do {                                                      \
        SBAR(); qkt<KB, SK>(PX0, PX1, K_lds, r32, hi, Qw_lds, ACT(t), bias_l + KBASE(t));                                             \
        finishSM(PY0, PY1, alY, l_reg, pa0, pa1, pa2, pa3); SBAR();                                                           \
        if ((t) + 1 < NT) { if constexpr (F32) { VMW(); SWRITE_KF(SB); SBAR(); SLOAD_F((const float*)Vh, KBASE((t) + 1)); }  \
                            else { SLOAD_H(Kh, Vh, KBASE((t) + 1)); } SBAR(); }                                               \
        pv_tile<VB, SK>(o, vb0, pa0, pa1, pa2, pa3, ACT((t) - 1)); MASKT(PX0, PX1, (t)); partialSM(PX0, PX1, m_reg, mnX, alX);                                        \
        __syncthreads();                                                                                                      \
        if ((t) + 1 < NT) { VMW(); if constexpr (F32) { SWRITE_VF(SB); SBAR(); if ((t) + 2 < NT) SLOAD_F((const float*)Kh, KBASE((t) + 2)); } \
                            else { SWRITE_H(SB); } }                                                                          \
        RESC(alX); __syncthreads(); } while (0)
    for (int t = 1; t + 1 < NT; t += 2) {
        HALF_STEP(pB0, pB1, mnB, alB, pA0, pA1, alA, t, 1, 0, 0);
        HALF_STEP(pA0, pA1, mnA, alA, pB0, pB1, alB, t + 1, 0, 1, 1);
    }
    const bool even = (NT & 1) == 0;
    if (even) { SBAR(); qkt<1, SK>(pB0, pB1, K_lds, r32, hi, Qw_lds, ACT(NT - 1), bias_l + KBASE(NT - 1)); SBAR(); }
#define QROW(e) (nxt.Q + (size_t)(wid * QBLK + r32) * QP + ((e) >> 1) * 16 + hi * 8 + ((e) & 1) * 4)
    if constexpr (F32) { SLOAD_F((const float*)nxt.K, kbn); SBAR();
#pragma unroll
        for (int e = 0; e < 8; ++e) S.tq[e] = *(const f32x4*)QROW(e); }
    else { SLOAD_H(nxt.K, nxt.V, kbn); SBAR(); }
    SBAR();
    finishSM(pA0, pA1, alA, l_reg, pa0, pa1, pa2, pa3); SBAR();
    if constexpr (F32) {
#pragma unroll
        for (int e = 8; e < 16; ++e) S.tq[e] = *(const f32x4*)QROW(e); SBAR(); }
#undef QROW
    pv_tile<0, SK>(o, vb0, pa0, pa1, pa2, pa3, ACT(even ? NT - 2 : NT - 1));
    if (even) { MASKT(pB0, pB1, NT - 1); partialSM(pB0, pB1, m_reg, mnB, alB); __syncthreads(); RESC(alB);
        finishSM(pB0, pB1, alB, l_reg, pa0, pa1, pa2, pa3); SBAR(); pv_tile<1, SK>(o, vb0, pa0, pa1, pa2, pa3, ACT(NT - 1)); }
    SBAR(); SEAM_K0();
    if (hi == 0) li_l[r32] = l_reg; asm volatile("s_waitcnt lgkmcnt(0)" ::: "memory");
    float rli[16];
#pragma unroll
    for (int r = 0; r < 16; ++r) rli[r] = __builtin_amdgcn_rcpf(li_l[crow(r, hi)]);
    TOut* Ow = cur.O + (size_t)(wid * QBLK) * OP;
#pragma unroll
    for (int r = 0; r < 16; ++r) { const int orow = crow(r, hi);
#pragma unroll
        for (int d0 = 0; d0 < 4; ++d0) { const float v = o[d0][r] * rli[r];
            if constexpr (same_t<TOut, float>::v) { Ow[(size_t)orow * OP + d0 * 32 + r32] = v; }
            else { const float vn = __shfl_xor(v, 1);
                   if ((r32 & 1) == 0) *(unsigned*)(Ow + (size_t)orow * OP + d0 * 32 + r32) = cvtpk(v, vn); } } }
    if constexpr (F32) {
#pragma unroll
        for (int d0 = 0; d0 < 8; ++d0) (void)S.tq[2 * d0]; }
    __syncthreads();
#undef RESC
#undef KBASE
#undef ACT
#undef MASKT
#undef SEAM_K0
#undef HALF_STEP
}
#undef ROW
#undef VMW
#undef VMWN
#undef SLOAD_H
#undef SWRITE_HK
#undef SWRITE_HV
#undef SWRITE_H
#undef SLOAD_F
#undef SWRITE_KF
#undef SWRITE_VF

#undef KSWZ
#undef SBAR
}

__device__ __forceinline__ void attn_phase(const bf16* proj, const float* cum, bf16* mix, unsigned char* lds_) {
    OPAQUE_TID();
    char* lds = (char*)lds_;
    for (int item = blockIdx.x; item < 256; item += gridDim.x) {
        const int bh = (item & 7) * 4 + ((item >> 3) & 3), qb = 7 - (item >> 5);
        const int b = bh >> 3, hh = bh & 7;
        float* bias = (float*)(lds + fa::BIAS_OFF);
        const float* cb = cum + (size_t)bh * SEQ;
        const int nk = (qb + 1) * 256;
        for (int s = tid; s < nk; s += 512) bias[s] = -cb[s] * (1.0f / fa::SCALE);
        fa::BlockRef<bf16, bf16> cur;
        cur.Q = proj + (size_t)(b * SEQ + qb * 256) * NPROJ + hh * 128; cur.K = proj + (size_t)(b * SEQ) * NPROJ + 1024 + hh * 128; cur.V = cur.K + 1024;
        cur.O = mix + (size_t)(b * SEQ + qb * 256) * DM + hh * 128; cur.P0 = qb * 256;
        fa::Seam<bf16> S;
        fa::causal_swa_prime<bf16, bf16>(cur, SEQ, lds, S, tid);
        fa::causal_swa_block<bf16, bf16>(cur, cur, SEQ, SEQ, lds, S, tid);
    }
}

__global__ void __launch_bounds__(512, 2) fwd(Args a) {
    extern __shared__ __attribute__((aligned(16))) unsigned char lds[];
    cg::grid_group grid = cg::this_grid();
    unsigned char* ws = a.ws;
    bf16* XN = (bf16*)(ws + WS_XN); bf16* PROJ = (bf16*)(ws + WS_PROJ); bf16* MIX = (bf16*)(ws + WS_MIX); bf16* ACT = (bf16*)(ws + WS_ACT); bf16* PP = (bf16*)(ws + WS_PP);
    bf16* PBF = (bf16*)(ws + WS_PBF); float* LOGF = (float*)(ws + WS_LOGF); float* CUM = (float*)(ws + WS_CUM);
    float* H = a.out;
    PG8_LAS unsigned char* ring = (PG8_LAS unsigned char*)lds;
    const int G = gridDim.x, bx = blockIdx.x;

    prologue_weights(a, (LAS unsigned char*)lds);
    norm_phase(a.in[I_X], a.in[I_NORM_MIX], XN, true, a.in[I_W_IN], a.in[I_FBIAS], LOGF, lds);
    grid.sync();

#pragma unroll 1
    for (int L = 0; L < DEPTH; ++L) {
        unsigned char* wl = ws + WS_W + (size_t)L * SZ_LAYER;
        const bf16* Win = (const bf16*)(wl + OFF_WIN); const bf16* Wout = (const bf16*)(wl + OFF_WOUT); const bf16* Wgu = (const bf16*)(wl + OFF_WGU);
        const bf16* Wdn = (const bf16*)(wl + OFF_WDN); const bf16* Wpg = (const bf16*)(wl + OFF_WPG); const bf16* Wpp = (const bf16*)(wl + OFF_WPP);
        { pg8::Gemm g{XN, Win, M, NPROJ, DM}; pg8::StaticOrder S; S.init(M, NPROJ, G, bx);
          pg8::EpiBf16<0> E{PROJ, NPROJ, nullptr, 0, 0, 1.f};
          pg8::gemm_phase<pg8::EpiBf16<0>, pg8::StaticOrder, true, true>(ring, g, S, E); }
        { pg8::Gemm g{PBF + (size_t)L * M * DPLE, Wpp, M, DM, DPLE}; pg8::StaticOrder S; S.init(M, DM, G, bx);
          pg8::EpiBf16<0> E{PP, DM, nullptr, 0, 0, 1.f};
          pg8::gemm_phase<pg8::EpiBf16<0>, pg8::StaticOrder, true, true>(ring, g, S, E); }
        grid.sync();
        post_phase(PROJ, a.in[I_Q_NORM] + L * 128, a.in[I_K_NORM] + L * 128, LOGF, CUM);
        grid.sync();
        gmlp_naive(PROJ, a.in[I_GV_NORM] + L * 512, a.in[I_G_WS] + (size_t)L * 4 * 128 * 128, a.in[I_G_BS] + L * 512, MIX, lds);
        pool_naive(PROJ, a.in[I_POOL_W] + (size_t)L * 4 * 128 * 128, a.in[I_POOL_SCALE] + L * 512, MIX, lds);
        attn_phase(PROJ, CUM, MIX, lds);
        grid.sync();
        { pg8::Gemm g{MIX, Wout, M, DM, DM}; pg8::StaticOrder S; S.init(M, DM, G, bx);
          pg8::EpiRes E{L == 0 ? a.in[I_X] : H, H, DM};
          pg8::gemm_phase<pg8::EpiRes, pg8::StaticOrder, true, true>(ring, g, S, E); }
        grid.sync();
        norm_phase(H, a.in[I_NORM_FFN] + L * DM, XN, false, nullptr, nullptr, nullptr, lds);
        grid.sync();
        { pg8::Gemm g{XN, Wgu, M, NGU, DM}; pg8::StaticOrder S; S.init(M, NGU, G, bx);
          pg8::EpiSwiglu E{ACT, DFF};
          pg8::gemm_phase<pg8::EpiSwiglu, pg8::StaticOrder, true, true>(ring, g, S, E); }
        grid.sync();
        { pg8::Gemm g{ACT, Wdn, M, DM, DFF}; pg8::StaticOrder S; S.init(M, DM, G, bx);
          pg8::EpiRes E{H, H, DM};
          pg8::gemm_phase<pg8::EpiRes, pg8::StaticOrder, true, true>(ring, g, S, E); }
        grid.sync();
        norm_phase(H, a.in[I_NORM_PLE] + L * DM, XN, false, nullptr, nullptr, nullptr, lds);
        grid.sync();
        { pg8::Gemm g{XN, Wpg, M, DM, DM}; pg8::StaticOrder S; S.init(M, DM, G, bx);
          pg8::EpiPle E{H, H, PP, DM};
          pg8::gemm_phase<pg8::EpiPle, pg8::StaticOrder, true, true>(ring, g, S, E); }
        if (L + 1 < DEPTH) {
            grid.sync();
            norm_phase(H, a.in[I_NORM_MIX] + (L + 1) * DM, XN, true, a.in[I_W_IN] + (size_t)(L + 1) * DM * DPROJ_SRC, a.in[I_FBIAS] + (L + 1) * 8, LOGF, lds);
            grid.sync();
        }
    }
}

extern "C" void kernel_launch(void* const* d_in, const int* in_sizes, int n_in, void* d_out, int out_size, void* d_ws, size_t ws_size, hipStream_t stream) {
    static int grid = 0;
    if (grid == 0) {
        if (n_in != 20 || out_size != M * DM || ws_size < WS_END) { fprintf(stderr, "kernel_launch: unexpected shapes (n_in %d out %d ws %zu, need %zu)\n", n_in, out_size, ws_size, (size_t)WS_END); grid = -1; return; }
        int dev = 0, cus = 0, per_cu = 0;
        (void)hipGetDevice(&dev); (void)hipDeviceGetAttribute(&cus, hipDeviceAttributeMultiprocessorCount, dev);
        if (hipFuncSetAttribute((const void*)fwd, hipFuncAttributeMaxDynamicSharedMemorySize, LDS_BYTES) != hipSuccess) fprintf(stderr, "kernel_launch: hipFuncSetAttribute failed\n");
        if (hipOccupancyMaxActiveBlocksPerMultiprocessor(&per_cu, (const void*)fwd, 512, LDS_BYTES) != hipSuccess || per_cu < 1) { fprintf(stderr, "kernel_launch: occupancy query gave %d\n", per_cu); per_cu = 1; }
        (void)hipGetLastError();
        if (cus <= 0) cus = 256;
        grid = cus * per_cu;
    }
    if (grid < 0) return;
    Args a{};
    for (int i = 0; i < 20; ++i) a.in[i] = (const float*)d_in[i];
    a.out = (float*)d_out; a.ws = (unsigned char*)d_ws;
    void* args[] = {&a};
    hipError_t e = hipLaunchCooperativeKernel((void*)fwd, dim3(grid), dim3(512), args, LDS_BYTES, stream);
    if (e != hipSuccess) fprintf(stderr, "cooperative launch failed: %s (grid %d)\n", hipGetErrorString(e), grid);
}
```

```cpp
#include <hip/hip_runtime.h>
#include <hip/hip_cooperative_groups.h>
#include <cstdio>
#include <cstdint>
namespace cg = cooperative_groups;
#ifndef REP_PRO
#define REP_PRO 1
#define REP_A 1
#define REP_C 1
#define REP_ATT 1
#define REP_F 1
#define REP_N 1
#define REP_SYNC 1
#endif
namespace pg8 {
#define PG8_LAS __attribute__((address_space(3)))
typedef unsigned short bf16_t;
typedef short bf16x8 __attribute__((ext_vector_type(8)));
typedef float f32x4 __attribute__((ext_vector_type(4)));
typedef unsigned u32x4 __attribute__((ext_vector_type(4)));
constexpr int BM = 256, BK = 64, HALF = 128, HTB = HALF * BK * 2  , STAGE_BYTES = 8 * HTB, NXCD = 8, WGM = 8;

__host__ __device__ __forceinline__ int lds_byte(int r, int c) { const int st = (r >> 4) * 2 + (c >> 5), rr = r & 15, cc = c & 31, ob = rr * 64 + cc * 2; return st * 1024 + (ob ^ (((ob >> 9) & 1) << 5)); }
__host__ __device__ __forceinline__ void stage_rc(int b, int& R, int& C) { const int st = b / 1024, sb = b % 1024, swz = sb ^ (((sb >> 9) & 1) << 5); R = (st >> 1) * 16 + swz / 64; C = (st & 1) * 32 + (swz % 64) / 2; }
__host__ __device__ __forceinline__ int perm32(int rho) { const int n = rho >> 4, i = rho & 15; return 8 * (i >> 2) + 4 * n + (i & 3); }

struct Unit { int pm, pn; };
struct Gemm { const bf16_t* A; const bf16_t* Bt; int M, N, K; };

struct StaticOrder {
    int nM, nN, nwg, G, c;
    __host__ __device__ void init(int M, int N, int G_, int c_) { nM = M / BM; nN = N / BM; nwg = nM * nN; G = G_; c = c_; }
    __host__ __device__ bool next(int i, Unit& u) const {
        const long L = (long)i * G + c; if (L >= nwg) return false;
        int wgid = (int)L; { const int q = nwg / NXCD, r = nwg % NXCD, xcd = wgid % NXCD, off = wgid / NXCD; wgid = (xcd < r ? xcd * (q + 1) : r * (q + 1) + (xcd - r) * q) + off; }
        const int nig = WGM * nN, gid = wgid / nig, fm = gid * WGM, gsz = (nM - fm) < WGM ? (nM - fm) : WGM;
        u.pm = fm + ((wgid % nig) % gsz); u.pn = (wgid % nig) / gsz; return true;
    }
    __device__ __forceinline__ void a_ready(const Unit&) const {}
    __device__ __forceinline__ void done(const Unit&) const {}
};

__device__ __forceinline__ unsigned cvt_pk_bf16(float lo, float hi) { unsigned r; asm volatile("v_cvt_pk_bf16_f32 %0, %1, %2" : "=v"(r) : "v"(lo), "v"(hi)); return r; }
typedef float f32x2 __attribute__((ext_vector_type(2)));
__device__ __forceinline__ f32x2 gelu_pk(f32x2 v) {
    const f32x2 av = __builtin_elementwise_abs(v), d = av * 0.2316418882f + 1.0f;
    f32x2 t; t.x = __builtin_amdgcn_rcpf(d.x); t.y = __builtin_amdgcn_rcpf(d.y);
    f32x2 q = t * 0.5307027145f + (-0.7265760135f); q = q * t + 0.7107068705f; q = q * t + (-0.142248368f); q = q * t + 0.127414796f; q = q * t;
    const f32x2 s = (v * v) * (-0.72134752044f);
    f32x2 e; e.x = __builtin_amdgcn_exp2f(s.x); e.y = __builtin_amdgcn_exp2f(s.y);
    const f32x2 m = v * (q * e), r = v - m;
    f32x2 o; o.x = v.x < 0.f ? m.x : r.x; o.y = v.y < 0.f ? m.y : r.y; return o;
}

template <int ACT  > struct EpiBf16 {
    static constexpr bool PERM = true, AFTER_DRAIN = false; static_assert(ACT == 0 || ACT == 1, "EpiBf16: ACT is 0 (none) or 1 (gelu_pk)");
    bf16_t* O; int ldc; const float* bias; int split_cols; size_t split_stride; float scale0;
    __device__ __forceinline__ void operator()(const f32x4 (&acc)[2][2][4][2], const Unit& u, int wr, int wc, int fr, int fq) const {
        const int row0 = u.pm * BM + wr * 64 + fr; int colt = u.pn * BM; bf16_t* base = O;
        float sc = 1.f; if (split_cols) { const int t = colt / split_cols; base += (size_t)t * split_stride; colt -= t * split_cols; if (t == 0) sc = scale0; }
        const int col0 = colt + wc * 32 + 8 * fq, bcol0 = u.pn * BM + wc * 32 + 8 * fq;
        f32x4 bv[2][2];
#pragma unroll
        for (int bj = 0; bj < 2; ++bj)
#pragma unroll
            for (int n = 0; n < 2; ++n) bv[bj][n] = bias ? *(const f32x4*)(bias + bcol0 + bj * HALF + 4 * n) : (f32x4){0.f, 0.f, 0.f, 0.f};
#pragma unroll
        for (int ai = 0; ai < 2; ++ai)
#pragma unroll
            for (int m = 0; m < 4; ++m) { bf16_t* rowp = base + (size_t)(row0 + ai * HALF + m * 16) * ldc + col0;
#pragma unroll
                for (int bj = 0; bj < 2; ++bj) { f32x4 v0 = acc[ai][bj][m][0] + bv[bj][0], v1 = acc[ai][bj][m][1] + bv[bj][1];
                    if (ACT == 1) { f32x2 a = gelu_pk((f32x2){v0[0], v0[1]}), b = gelu_pk((f32x2){v0[2], v0[3]}), c = gelu_pk((f32x2){v1[0], v1[1]}), d = gelu_pk((f32x2){v1[2], v1[3]});
                        v0 = (f32x4){a.x, a.y, b.x, b.y}; v1 = (f32x4){c.x, c.y, d.x, d.y}; }
                    v0 = v0 * sc; v1 = v1 * sc; u32x4 w; w.x = cvt_pk_bf16(v0[0], v0[1]); w.y = cvt_pk_bf16(v0[2], v0[3]); w.z = cvt_pk_bf16(v1[0], v1[1]); w.w = cvt_pk_bf16(v1[2], v1[3]);
                    *(u32x4*)(rowp + bj * HALF) = w; } }
    }
};
typedef unsigned u32x2 __attribute__((ext_vector_type(2)));
__device__ __forceinline__ float bf_lo(unsigned w) { return __uint_as_float(w << 16); }
__device__ __forceinline__ float bf_hi(unsigned w) { return __uint_as_float(w & 0xffff0000u); }
__device__ __forceinline__ float sigmoidf_(float x) { return 1.0f / (1.0f + __expf(-x)); }
struct EpiRes {
    static constexpr bool PERM = false, AFTER_DRAIN = false;
    const float* base; float* out; int ldc;
    __device__ __forceinline__ void operator()(const f32x4 (&acc)[2][2][4][2], const Unit& u, int wr, int wc, int fr, int fq) const {
        const int col0 = u.pn * BM + wc * 32 + 4 * fq;
#pragma unroll
        for (int ai = 0; ai < 2; ++ai)
#pragma unroll
            for (int m = 0; m < 4; ++m) { const size_t off = (size_t)(u.pm * BM + ai * HALF + wr * 64 + m * 16 + fr) * ldc + col0;
#pragma unroll
                for (int bj = 0; bj < 2; ++bj)
#pragma unroll
                    for (int n = 0; n < 2; ++n) { const f32x4 bs = *(const f32x4*)(base + off + bj * HALF + n * 16); *(f32x4*)(out + off + bj * HALF + n * 16) = bs + acc[ai][bj][m][n]; }
                asm volatile("" ::: "memory"); }
    }
};
struct EpiPle {
    static constexpr bool PERM = false, AFTER_DRAIN = false;
    const float* base; float* out; const bf16_t* pp; int ldc;
    __device__ __forceinline__ void operator()(const f32x4 (&acc)[2][2][4][2], const Unit& u, int wr, int wc, int fr, int fq) const {
        const int col0 = u.pn * BM + wc * 32 + 4 * fq;
#pragma unroll
        for (int ai = 0; ai < 2; ++ai)
#pragma unroll
            for (int m = 0; m < 4; ++m) { const size_t off = (size_t)(u.pm * BM + ai * HALF + wr * 64 + m * 16 + fr) * ldc + col0;
#pragma unroll
                for (int bj = 0; bj < 2; ++bj)
#pragma unroll
                    for (int n = 0; n < 2; ++n) { const f32x4 bs = *(const f32x4*)(base + off + bj * HALF + n * 16); const u32x2 pw = *(const u32x2*)(pp + off + bj * HALF + n * 16);
                        const f32x4 a = acc[ai][bj][m][n]; f32x4 o;
                        o[0] = bs[0] + bf_lo(pw.x) * sigmoidf_(a[0]); o[1] = bs[1] + bf_hi(pw.x) * sigmoidf_(a[1]);
                        o[2] = bs[2] + bf_lo(pw.y) * sigmoidf_(a[2]); o[3] = bs[3] + bf_hi(pw.y) * sigmoidf_(a[3]);
                        *(f32x4*)(out + off + bj * HALF + n * 16) = o; }
                asm volatile("" ::: "memory"); }
    }
};
struct EpiSwiglu {
    static constexpr bool PERM = true, AFTER_DRAIN = false;
    bf16_t* O; int ldc;
    __device__ __forceinline__ void operator()(const f32x4 (&acc)[2][2][4][2], const Unit& u, int wr, int wc, int fr, int fq) const {
        const int col0 = u.pn * HALF + wc * 32 + 8 * fq;
#pragma unroll
        for (int ai = 0; ai < 2; ++ai)
#pragma unroll
            for (int m = 0; m < 4; ++m) { bf16_t* rowp = O + (size_t)(u.pm * BM + ai * HALF + wr * 64 + m * 16 + fr) * ldc + col0;
                float r[8];
#pragma unroll
                for (int n = 0; n < 2; ++n)
#pragma unroll
                    for (int j = 0; j < 4; ++j) { const float g = acc[ai][0][m][n][j], up = acc[ai][1][m][n][j]; r[n * 4 + j] = g * sigmoidf_(g) * up; }
                u32x4 w; w.x = cvt_pk_bf16(r[0], r[1]); w.y = cvt_pk_bf16(r[2], r[3]); w.z = cvt_pk_bf16(r[4], r[5]); w.w = cvt_pk_bf16(r[6], r[7]);
                *(u32x4*)rowp = w; asm volatile("" ::: "memory"); }
    }
};
template <class Epi, class Sched, bool ALIGN_EPI = false, bool SP2 = false>
__device__ __forceinline__ void gemm_phase(PG8_LAS unsigned char* lds, const Gemm g, const Sched& S, const Epi& E) {
    int tid_ = threadIdx.x; asm volatile("" : "+v"(tid_));
    const int tid = tid_, wid = __builtin_amdgcn_readfirstlane(tid >> 6), lane = tid & 63, wr = wid >> 2, wc = wid & 3, fr = lane & 15, fq = lane >> 4;
    const int K = g.K, nt = K / BK;
    unsigned voffA[2], voffB[2];
#pragma unroll
    for (int i = 0; i < 2; ++i) { int R, C; stage_rc(tid * 16 + i * 8192, R, C); const int Rb = Epi::PERM ? ((R & ~31) + perm32(R & 31)) : R;
        voffA[i] = (unsigned)(R * K + C) * 2u; voffB[i] = (unsigned)(Rb * K + C) * 2u; }
    const size_t kstep = (size_t)(BK * 2);
    const size_t hstep = (size_t)HALF * K * 2;
    const size_t tstep = 2 * hstep;
    const unsigned ldsw = (unsigned)wid * 1024u;
    const int aoff = lds_byte(wr * 64 + fr, fq * 8), boff = lds_byte(wc * 32 + fr, fq * 8);
#define PG8_SA(b, h) (((b) * 2 + (h)) * HTB)
#define PG8_SB(b, h) ((4 + (b) * 2 + (h)) * HTB)
#define PG8_STAGE(bufoff, gbase, voff) do { _Pragma("unroll") for (int _i = 0; _i < 2; ++_i) \
        __builtin_amdgcn_global_load_lds((const unsigned*)((const char*)(gbase) + (voff)[_i]), (PG8_LAS unsigned*)(lds + (bufoff) + ldsw + _i * 8192), 16, 0, 0); } while (0)
#define PG8_LDA(dst, b, h) do { _Pragma("unroll") for (int m = 0; m < 4; ++m) _Pragma("unroll") for (int k = 0; k < 2; ++k) dst[m][k] = *(const PG8_LAS bf16x8*)(lds + PG8_SA(b, h) + aoff + m * 2048 + k * 1024); } while (0)
#define PG8_LDB(dst, b, h) do { _Pragma("unroll") for (int n = 0; n < 2; ++n) _Pragma("unroll") for (int k = 0; k < 2; ++k) dst[n][k] = *(const PG8_LAS bf16x8*)(lds + PG8_SB(b, h) + boff + n * 2048 + k * 1024); } while (0)
#define PG8_MMA(ai, bj, At, Bt) do { __builtin_amdgcn_s_setprio(1); _Pragma("unroll") for (int m = 0; m < 4; ++m) _Pragma("unroll") for (int n = 0; n < 2; ++n) _Pragma("unroll") for (int k = 0; k < 2; ++k) \
        acc[ai][bj][m][n] = __builtin_amdgcn_mfma_f32_16x16x32_bf16(Bt[n][k], At[m][k], acc[ai][bj][m][n], 0, 0, 0); __builtin_amdgcn_s_setprio(0); } while (0)
#define PG8_WAIT_V(n) asm volatile("s_waitcnt vmcnt(" #n ")" ::: "memory")
#define PG8_WAIT_L(n) asm volatile("s_waitcnt lgkmcnt(" #n ")" ::: "memory")
#define PG8_BAR __builtin_amdgcn_s_barrier()
#define PG8_SCHED __builtin_amdgcn_sched_barrier(0)
    Unit cur, nxt; int ui = 0;
    if (!S.next(0, cur)) return;
    f32x4 acc[2][2][4][2];
#pragma unroll
    for (int a = 0; a < 2; ++a)
#pragma unroll
        for (int b = 0; b < 2; ++b)
#pragma unroll
            for (int m = 0; m < 4; ++m)
#pragma unroll
                for (int n = 0; n < 2; ++n) acc[a][b][m][n] = (f32x4){0.f, 0.f, 0.f, 0.f};
    bf16x8 At[4][2], B0[2][2], B1[2][2];
    const char* cA = (const char*)g.A + (size_t)cur.pm * tstep; const char* cB = (const char*)g.Bt + (size_t)cur.pn * tstep;
    S.a_ready(cur);
    if constexpr (SP2) {
        PG8_STAGE(PG8_SB(0, 0), cB, voffB); PG8_STAGE(PG8_SB(0, 1), cB + hstep, voffB); PG8_STAGE(PG8_SA(0, 0), cA, voffA); PG8_STAGE(PG8_SA(0, 1), cA + hstep, voffA);
        if (wr == 1) PG8_BAR;
        PG8_WAIT_V(2); PG8_BAR;
        PG8_STAGE(PG8_SB(1, 0), cB + kstep, voffB); PG8_STAGE(PG8_SA(1, 0), cA + kstep, voffA); PG8_STAGE(PG8_SB(1, 1), cB + hstep + kstep, voffB);
        PG8_WAIT_V(6); PG8_BAR;
    } else {
        PG8_STAGE(PG8_SB(0, 0), cB, voffB); PG8_STAGE(PG8_SA(0, 0), cA, voffA); PG8_STAGE(PG8_SB(0, 1), cB + hstep, voffB); PG8_STAGE(PG8_SA(0, 1), cA + hstep, voffA);
        if (wr == 1) PG8_BAR;
        PG8_WAIT_V(4); PG8_BAR;
        PG8_STAGE(PG8_SB(1, 0), cB + kstep, voffB); PG8_STAGE(PG8_SA(1, 0), cA + kstep, voffA); PG8_STAGE(PG8_SB(1, 1), cB + hstep + kstep, voffB);
        PG8_WAIT_V(6); PG8_BAR;
    }
    for (;;) {
        const bool has_next = S.next(ui + 1, nxt);
        const char* nA = has_next ? (const char*)g.A + (size_t)nxt.pm * tstep : cA; const char* nB = has_next ? (const char*)g.Bt + (size_t)nxt.pn * tstep : cB;
        for (int t = 0; t < nt; t += 2) {
            const bool last = (t == nt - 2);
            const char* a1 = cA + (size_t)(t + 1) * kstep;
            const char* a2 = last ? nA : cA + (size_t)(t + 2) * kstep; const char* b2 = last ? nB : cB + (size_t)(t + 2) * kstep;
            const char* a3 = a2 + kstep; const char* b3 = b2 + kstep;
            if (last && has_next) S.a_ready(nxt);
            if constexpr (SP2) {
            PG8_LDB(B0, 0, 0); PG8_LDB(B1, 0, 1); PG8_SCHED; PG8_LDA(At, 0, 0); PG8_STAGE(PG8_SA(1, 1), a1 + hstep, voffA);
            PG8_WAIT_V(8); PG8_WAIT_L(0); PG8_BAR; PG8_MMA(0, 0, At, B0); PG8_MMA(0, 1, At, B1); PG8_BAR; PG8_SCHED;
            PG8_LDA(At, 0, 1); PG8_STAGE(PG8_SB(0, 0), b2, voffB); PG8_STAGE(PG8_SB(0, 1), b2 + hstep, voffB); PG8_STAGE(PG8_SA(0, 0), a2, voffA);
            PG8_WAIT_V(8); PG8_WAIT_L(0); PG8_BAR; PG8_MMA(1, 0, At, B0); PG8_MMA(1, 1, At, B1); PG8_BAR; PG8_SCHED;
            PG8_LDB(B0, 1, 0); PG8_LDB(B1, 1, 1); PG8_SCHED; PG8_LDA(At, 1, 0); PG8_STAGE(PG8_SA(0, 1), a2 + hstep, voffA);
            PG8_WAIT_V(8); PG8_WAIT_L(0); PG8_BAR; PG8_MMA(0, 0, At, B0); PG8_MMA(0, 1, At, B1); PG8_BAR; PG8_SCHED;
            PG8_LDA(At, 1, 1); PG8_STAGE(PG8_SB(1, 0), b3, voffB); PG8_STAGE(PG8_SB(1, 1), b3 + hstep, voffB); PG8_STAGE(PG8_SA(1, 0), a3, voffA);
            PG8_WAIT_V(8); PG8_WAIT_L(0); PG8_BAR; PG8_MMA(1, 0, At, B0); PG8_MMA(1, 1, At, B1); PG8_BAR; PG8_SCHED;
            } else {
            PG8_LDB(B0, 0, 0); PG8_SCHED; PG8_LDA(At, 0, 0); PG8_STAGE(PG8_SA(1, 1), a1 + hstep, voffA);
            PG8_WAIT_L(8); PG8_BAR; PG8_WAIT_L(0); PG8_MMA(0, 0, At, B0); PG8_BAR; PG8_SCHED;
            PG8_LDB(B1, 0, 1); PG8_STAGE(PG8_SB(0, 0), b2, voffB);
            PG8_BAR; PG8_WAIT_L(0); PG8_MMA(0, 1, At, B1); PG8_BAR;
            PG8_LDA(At, 0, 1); PG8_STAGE(PG8_SA(0, 0), a2, voffA);
            PG8_BAR; PG8_WAIT_L(0); PG8_MMA(1, 0, At, B0); PG8_BAR; PG8_SCHED;
            PG8_STAGE(PG8_SB(0, 1), b2 + hstep, voffB);
            PG8_WAIT_V(6); PG8_BAR; PG8_MMA(1, 1, At, B1); PG8_BAR;
            PG8_LDB(B0, 1, 0); PG8_SCHED; PG8_LDA(At, 1, 0); PG8_STAGE(PG8_SA(0, 1), a2 + hstep, voffA);
            PG8_WAIT_L(8); PG8_BAR; PG8_WAIT_L(0); PG8_MMA(0, 0, At, B0); PG8_BAR; PG8_SCHED;
            PG8_LDB(B1, 1, 1); PG8_STAGE(PG8_SB(1, 0), b3, voffB);
            PG8_BAR; PG8_WAIT_L(0); PG8_MMA(0, 1, At, B1); PG8_BAR;
            PG8_LDA(At, 1, 1); PG8_STAGE(PG8_SA(1, 0), a3, voffA);
            PG8_BAR; PG8_WAIT_L(0); PG8_MMA(1, 0, At, B0); PG8_BAR; PG8_SCHED;
            PG8_STAGE(PG8_SB(1, 1), b3 + hstep, voffB);
            PG8_WAIT_V(6); PG8_BAR; PG8_MMA(1, 1, At, B1); PG8_BAR;
            }
        }
        if constexpr (ALIGN_EPI) { if (wr == 0) PG8_BAR; }
        if constexpr (!Epi::AFTER_DRAIN) { E(acc, cur, wr, wc, fr, fq); S.done(cur); }
        if (!has_next) break;
#pragma unroll
        for (int a = 0; a < 2; ++a)
#pragma unroll
            for (int b = 0; b < 2; ++b)
#pragma unroll
                for (int m = 0; m < 4; ++m)
#pragma unroll
                    for (int n = 0; n < 2; ++n) acc[a][b][m][n] = (f32x4){0.f, 0.f, 0.f, 0.f};
        cur = nxt; cA = nA; cB = nB; ++ui;
        if constexpr (ALIGN_EPI) { if (wr == 1) PG8_BAR; }
    }
    PG8_WAIT_V(0);
    if constexpr (!ALIGN_EPI) { if (wr == 0) PG8_BAR; }
    PG8_BAR;
    if constexpr (Epi::AFTER_DRAIN) { E.fused(acc, cur, wr, wc, fr, fq, lds, wid, lane); S.done(cur); }
#undef PG8_SA
#undef PG8_SB
#undef PG8_STAGE
#undef PG8_LDA
#undef PG8_LDB
#undef PG8_MMA
#undef PG8_WAIT_V
#undef PG8_WAIT_L
#undef PG8_BAR
#undef PG8_SCHED
}
}

constexpr int M = 8192, DM = 2048, SEQ = 2048, NPROJ = 4608, DPROJ_SRC = 4616, DFF = 5632, NGU = 11264, DPLE = 256, DEPTH = 4;
constexpr size_t SZ_WIN = (size_t)NPROJ * DM * 2, SZ_WOUT = (size_t)DM * DM * 2, SZ_WGU = (size_t)NGU * DM * 2, SZ_WDN = (size_t)DM * DFF * 2, SZ_WPG = SZ_WOUT, SZ_WPP = (size_t)DM * DPLE * 2;
constexpr size_t OFF_WIN = 0, OFF_WOUT = OFF_WIN + SZ_WIN, OFF_WGU = OFF_WOUT + SZ_WOUT, OFF_WDN = OFF_WGU + SZ_WGU, OFF_WPG = OFF_WDN + SZ_WDN, OFF_WPP = OFF_WPG + SZ_WPG, SZ_LAYER = OFF_WPP + SZ_WPP;
constexpr size_t WS_W = 1u << 20, WS_XN = WS_W + DEPTH * SZ_LAYER, WS_PROJ = WS_XN + (size_t)M * DM * 2, WS_MIX = WS_PROJ + (size_t)M * NPROJ * 2, WS_ACT = WS_MIX + (size_t)M * DM * 2,
                 WS_PP = WS_ACT + (size_t)M * DFF * 2, WS_PBF = WS_PP + (size_t)M * DM * 2, WS_LOGF = WS_PBF + (size_t)DEPTH * M * DPLE * 2, WS_CUM = WS_LOGF + (size_t)M * 8 * 4, WS_END = WS_CUM + (size_t)M * 8 * 4;
constexpr int LDS_BYTES = 147456;
constexpr float EPS = 1e-6f;

typedef unsigned short bf16;
typedef unsigned v4u __attribute__((ext_vector_type(4)));
typedef unsigned v2u __attribute__((ext_vector_type(2)));
typedef float f32x4 __attribute__((ext_vector_type(4)));
#define LAS __attribute__((address_space(3)))
#define LDS_WAIT() asm volatile("s_waitcnt lgkmcnt(0)" ::: "memory")
#define OPAQUE_TID() int tid; { int t_ = threadIdx.x; asm volatile("" : "+v"(t_)); tid = t_; } const int lane = tid & 63, wave = __builtin_amdgcn_readfirstlane(tid >> 6); (void)lane; (void)wave

__device__ __forceinline__ unsigned f2bf(float f) { unsigned u = __builtin_bit_cast(unsigned, f); return (u + 0x7fffu + ((u >> 16) & 1u)) >> 16; }
__device__ __forceinline__ unsigned pk2(float lo, float hi) { return f2bf(lo) | (f2bf(hi) << 16); }
__device__ __forceinline__ float bflo(unsigned w) { return __uint_as_float(w << 16); }
__device__ __forceinline__ float bfhi(unsigned w) { return __uint_as_float(w & 0xffff0000u); }
__device__ __forceinline__ float bf2f(bf16 v) { return __uint_as_float((unsigned)v << 16); }
__device__ __forceinline__ float wave_sum(float v) {
#pragma unroll
    for (int o = 1; o < 64; o <<= 1) v += __shfl_xor(v, o);
    return v;
}
__device__ __forceinline__ float gelu_tanh(float x) { const float y2 = 1.5957691216057308f * (x + 0.044715f * x * x * x); return x / (1.0f + __expf(-y2)); }
__device__ __forceinline__ float log_sigmoid(float x) { return fminf(x, 0.f) - __logf(1.0f + __expf(-fabsf(x))); }

__device__ __forceinline__ unsigned char* opq_ptr(unsigned char* p) { asm volatile("" : "+s"(p)); return p; }
struct Args { const float* in[20]; float* out; unsigned char* ws; };
enum { I_X = 0, I_P, I_NORM_MIX, I_W_IN, I_Q_NORM, I_K_NORM, I_FBIAS, I_GV_NORM, I_G_WS, I_G_BS, I_POOL_W, I_POOL_SCALE, I_W_OUT, I_NORM_FFN, I_W_GATE, I_W_UP, I_W_DOWN, I_NORM_PLE, I_W_PG, I_W_PP };

__device__ __forceinline__ void transpose_item(const float* W, int ldw, bf16* WT, int K, int k0, LAS float* scr, int lane) {
#pragma unroll 8
    for (int i = 0; i < 32; ++i) { const int kk = 2 * i + (lane >> 5); scr[kk * 33 + (lane & 31)] = W[(size_t)(k0 + kk) * ldw + (lane & 31)]; }
    LDS_WAIT(); asm volatile("" ::: "memory");
    const int c = lane & 7;
#pragma unroll
    for (int j = 0; j < 4; ++j) { const int n = (lane >> 3) + 8 * j; const LAS float* s = scr + (8 * c) * 33 + n;
        v4u o; o.x = pk2(s[0 * 33], s[1 * 33]); o.y = pk2(s[2 * 33], s[3 * 33]); o.z = pk2(s[4 * 33], s[5 * 33]); o.w = pk2(s[6 * 33], s[7 * 33]);
        *(v4u*)(WT + (size_t)n * K + k0 + 8 * c) = o; }
    LDS_WAIT(); asm volatile("" ::: "memory");
}

__device__ __forceinline__ void prologue_weights(const Args& a, LAS unsigned char* lds) {
    OPAQUE_TID();
    LAS float* scr = (LAS float*)(lds + wave * 16384);
    const int gw = blockIdx.x * 8 + wave, NGW = gridDim.x * 8;
    constexpr int I_IN = 32 * 144, I_OUT = 32 * 64, I_GU = 32 * 352, I_DN = 88 * 64, I_PG = 32 * 64, I_PPN = 4 * 64, I_L = I_IN + I_OUT + I_GU + I_DN + I_PG + I_PPN;
    for (int it = gw; it < DEPTH * I_L; it += NGW) {
        const int L = it / I_L; int r = it - L * I_L;
        unsigned char* wl = a.ws + WS_W + (size_t)L * SZ_LAYER;
        const float* src; int ldw, K, k0; bf16* dst;
        if (r < I_IN) { const int kb = r / 144, nb = r - kb * 144, n0 = nb * 32, c0 = n0 < 3072 ? n0 : n0 + 8;
            src = a.in[I_W_IN] + (size_t)L * DM * DPROJ_SRC + c0; ldw = DPROJ_SRC; K = DM; k0 = kb * 64; dst = (bf16*)(wl + OFF_WIN) + (size_t)n0 * DM; }
        else if ((r -= I_IN) < I_OUT) { const int kb = r / 64, nb = r - kb * 64, n0 = nb * 32;
            src = a.in[I_W_OUT] + (size_t)L * DM * DM + n0; ldw = DM; K = DM; k0 = kb * 64; dst = (bf16*)(wl + OFF_WOUT) + (size_t)n0 * DM; }
        else if ((r -= I_OUT) < I_GU) { const int kb = r / 352, nb = r - kb * 352, n0 = nb * 32, t = n0 >> 8, within = n0 & 255, half = within >> 7, j0 = within & 127;
            src = (half ? a.in[I_W_UP] : a.in[I_W_GATE]) + (size_t)L * DM * DFF + t * 128 + j0; ldw = DFF; K = DM; k0 = kb * 64; dst = (bf16*)(wl + OFF_WGU) + (size_t)n0 * DM; }
        else if ((r -= I_GU) < I_DN) { const int kb = r / 64, nb = r - kb * 64, n0 = nb * 32;
            src = a.in[I_W_DOWN] + (size_t)L * DFF * DM + n0; ldw = DM; K = DFF; k0 = kb * 64; dst = (bf16*)(wl + OFF_WDN) + (size_t)n0 * DFF; }
        else if ((r -= I_DN) < I_PG) { const int kb = r / 64, nb = r - kb * 64, n0 = nb * 32;
            src = a.in[I_W_PG] + (size_t)L * DM * DM + n0; ldw = DM; K = DM; k0 = kb * 64; dst = (bf16*)(wl + OFF_WPG) + (size_t)n0 * DM; }
        else { r -= I_PG; const int kb = r / 64, nb = r - kb * 64, n0 = nb * 32;
            src = a.in[I_W_PP] + (size_t)L * DPLE * DM + n0; ldw = DM; K = DPLE; k0 = kb * 64; dst = (bf16*)(wl + OFF_WPP) + (size_t)n0 * DPLE; }
        transpose_item(src, ldw, dst, K, k0, scr, lane);
    }
    { const size_t n8 = (size_t)DEPTH * M * DPLE / 8; const float* p = a.in[I_P]; bf16* pb = (bf16*)(a.ws + WS_PBF);
      for (size_t i = (size_t)blockIdx.x * 512 + tid; i < n8; i += (size_t)gridDim.x * 512) {
          const f32x4 x0 = *(const f32x4*)(p + i * 8), x1 = *(const f32x4*)(p + i * 8 + 4);
          v4u o; o.x = pk2(x0[0], x0[1]); o.y = pk2(x0[2], x0[3]); o.z = pk2(x1[0], x1[1]); o.w = pk2(x1[2], x1[3]);
          *(v4u*)(pb + i * 8) = o; } }
}

__device__ __forceinline__ void norm_phase(const float* h, const float* gain, bf16* xn, bool with_f, const float* win_l, const float* fbias, float* logf,
                                           unsigned char* lds) {
    OPAQUE_TID();
    float* wf = (float*)lds;
    if (with_f) {
        for (int c = tid; c < DM; c += 512) {
            const f32x4 x0 = *(const f32x4*)(win_l + (size_t)c * DPROJ_SRC + 3072), x1 = *(const f32x4*)(win_l + (size_t)c * DPROJ_SRC + 3076);
            wf[0 * DM + c] = x0[0]; wf[1 * DM + c] = x0[1]; wf[2 * DM + c] = x0[2]; wf[3 * DM + c] = x0[3];
            wf[4 * DM + c] = x1[0]; wf[5 * DM + c] = x1[1]; wf[6 * DM + c] = x1[2]; wf[7 * DM + c] = x1[3]; }
        __syncthreads();
    }
    const int gw = blockIdx.x * 8 + wave, NGW = gridDim.x * 8;
    f32x4 g[8];
#pragma unroll
    for (int j = 0; j < 8; ++j) g[j] = *(const f32x4*)(gain + 4 * lane + 256 * j);
    for (int row = gw; row < M; row += NGW) {
        const f32x4* xr = (const f32x4*)(h + (size_t)row * DM) + lane;
        f32x4 v[8]; float ss = 0.f;
#pragma unroll
        for (int j = 0; j < 8; ++j) { v[j] = xr[64 * j]; ss += (v[j][0] * v[j][0] + v[j][1] * v[j][1]) + (v[j][2] * v[j][2] + v[j][3] * v[j][3]); }
        ss = wave_sum(ss);
        const float rinv = 1.0f / sqrtf(ss * (1.0f / DM) + EPS);
        v2u* o8 = (v2u*)(xn + (size_t)row * DM) + lane;
#pragma unroll
        for (int j = 0; j < 8; ++j) { v[j] = v[j] * rinv * g[j]; v2u w; w.x = pk2(v[j][0], v[j][1]); w.y = pk2(v[j][2], v[j][3]); o8[64 * j] = w; }
        if (with_f) {
            float f[8];
#pragma unroll
            for (int hh = 0; hh < 8; ++hh) { float s = 0.f;
#pragma unroll
                for (int j = 0; j < 8; ++j) { const f32x4 w = *(const f32x4*)(wf + hh * DM + 4 * lane + 256 * j); s += (v[j][0] * w[0] + v[j][1] * w[1]) + (v[j][2] * w[2] + v[j][3] * w[3]); }
                f[hh] = wave_sum(s); asm volatile("" ::: "memory"); }
            float mine = f[0];
#pragma unroll
            for (int hh = 1; hh < 8; ++hh) mine = (lane == hh) ? f[hh] : mine;
            if (lane < 8) logf[(size_t)row * 8 + lane] = log_sigmoid(mine + fbias[lane]);
        }
    }
    if (with_f) __syncthreads();
}

__device__ __forceinline__ void post_phase(bf16* proj, const float* qg, const float* kg, const float* logf, float* cum) {
    OPAQUE_TID();
    const int gw = blockIdx.x * 8 + wave, NGW = gridDim.x * 8;
    const int d0 = 8 * (lane & 15);
    float gq[8], gk[8];
#pragma unroll
    for (int e = 0; e < 8; ++e) { gq[e] = qg[d0 + e]; gk[e] = kg[d0 + e]; }
    for (int row = gw; row < M; row += NGW) {
        v4u* pr = (v4u*)(proj + (size_t)row * NPROJ);
#pragma unroll
        for (int j = 0; j < 4; ++j) {
            const v4u w = pr[lane + 64 * j];
            float x[8] = {bflo(w.x), bfhi(w.x), bflo(w.y), bfhi(w.y), bflo(w.z), bfhi(w.z), bflo(w.w), bfhi(w.w)};
            float ss = 0.f;
#pragma unroll
            for (int e = 0; e < 8; ++e) ss += x[e] * x[e];
            ss += __shfl_xor(ss, 1); ss += __shfl_xor(ss, 2); ss += __shfl_xor(ss, 4); ss += __shfl_xor(ss, 8);
            const float rinv = 1.0f / sqrtf(ss * (1.0f / 128.0f) + EPS);
#pragma unroll
            for (int e = 0; e < 8; ++e) x[e] = x[e] * rinv * (j < 2 ? gq[e] : gk[e]);
            v4u o; o.x = pk2(x[0], x[1]); o.y = pk2(x[2], x[3]); o.z = pk2(x[4], x[5]); o.w = pk2(x[6], x[7]);
            pr[lane + 64 * j] = o;
        }
    }
    for (int bh = blockIdx.x; bh < 32; bh += gridDim.x) if (wave == 0) {
        const int b = bh >> 3, hh = bh & 7;
        float loc[32]; float run = 0.f;
#pragma unroll
        for (int i = 0; i < 32; ++i) { run += logf[((size_t)(b * SEQ + lane * 32 + i)) * 8 + hh]; loc[i] = run; }
        float inc = run;
#pragma unroll
        for (int o = 1; o < 64; o <<= 1) { const float t = __shfl_up(inc, o); if (lane >= o) inc += t; }
        const float excl = inc - run;
#pragma unroll
        for (int i = 0; i < 32; ++i) cum[(size_t)bh * SEQ + lane * 32 + i] = excl + loc[i];
    }
}

typedef short mm_bf16x8 __attribute__((ext_vector_type(8)));
constexpr int MXS = 136;

__device__ __forceinline__ void gmlp_mfma(const bf16* proj, const float* vgain, const float* wsp, const float* bs, bf16* mix, unsigned char* lds_) {
    bf16* Wl = (bf16*)lds_;
    bf16* Vt = (bf16*)lds_ + 128 * MXS;
    for (int item = blockIdx.x; item < 256; item += gridDim.x) {
        OPAQUE_TID();
        const int g = item & 3, n = (item >> 2) & 15, b = item >> 6;
        const size_t row0 = (size_t)b * SEQ + n * 128;
        { const float* wg = wsp + (size_t)g * 128 * 128;
#pragma unroll 4
          for (int i = 0; i < 8; ++i) { const int e = (i * 512 + tid) * 4, t = e >> 7, s = e & 127;
              const f32x4 w = *(const f32x4*)(wg + e);
              v2u o; o.x = pk2(s <= t ? w[0] : 0.f, s + 1 <= t ? w[1] : 0.f); o.y = pk2(s + 2 <= t ? w[2] : 0.f, s + 3 <= t ? w[3] : 0.f);
              *(v2u*)(Wl + t * MXS + s) = o; } }
        for (int i = 0; i < 16; ++i) { const int s = wave * 16 + i;
            const unsigned w = *(const unsigned*)(proj + (row0 + s) * NPROJ + 3584 + g * 128 + 2 * lane);
            const float v0 = gelu_tanh(bflo(w)), v1 = gelu_tanh(bfhi(w));
            const float ss = wave_sum(v0 * v0 + v1 * v1); const float rinv = 1.0f / sqrtf(ss * (1.0f / 128.0f) + EPS);
            Vt[(2 * lane) * MXS + s] = (bf16)f2bf(v0 * rinv * vgain[g * 128 + 2 * lane]); Vt[(2 * lane + 1) * MXS + s] = (bf16)f2bf(v1 * rinv * vgain[g * 128 + 2 * lane + 1]); }
        __syncthreads();
        { const int fr = lane & 15, fq = lane >> 4;
          f32x4 acc[8];
#pragma unroll
          for (int cb = 0; cb < 8; ++cb) acc[cb] = (f32x4){0.f, 0.f, 0.f, 0.f};
          const int nkc = (16 * (wave + 1) + 31) >> 5;
          for (int kc = 0; kc < nkc; ++kc) {
              const mm_bf16x8 af = *(const mm_bf16x8*)(Wl + (16 * wave + fr) * MXS + kc * 32 + fq * 8);
#pragma unroll
              for (int cb = 0; cb < 8; ++cb) { const mm_bf16x8 bf = *(const mm_bf16x8*)(Vt + (16 * cb + fr) * MXS + kc * 32 + fq * 8);
                  acc[cb] = __builtin_amdgcn_mfma_f32_16x16x32_bf16(bf, af, acc[cb], 0, 0, 0); } }
          const int t = 16 * wave + fr; const float bt = bs[g * 128 + t];
#pragma unroll
          for (int cb = 0; cb < 8; ++cb) { const int c = 16 * cb + 4 * fq;
              const v2u uw = *(const v2u*)(proj + (row0 + t) * NPROJ + 3072 + g * 128 + c);
              v2u o; o.x = pk2(gelu_tanh(bflo(uw.x)) * (acc[cb][0] + bt), gelu_tanh(bfhi(uw.x)) * (acc[cb][1] + bt));
              o.y = pk2(gelu_tanh(bflo(uw.y)) * (acc[cb][2] + bt), gelu_tanh(bfhi(uw.y)) * (acc[cb][3] + bt));
              *(v2u*)(mix + (row0 + t) * DM + 1024 + g * 128 + c) = o; } }
        __syncthreads();
    }
}

__device__ __forceinline__ void pool_mfma(const bf16* proj, const float* pw, const float* pscale, bf16* mix, unsigned char* lds_) {
    bf16* Wt = (bf16*)lds_;
    bf16* Dl = (bf16*)lds_ + 128 * MXS;
    for (int item = blockIdx.x; item < 256; item += gridDim.x) {
        OPAQUE_TID();
        const int g = item & 3, tb = item >> 2; const size_t row0 = (size_t)tb * 128; const int sbase = (tb * 128) % SEQ;
        const int win = 2 << g;
        { const float* wg = pw + (size_t)g * 128 * 128;
#pragma unroll 4
          for (int i = 0; i < 8; ++i) { const int e = (i * 512 + tid) * 4, c = e >> 7, dd = e & 127;
              const f32x4 w = *(const f32x4*)(wg + e);
              Wt[(dd + 0) * MXS + c] = (bf16)f2bf(w[0]); Wt[(dd + 1) * MXS + c] = (bf16)f2bf(w[1]); Wt[(dd + 2) * MXS + c] = (bf16)f2bf(w[2]); Wt[(dd + 3) * MXS + c] = (bf16)f2bf(w[3]); } }
        { const int r0 = wave * 16; const bf16* xp = proj + 4096 + g * 128 + 2 * lane;
          float x0[31], x1[31];
#pragma unroll
          for (int k = 0; k < 31; ++k) { const int r = r0 - 15 + k; unsigned w = 0u;
              if (sbase + r >= 0) w = *(const unsigned*)(xp + (size_t)((long)row0 + r) * NPROJ);
              x0[k] = bflo(w); x1[k] = bfhi(w); }
#pragma unroll
          for (int i = 0; i < 16; ++i) { const int k = i + 15, s = sbase + r0 + i;
              float s0 = 0.f, s1 = 0.f;
#pragma unroll
              for (int j = 0; j < 16; ++j) { if (j < win) { s0 += x0[k - j]; s1 += x1[k - j]; } }
              const int cnt = (s + 1 < win) ? (s + 1) : win; const float ic = 1.0f / (float)cnt;
              *(unsigned*)(Dl + (r0 + i) * MXS + 2 * lane) = pk2(s0 * ic - x0[k], s1 * ic - x1[k]); } }
        __syncthreads();
        { const int fr = lane & 15, fq = lane >> 4;
          f32x4 acc[8];
#pragma unroll
          for (int db = 0; db < 8; ++db) acc[db] = (f32x4){0.f, 0.f, 0.f, 0.f};
#pragma unroll
          for (int kc = 0; kc < 4; ++kc) {
              const mm_bf16x8 af = *(const mm_bf16x8*)(Dl + (16 * wave + fr) * MXS + kc * 32 + fq * 8);
#pragma unroll
              for (int db = 0; db < 8; ++db) { const mm_bf16x8 bf = *(const mm_bf16x8*)(Wt + (16 * db + fr) * MXS + kc * 32 + fq * 8);
                  acc[db] = __builtin_amdgcn_mfma_f32_16x16x32_bf16(bf, af, acc[db], 0, 0, 0); } }
          const int s = 16 * wave + fr;
#pragma unroll
          for (int db = 0; db < 8; ++db) { const int dd = 16 * db + 4 * fq; const f32x4 sc = *(const f32x4*)(pscale + g * 128 + dd);
              v2u o; o.x = pk2(acc[db][0] * sc[0], acc[db][1] * sc[1]); o.y = pk2(acc[db][2] * sc[2], acc[db][3] * sc[3]);
              *(v2u*)(mix + (row0 + s) * DM + 1536 + g * 128 + dd) = o; } }
        __syncthreads();
    }
}

namespace fa {
constexpr int D = 128;
constexpr float THR = 8.f;
constexpr bool WSKIP = false;
constexpr int KVP = 4608, QP = 4608, OP = 2048;
constexpr float SCALE = 0.08838834764831845f;
constexpr int NW = 8, QBLK = 32, KVBLK = 64, QB = NW * QBLK;
constexpr int SHM_V = KVBLK * D * 2, SHM_K = KVBLK * D * 2;
constexpr int BIAS_OFF = 2 * SHM_V + 2 * SHM_K + NW * 64 * 4;
constexpr int Q_OFF = BIAS_OFF + 2048 * 4;
constexpr int FA_LDS_BYTES = Q_OFF + 8 * 8192;

typedef short bf16x8 __attribute__((ext_vector_type(8)));
typedef short s16x4 __attribute__((ext_vector_type(4)));
typedef float f32x16 __attribute__((ext_vector_type(16)));
typedef float f32x4 __attribute__((ext_vector_type(4)));
typedef unsigned u32x4 __attribute__((ext_vector_type(4)));
template <class A, class Bt> struct same_t { static constexpr bool v = false; };
template <class A> struct same_t<A, A> { static constexpr bool v = true; };

#define KSWZ(row, colB) ((row) * 256 + ((colB) ^ (((row) & 7) << 4)))
#define SBAR() __builtin_amdgcn_sched_barrier(0)
__device__ __forceinline__ int v_st(int k, int c) { const int kk = (k & ~0xC) | ((k & 4) << 1) | ((k & 8) >> 1); return ((kk >> 3) * 4 + (c >> 5)) * 512 + ((kk & 7) * 32 + (c & 31)) * 2; }
__device__ __forceinline__ int v_rd_base(int lane) { return ((lane & 3) << 3) | (((lane >> 2) & 3) << 6) | (((lane >> 4) & 1) << 5) | (((lane >> 5) & 1) << 8); }
constexpr int v_rd_off(int d0, int ks, int half) { return d0 * 512 + ks * 4096 + half * 2048; }
__device__ __forceinline__ int crow(int r, int hi) { return (r & 3) + 8 * (r >> 2) + 4 * hi; }
__device__ __forceinline__ unsigned cvtpk(float lo, float hi) {
    unsigned r; asm volatile("v_cvt_pk_bf16_f32 %0, %1, %2" : "=v"(r) : "v"(lo), "v"(hi)); return r;
}
__device__ __forceinline__ bf16x8 pack8(f32x4 a, f32x4 b) {
    u32x4 w = {cvtpk(a[0], a[1]), cvtpk(a[2], a[3]), cvtpk(b[0], b[1]), cvtpk(b[2], b[3])};
    return *reinterpret_cast<bf16x8*>(&w);
}
template <class T> __device__ __forceinline__ bf16x8 load8(const T* p) {
    if constexpr (same_t<T, float>::v) { return pack8(*(const f32x4*)p, *(const f32x4*)(p + 4)); }
    else { return *reinterpret_cast<const bf16x8*>(p); }
}
__device__ __forceinline__ void mask_tile(f32x16& p0, f32x16& p1, int dq, unsigned W) {
    const float NEG = -__builtin_inff();
#pragma unroll
    for (int r = 0; r < 16; ++r) {
        const int c = (r & 3) + 8 * (r >> 2);
        if ((unsigned)(dq - c) >= W) p0[r] = NEG;
        if ((unsigned)(dq - c - 32) >= W) p1[r] = NEG;
    }
}
__device__ __forceinline__ void partialSM(f32x16& p0, f32x16& p1, float& m_reg, float& mn, float& alpha) {
    float pmax = p0[0]; for (int r = 1; r < 16; ++r) pmax = fmaxf(pmax, p0[r]); for (int r = 0; r < 16; ++r) pmax = fmaxf(pmax, p1[r]);
    { auto rr = __builtin_amdgcn_permlane32_swap(__float_as_uint(pmax), __float_as_uint(pmax), false, false);
      pmax = fmaxf(__uint_as_float(rr[0]), __uint_as_float(rr[1])); }
    constexpr float C2 = 1.4426950408889634f * SCALE;
    if (__builtin_expect(__all((pmax - m_reg) * SCALE <= THR), 1)) { mn = m_reg; alpha = 1.f; }
    else { mn = fmaxf(m_reg, pmax); alpha = __builtin_amdgcn_exp2f((m_reg - mn) * C2); m_reg = mn; }
    const float mnL = -mn * C2;
    for (int r = 0; r < 16; ++r) p0[r] = fmaf(p0[r], C2, mnL); for (int r = 0; r < 16; ++r) p1[r] = fmaf(p1[r], C2, mnL);
    for (int r = 0; r < 16; ++r) p0[r] = __builtin_amdgcn_exp2f(p0[r]);
}
__device__ __forceinline__ void finishSM(f32x16& p0, f32x16& p1, float alpha, float& l_reg, bf16x8& pa0, bf16x8& pa1, bf16x8& pa2, bf16x8& pa3) {
    for (int r = 0; r < 16; ++r) p1[r] = __builtin_amdgcn_exp2f(p1[r]);
    float ps = 0; for (int r = 0; r < 16; ++r) ps += p0[r]; for (int r = 0; r < 16; ++r) ps += p1[r];
    { auto rr = __builtin_amdgcn_permlane32_swap(__float_as_uint(ps), __float_as_uint(ps), false, false);
      ps = __uint_as_float(rr[0]) + __uint_as_float(rr[1]); }
    l_reg = l_reg * alpha + ps;
#define PK4(P, B_, OUT) do { unsigned a0 = cvtpk(P[B_+0], P[B_+1]), a1 = cvtpk(P[B_+2], P[B_+3]);                          \
        unsigned b0 = cvtpk(P[B_+4], P[B_+5]), b1 = cvtpk(P[B_+6], P[B_+7]);                                             \
        auto r0 = __builtin_amdgcn_permlane32_swap(a0, b0, false, false); auto r1 = __builtin_amdgcn_permlane32_swap(a1, b1, false, false); \
        u32x4 w = {r0[0], r1[0], r0[1], r1[1]}; OUT = *reinterpret_cast<bf16x8*>(&w); } while (0)
    PK4(p0, 0, pa0); PK4(p0, 8, pa1); PK4(p1, 0, pa2); PK4(p1, 8, pa3);
#undef PK4
}
template <int KB, bool SK>
__device__ __forceinline__ void qkt(f32x16& p0, f32x16& p1, const char* K_lds, int r32, int hi, const char* Qw, bool act, const float* bt) {
    if (SK && !act) { const float NEG = -__builtin_inff();
#pragma unroll
        for (int r = 0; r < 16; ++r) { p0[r] = NEG; p1[r] = NEG; } return; }
#pragma unroll
    for (int g_ = 0; g_ < 4; ++g_) { const f32x4 b0_ = *(const f32x4*)(bt + 8 * g_), b1_ = *(const f32x4*)(bt + 32 + 8 * g_);
#pragma unroll
        for (int j_ = 0; j_ < 4; ++j_) { p0[4 * g_ + j_] = b0_[j_]; p1[4 * g_ + j_] = b1_[j_]; } }
    const char* kb[4];
#pragma unroll
    for (int dd = 0; dd < 4; ++dd) kb[dd] = K_lds + KB * SHM_K + KSWZ(r32, (dd * 16 + hi * 8) * 2);
#pragma unroll
    for (int d0 = 0; d0 < 8; ++d0) { const char* a = kb[d0 & 3] + (d0 >> 2) * 128;
        bf16x8 b0 = *reinterpret_cast<const bf16x8*>(a);
        bf16x8 b1 = *reinterpret_cast<const bf16x8*>(a + 32 * 256);
        const bf16x8 q_ = *reinterpret_cast<const bf16x8*>(Qw + KSWZ(r32, ((d0 & 3) * 16 + hi * 8) * 2) + (d0 >> 2) * 128);
        p0 = __builtin_amdgcn_mfma_f32_32x32x16_bf16(b0, q_, p0, 0, 0, 0);
        p1 = __builtin_amdgcn_mfma_f32_32x32x16_bf16(b1, q_, p1, 0, 0, 0); }
}
template <int VB, bool SK>
__device__ __forceinline__ void pv_tile(f32x16* o, int vb0, bf16x8 pa0, bf16x8 pa1, bf16x8 pa2, bf16x8 pa3, bool act) {
    if (SK && !act) return;
#define TRRD(dst, off) asm volatile("ds_read_b64_tr_b16 %0, %1 offset:%2" : "=&v"(dst) : "v"(vb0), "i"(off) : "memory")
#define PV_D0(d0) do { s16x4 l0, l1, l2, l3, h0, h1, h2, h3; constexpr int b_ = VB * SHM_V + v_rd_off(d0, 0, 0);     \
        TRRD(l0, b_); TRRD(h0, b_ + 2048); TRRD(l1, b_ + 4096); TRRD(h1, b_ + 6144); TRRD(l2, b_ + 8192); TRRD(h2, b_ + 10240); TRRD(l3, b_ + 12288); TRRD(h3, b_ + 14336); \
        asm volatile("s_waitcnt lgkmcnt(0)" ::: "memory"); SBAR();                 \
        o[d0] = __builtin_amdgcn_mfma_f32_32x32x16_bf16(pa0, (bf16x8){l0[0], l0[1], l0[2], l0[3], h0[0], h0[1], h0[2], h0[3]}, o[d0], 0, 0, 0);   \
        o[d0] = __builtin_amdgcn_mfma_f32_32x32x16_bf16(pa1, (bf16x8){l1[0], l1[1], l1[2], l1[3], h1[0], h1[1], h1[2], h1[3]}, o[d0], 0, 0, 0);   \
        o[d0] = __builtin_amdgcn_mfma_f32_32x32x16_bf16(pa2, (bf16x8){l2[0], l2[1], l2[2], l2[3], h2[0], h2[1], h2[2], h2[3]}, o[d0], 0, 0, 0);   \
        o[d0] = __builtin_amdgcn_mfma_f32_32x32x16_bf16(pa3, (bf16x8){l3[0], l3[1], l3[2], l3[3], h3[0], h3[1], h3[2], h3[3]}, o[d0], 0, 0, 0); } while (0)
    PV_D0(0); PV_D0(1); PV_D0(2); PV_D0(3);
#undef PV_D0
#undef TRRD
}

template <class TIn, class TOut> struct BlockRef { const TIn* Q; const TIn* K; const TIn* V; TOut* O; int P0; };
template <class TIn> struct Seam {
    bf16x8 st_v0, st_v1, st_k0, st_k1; f32x4 sf0, sf1, sf2, sf3;
    f32x4 tq[16];
};
__device__ __forceinline__ int swa_jlo(int P0, int W) { const int lowk = P0 - W + 1; return lowk > 0 ? lowk / KVBLK : 0; }
#define ROW(p, k0, rr) ((p) + (size_t)((k0) + (rr)) * KVP + sc)
#define VMW() asm volatile("s_waitcnt vmcnt(0)" ::: "memory")
#define VMWN(n) asm volatile("s_waitcnt vmcnt(%0)" :: "i"(n) : "memory")
#define SLOAD_H(Kp, Vp, k0) do { S.st_v0 = load8<TIn>(ROW(Vp, k0, sr)); S.st_v1 = load8<TIn>(ROW(Vp, k0, 32 + sr));              \
                         S.st_k0 = load8<TIn>(ROW(Kp, k0, sr)); S.st_k1 = load8<TIn>(ROW(Kp, k0, 32 + sr)); } while (0)
#define SWRITE_HK(bf) do { *(bf16x8*)(K_lds + (bf) * SHM_K + kws) = S.st_k0; *(bf16x8*)(K_lds + (bf) * SHM_K + kws + 32 * 256) = S.st_k1; } while (0)
#define SWRITE_HV(bf) do { *(bf16x8*)(V_lds + (bf) * SHM_V + vst0) = S.st_v0; *(bf16x8*)(V_lds + (bf) * SHM_V + vst1) = S.st_v1; } while (0)
#define SWRITE_H(bf) do { SWRITE_HV(bf); SWRITE_HK(bf); } while (0)
#define SLOAD_F(p, k0) do { S.sf0 = *(const f32x4*)ROW(p, k0, sr); S.sf1 = *(const f32x4*)(ROW(p, k0, sr) + 4);                \
                            S.sf2 = *(const f32x4*)ROW(p, k0, 32 + sr); S.sf3 = *(const f32x4*)(ROW(p, k0, 32 + sr) + 4); } while (0)
#define SWRITE_KF(bf) do { *(bf16x8*)(K_lds + (bf) * SHM_K + kws) = pack8(S.sf0, S.sf1); *(bf16x8*)(K_lds + (bf) * SHM_K + kws + 32 * 256) = pack8(S.sf2, S.sf3); } while (0)
#define SWRITE_VF(bf) do { *(bf16x8*)(V_lds + (bf) * SHM_V + vst0) = pack8(S.sf0, S.sf1); *(bf16x8*)(V_lds + (bf) * SHM_V + vst1) = pack8(S.sf2, S.sf3); } while (0)
template <class TIn, class TOut>
__device__ __forceinline__ void causal_swa_prime(const BlockRef<TIn, TOut>& cur, int W, char* lds, Seam<TIn>& S, int tid_in) {
    constexpr bool F32 = same_t<TIn, float>::v;
    const int tid = tid_in, wid = __builtin_amdgcn_readfirstlane(tid >> 6), lane = tid & 63, r32 = lane & 31, hi = lane >> 5;
    const int sr = tid >> 4, sc = (tid & 15) * 8, kws = KSWZ(sr, sc * 2); char* K_lds = lds + 2 * SHM_V;
    const int kb0 = swa_jlo(cur.P0, W) * KVBLK;
    { char* Qw_ = lds + Q_OFF + wid * 8192;
#pragma unroll
      for (int d0 = 0; d0 < 8; ++d0) *(bf16x8*)(Qw_ + KSWZ(r32, ((d0 & 3) * 16 + hi * 8) * 2) + (d0 >> 2) * 128) = load8<TIn>(cur.Q + (size_t)(wid * QBLK + r32) * QP + d0 * 16 + hi * 8); }
    if constexpr (F32) { SLOAD_F((const float*)cur.K, kb0); VMW(); SWRITE_KF(0); SBAR(); SLOAD_F((const float*)cur.V, kb0); }
    else { SLOAD_H(cur.K, cur.V, kb0); VMW(); SWRITE_HK(0); }
    __syncthreads();
}
template <class TIn, class TOut>
__device__ __forceinline__ void causal_swa_block(const BlockRef<TIn, TOut>& cur, const BlockRef<TIn, TOut>& nxt, int skv, int W, char* lds, Seam<TIn>& S, int tid_in) {
    constexpr bool F32 = same_t<TIn, float>::v;
    const int tid = tid_in, wid = __builtin_amdgcn_readfirstlane(tid >> 6), lane = tid & 63, r32 = lane & 31, hi = lane >> 5;
    const int j_lo = swa_jlo(cur.P0, W);
    int j_hi = (cur.P0 + QB - 1) / KVBLK + 1; if (j_hi > skv / KVBLK) j_hi = skv / KVBLK;
    const int NT = j_hi - j_lo;
    const int kbn = swa_jlo(nxt.P0, W) * KVBLK;
    const int qlo = cur.P0 + wid * QBLK, qm = qlo + r32 - 4 * hi;
    char* V_lds = lds; char* K_lds = lds + 2 * SHM_V;
    float* ws = (float*)(lds + 2 * SHM_V + 2 * SHM_K) + wid * 64; float* li_l = ws, * al_l = ws + 32;
    const float* bias_l = (const float*)(lds + BIAS_OFF) + 4 * hi;
    const char* Qw_lds = lds + Q_OFF + wid * 8192;
    float m_reg = -1e30f, l_reg = 0; f32x16 o[4] = {};
    const int sr = tid >> 4, sc = (tid & 15) * 8, vst0 = v_st(sr, sc), vst1 = v_st(32 + sr, sc), kws = KSWZ(sr, sc * 2);
    const int vb0 = (int)(uintptr_t)V_lds + v_rd_base(lane);
    const TIn* Kh = cur.K; const TIn* Vh = cur.V;
#define RESC(a) do { if (__any((a) < 1.f)) { if (hi == 0) al_l[r32] = (a); asm volatile("s_waitcnt lgkmcnt(0)" ::: "memory");              \
                     for (int d_ = 0; d_ < 4; ++d_) for (int r = 0; r < 16; ++r) o[d_][r] *= al_l[crow(r, hi)]; } } while (0)
#define KBASE(t) ((j_lo + (t)) * KVBLK)
#define ACT(t) (KBASE(t) <= qlo + QBLK - 1 && KBASE(t) + KVBLK - 1 >= qlo - W + 1)
#define MASKT(P0_, P1_, t) do { const int kb_ = KBASE(t); if ((!SK || ACT(t)) && (kb_ + KVBLK - 1 > qlo || kb_ <= qlo + QBLK - 1 - W)) mask_tile(P0_, P1_, qm - kb_, (unsigned)W); } while (0)
    constexpr int NQL = F32 ? 16 : 0;
    constexpr bool SK = WSKIP && !F32;
#define SEAM_K0() do { VMWN(NQL); if constexpr (F32) { SWRITE_KF(0); SBAR(); SLOAD_F((const float*)nxt.V, kbn); } else { SWRITE_HK(0); } SBAR(); } while (0)
    f32x16 pA0, pA1, pB0, pB1; float mnA, mnB, alA, alB; bf16x8 pa0, pa1, pa2, pa3;
    if constexpr (F32) { VMW(); SWRITE_VF(0); SBAR(); } else { SWRITE_HV(0); SBAR(); }
    if (NT > 1) { if constexpr (F32) SLOAD_F((const float*)Kh, KBASE(1)); else SLOAD_H(Kh, Vh, KBASE(1)); }
    SBAR(); qkt<0, SK>(pA0, pA1, K_lds, r32, hi, Qw_lds, ACT(0), bias_l + KBASE(0));
    if constexpr (F32) { if (NT > 1) { VMW(); SWRITE_KF(1); SBAR(); SLOAD_F((const float*)Vh, KBASE(1)); } }
    MASKT(pA0, pA1, 0); partialSM(pA0, pA1, m_reg, mnA, alA);
    if (NT > 1) { VMW(); if constexpr (F32) { SWRITE_VF(1); SBAR(); if (NT > 2) SLOAD_F((const float*)Kh, KBASE(2)); } else SWRITE_H(1); }
    __syncthreads();
#define HALF_STEP(PX0, PX1, mnX, alX, PY0, PY1, alY, t, KB, VB, SB) do {                                                      \
        SBAR(); qkt<KB, SK>(PX0, PX1, K_lds, r32, hi, Qw_lds, ACT(t), bias_l + KBASE(t));                                             \
        finishSM(PY0, PY1, alY, l_reg, pa0, pa1, pa2, pa3); SBAR();                                                           \
        if ((t) + 1 < NT) { if constexpr (F32) { VMW(); SWRITE_KF(SB); SBAR(); SLOAD_F((const float*)Vh, KBASE((t) + 1)); }  \
                            else { SLOAD_H(Kh, Vh, KBASE((t) + 1)); } SBAR(); }                                               \
        pv_tile<VB, SK>(o, vb0, pa0, pa1, pa2, pa3, ACT((t) - 1)); MASKT(PX0, PX1, (t)); partialSM(PX0, PX1, m_reg, mnX, alX);                                        \
        __syncthreads();                                                                                                      \
        if ((t) + 1 < NT) { VMW(); if constexpr (F32) { SWRITE_VF(SB); SBAR(); if ((t) + 2 < NT) SLOAD_F((const float*)Kh, KBASE((t) + 2)); } \
                            else { SWRITE_H(SB); } }                                                                          \
        RESC(alX); __syncthreads(); } while (0)
    for (int t = 1; t + 1 < NT; t += 2) {
        HALF_STEP(pB0, pB1, mnB, alB, pA0, pA1, alA, t, 1, 0, 0);
        HALF_STEP(pA0, pA1, mnA, alA, pB0, pB1, alB, t + 1, 0, 1, 1);
    }
    const bool even = (NT & 1) == 0;
    if (even) { SBAR(); qkt<1, SK>(pB0, pB1, K_lds, r32, hi, Qw_lds, ACT(NT - 1), bias_l + KBASE(NT - 1)); SBAR(); }
#define QROW(e) (nxt.Q + (size_t)(wid * QBLK + r32) * QP + ((e) >> 1) * 16 + hi * 8 + ((e) & 1) * 4)
    if constexpr (F32) { SLOAD_F((const float*)nxt.K, kbn); SBAR();
#pragma unroll
        for (int e = 0; e < 8; ++e) S.tq[e] = *(const f32x4*)QROW(e); }
    else { SLOAD_H(nxt.K, nxt.V, kbn); SBAR(); }
    SBAR();
    finishSM(pA0, pA1, alA, l_reg, pa0, pa1, pa2, pa3); SBAR();
    if constexpr (F32) {
#pragma unroll
        for (int e = 8; e < 16; ++e) S.tq[e] = *(const f32x4*)QROW(e); SBAR(); }
#undef QROW
    pv_tile<0, SK>(o, vb0, pa0, pa1, pa2, pa3, ACT(even ? NT - 2 : NT - 1));
    if (even) { MASKT(pB0, pB1, NT - 1); partialSM(pB0, pB1, m_reg, mnB, alB); __syncthreads(); RESC(alB);
        finishSM(pB0, pB1, alB, l_reg, pa0, pa1, pa2, pa3); SBAR(); pv_tile<1, SK>(o, vb0, pa0, pa1, pa2, pa3, ACT(NT - 1)); }
    SBAR(); SEAM_K0();
    if (hi == 0) li_l[r32] = l_reg; asm volatile("s_waitcnt lgkmcnt(0)" ::: "memory");
    float rli[16];
#pragma unroll
    for (int r = 0; r < 16; ++r) rli[r] = __builtin_amdgcn_rcpf(li_l[crow(r, hi)]);
    TOut* Ow = cur.O + (size_t)(wid * QBLK) * OP;
#pragma unroll
    for (int r = 0; r < 16; ++r) { const int orow = crow(r, hi);
#pragma unroll
        for (int d0 = 0; d0 < 4; ++d0) { const float v = o[d0][r] * rli[r];
            if constexpr (same_t<TOut, float>::v) { Ow[(size_t)orow * OP + d0 * 32 + r32] = v; }
            else { const float vn = __shfl_xor(v, 1);
                   if ((r32 & 1) == 0) *(unsigned*)(Ow + (size_t)orow * OP + d0 * 32 + r32) = cvtpk(v, vn); } } }
    if constexpr (F32) {
#pragma unroll
        for (int d0 = 0; d0 < 8; ++d0) (void)S.tq[2 * d0]; }
    __syncthreads();
#undef RESC
#undef KBASE
#undef ACT
#undef MASKT
#undef SEAM_K0
#undef HALF_STEP
}
#undef ROW
#undef VMW
#undef VMWN
#undef SLOAD_H
#undef SWRITE_HK
#undef SWRITE_HV
#undef SWRITE_H
#undef SLOAD_F
#undef SWRITE_KF
#undef SWRITE_VF

#undef KSWZ
#undef SBAR
}

__device__ __forceinline__ void attn_phase(const bf16* proj, const float* cum, bf16* mix, unsigned char* lds_) {
    char* lds = (char*)lds_;
    for (int item = blockIdx.x; item < 256; item += gridDim.x) {
        OPAQUE_TID();
        const int bh = (item & 7) * 4 + ((item >> 3) & 3), qb = 7 - (item >> 5);
        const int b = bh >> 3, hh = bh & 7;
        float* bias = (float*)(lds + fa::BIAS_OFF);
        const float* cb = cum + (size_t)bh * SEQ;
        const int nk = (qb + 1) * 256;
        for (int s = tid; s < nk; s += 512) bias[s] = -cb[s] * (1.0f / fa::SCALE);
        fa::BlockRef<bf16, bf16> cur;
        cur.Q = proj + (size_t)(b * SEQ + qb * 256) * NPROJ + hh * 128; cur.K = proj + (size_t)(b * SEQ) * NPROJ + 1024 + hh * 128; cur.V = cur.K + 1024;
        cur.O = mix + (size_t)(b * SEQ + qb * 256) * DM + hh * 128; cur.P0 = qb * 256;
        fa::Seam<bf16> S;
        fa::causal_swa_prime<bf16, bf16>(cur, SEQ, lds, S, tid);
        fa::causal_swa_block<bf16, bf16>(cur, cur, SEQ, SEQ, lds, S, tid);
    }
}

__global__ void __launch_bounds__(512, 2) fwd(Args a) {
    extern __shared__ __attribute__((aligned(16))) unsigned char lds[];
    cg::grid_group grid = cg::this_grid();
#define OPQ_WS() opq_ptr(a.ws)
#define XN ((bf16*)(OPQ_WS() + WS_XN))
#define PROJ ((bf16*)(OPQ_WS() + WS_PROJ))
#define MIX ((bf16*)(OPQ_WS() + WS_MIX))
#define ACT ((bf16*)(OPQ_WS() + WS_ACT))
#define PP ((bf16*)(OPQ_WS() + WS_PP))
#define PBF ((bf16*)(OPQ_WS() + WS_PBF))
#define LOGF ((float*)(OPQ_WS() + WS_LOGF))
#define CUM ((float*)(OPQ_WS() + WS_CUM))
#define H ((float*)opq_ptr((unsigned char*)a.out))
    PG8_LAS unsigned char* ring = (PG8_LAS unsigned char*)lds;
    const int G = gridDim.x, bx = blockIdx.x;

    for (int rep_ = 0; rep_ < REP_PRO; ++rep_) prologue_weights(a, (LAS unsigned char*)lds);
    norm_phase(a.in[I_X], a.in[I_NORM_MIX], XN, true, a.in[I_W_IN], a.in[I_FBIAS], LOGF, lds);
    grid.sync();

#pragma unroll 1
    for (int L = 0; L < DEPTH; ++L) {
#define WL(off) ((const bf16*)(OPQ_WS() + WS_W + (size_t)L * SZ_LAYER + (off)))
#define Win WL(OFF_WIN)
#define Wout WL(OFF_WOUT)
#define Wgu WL(OFF_WGU)
#define Wdn WL(OFF_WDN)
#define Wpg WL(OFF_WPG)
#define Wpp WL(OFF_WPP)
        for (int rep_ = 0; rep_ < REP_A; ++rep_) {
        { pg8::Gemm g{XN, Win, M, NPROJ, DM}; pg8::StaticOrder S; S.init(M, NPROJ, G, bx);
          pg8::EpiBf16<0> E{PROJ, NPROJ, nullptr, 0, 0, 1.f};
          pg8::gemm_phase<pg8::EpiBf16<0>, pg8::StaticOrder, true, true>(ring, g, S, E); }
        { pg8::Gemm g{PBF + (size_t)L * M * DPLE, Wpp, M, DM, DPLE}; pg8::StaticOrder S; S.init(M, DM, G, bx);
          pg8::EpiBf16<0> E{PP, DM, nullptr, 0, 0, 1.f};
          pg8::gemm_phase<pg8::EpiBf16<0>, pg8::StaticOrder, true, true>(ring, g, S, E); }
        }
        grid.sync();
        post_phase(PROJ, a.in[I_Q_NORM] + L * 128, a.in[I_K_NORM] + L * 128, LOGF, CUM);
        grid.sync();
        for (int rep_ = 0; rep_ < REP_C; ++rep_) {
        gmlp_mfma(PROJ, a.in[I_GV_NORM] + L * 512, a.in[I_G_WS] + (size_t)L * 4 * 128 * 128, a.in[I_G_BS] + L * 512, MIX, lds);
        pool_mfma(PROJ, a.in[I_POOL_W] + (size_t)L * 4 * 128 * 128, a.in[I_POOL_SCALE] + L * 512, MIX, lds);
        for (int rep2_ = 0; rep2_ < REP_ATT; ++rep2_) attn_phase(PROJ, CUM, MIX, lds);
        }
        for (int rep_ = 0; rep_ < REP_SYNC; ++rep_) grid.sync();
        { pg8::Gemm g{MIX, Wout, M, DM, DM}; pg8::StaticOrder S; S.init(M, DM, G, bx);
          pg8::EpiRes E{L == 0 ? a.in[I_X] : H, H, DM};
          pg8::gemm_phase<pg8::EpiRes, pg8::StaticOrder, true, true>(ring, g, S, E); }
        grid.sync();
        for (int rep_ = 0; rep_ < REP_N; ++rep_) norm_phase(H, a.in[I_NORM_FFN] + L * DM, XN, false, nullptr, nullptr, nullptr, lds);
        grid.sync();
        for (int rep_ = 0; rep_ < REP_F; ++rep_) { pg8::Gemm g{XN, Wgu, M, NGU, DM}; pg8::StaticOrder S; S.init(M, NGU, G, bx);
          pg8::EpiSwiglu E{ACT, DFF};
          pg8::gemm_phase<pg8::EpiSwiglu, pg8::StaticOrder, true, true>(ring, g, S, E); }
        grid.sync();
        { pg8::Gemm g{ACT, Wdn, M, DM, DFF}; pg8::StaticOrder S; S.init(M, DM, G, bx);
          pg8::EpiRes E{H, H, DM};
          pg8::gemm_phase<pg8::EpiRes, pg8::StaticOrder, true, true>(ring, g, S, E); }
        grid.sync();
        for (int rep_ = 0; rep_ < REP_N; ++rep_) norm_phase(H, a.in[I_NORM_PLE] + L * DM, XN, false, nullptr, nullptr, nullptr, lds);
        grid.sync();
        { pg8::Gemm g{XN, Wpg, M, DM, DM}; pg8::StaticOrder S; S.init(M, DM, G, bx);
          pg8::EpiPle E{H, H, PP, DM};
          pg8::gemm_phase<pg8::EpiPle, pg8::StaticOrder, true, true>(ring, g, S, E); }
        if (L + 1 < DEPTH) {
            grid.sync();
            norm_phase(H, a.in[I_NORM_MIX] + (L + 1) * DM, XN, true, a.in[I_W_IN] + (size_t)(L + 1) * DM * DPROJ_SRC, a.in[I_FBIAS] + (L + 1) * 8, LOGF, lds);
            grid.sync();
        }
    }
}

extern "C" void kernel_launch(void* const* d_in, const int* in_sizes, int n_in, void* d_out, int out_size, void* d_ws, size_t ws_size, hipStream_t stream) {
    static int grid = 0;
    if (grid == 0) {
        if (n_in != 20 || out_size != M * DM || ws_size < WS_END) { fprintf(stderr, "kernel_launch: unexpected shapes (n_in %d out %d ws %zu, need %zu)\n", n_in, out_size, ws_size, (size_t)WS_END); grid = -1; return; }
        int dev = 0, cus = 0, per_cu = 0;
        (void)hipGetDevice(&dev); (void)hipDeviceGetAttribute(&cus, hipDeviceAttributeMultiprocessorCount, dev);
        if (hipFuncSetAttribute((const void*)fwd, hipFuncAttributeMaxDynamicSharedMemorySize, LDS_BYTES) != hipSuccess) fprintf(stderr, "kernel_launch: hipFuncSetAttribute failed\n");
        if (hipOccupancyMaxActiveBlocksPerMultiprocessor(&per_cu, (const void*)fwd, 512, LDS_BYTES) != hipSuccess || per_cu < 1) { fprintf(stderr, "kernel_launch: occupancy query gave %d\n", per_cu); per_cu = 1; }
        (void)hipGetLastError();
        if (cus <= 0) cus = 256;
        grid = cus * per_cu;
    }
    if (grid < 0) return;
    Args a{};
    for (int i = 0; i < 20; ++i) a.in[i] = (const float*)d_in[i];
    a.out = (float*)d_out; a.ws = (unsigned char*)d_ws;
    void* args[] = {&a};
    hipError_t e = hipLaunchCooperativeKernel((void*)fwd, dim3(grid), dim3(512), args, LDS_BYTES, stream);
    if (e != hipSuccess) fprintf(stderr, "cooperative launch failed: %s (grid %d)\n", hipGetErrorString(e), grid);
}
```

```cpp
#include <hip/hip_runtime.h>
#include <hip/hip_cooperative_groups.h>
#include <cstdio>
#include <cstdint>
namespace cg = cooperative_groups;
#ifndef REP_PRO
#define REP_PRO 1
#define REP_A 1
#define REP_C 1
#define REP_ATT 1
#define REP_F 1
#define REP_N 1
#define REP_SYNC 1
#endif
namespace pg8 {
#define PG8_LAS __attribute__((address_space(3)))
typedef unsigned short bf16_t;
typedef short bf16x8 __attribute__((ext_vector_type(8)));
typedef float f32x4 __attribute__((ext_vector_type(4)));
typedef unsigned u32x4 __attribute__((ext_vector_type(4)));
constexpr int BM = 256, BK = 64, HALF = 128, HTB = HALF * BK * 2  , STAGE_BYTES = 8 * HTB, NXCD = 8, WGM = 8;

__host__ __device__ __forceinline__ int lds_byte(int r, int c) { const int st = (r >> 4) * 2 + (c >> 5), rr = r & 15, cc = c & 31, ob = rr * 64 + cc * 2; return st * 1024 + (ob ^ (((ob >> 9) & 1) << 5)); }
__host__ __device__ __forceinline__ void stage_rc(int b, int& R, int& C) { const int st = b / 1024, sb = b % 1024, swz = sb ^ (((sb >> 9) & 1) << 5); R = (st >> 1) * 16 + swz / 64; C = (st & 1) * 32 + (swz % 64) / 2; }
__host__ __device__ __forceinline__ int perm32(int rho) { const int n = rho >> 4, i = rho & 15; return 8 * (i >> 2) + 4 * n + (i & 3); }

struct Unit { int pm, pn; };
struct Gemm { const bf16_t* A; const bf16_t* Bt; int M, N, K; };

struct StaticOrder {
    int nM, nN, nwg, G, c;
    __host__ __device__ void init(int M, int N, int G_, int c_) { nM = M / BM; nN = N / BM; nwg = nM * nN; G = G_; c = c_; }
    __host__ __device__ bool next(int i, Unit& u) const {
        const long L = (long)i * G + c; if (L >= nwg) return false;
        int wgid = (int)L; { const int q = nwg / NXCD, r = nwg % NXCD, xcd = wgid % NXCD, off = wgid / NXCD; wgid = (xcd < r ? xcd * (q + 1) : r * (q + 1) + (xcd - r) * q) + off; }
        const int nig = WGM * nN, gid = wgid / nig, fm = gid * WGM, gsz = (nM - fm) < WGM ? (nM - fm) : WGM;
        u.pm = fm + ((wgid % nig) % gsz); u.pn = (wgid % nig) / gsz; return true;
    }
    __device__ __forceinline__ void a_ready(const Unit&) const {}
    __device__ __forceinline__ void done(const Unit&) const {}
};

__device__ __forceinline__ unsigned cvt_pk_bf16(float lo, float hi) { unsigned r; asm volatile("v_cvt_pk_bf16_f32 %0, %1, %2" : "=v"(r) : "v"(lo), "v"(hi)); return r; }
typedef float f32x2 __attribute__((ext_vector_type(2)));
__device__ __forceinline__ f32x2 gelu_pk(f32x2 v) {
    const f32x2 av = __builtin_elementwise_abs(v), d = av * 0.2316418882f + 1.0f;
    f32x2 t; t.x = __builtin_amdgcn_rcpf(d.x); t.y = __builtin_amdgcn_rcpf(d.y);
    f32x2 q = t * 0.5307027145f + (-0.7265760135f); q = q * t + 0.7107068705f; q = q * t + (-0.142248368f); q = q * t + 0.127414796f; q = q * t;
    const f32x2 s = (v * v) * (-0.72134752044f);
    f32x2 e; e.x = __builtin_amdgcn_exp2f(s.x); e.y = __builtin_amdgcn_exp2f(s.y);
    const f32x2 m = v * (q * e), r = v - m;
    f32x2 o; o.x = v.x < 0.f ? m.x : r.x; o.y = v.y < 0.f ? m.y : r.y; return o;
}

template <int ACT  > struct EpiBf16 {
    static constexpr bool PERM = true, AFTER_DRAIN = false; static_assert(ACT == 0 || ACT == 1, "EpiBf16: ACT is 0 (none) or 1 (gelu_pk)");
    bf16_t* O; int ldc; const float* bias; int split_cols; size_t split_stride; float scale0;
    __device__ __forceinline__ void operator()(const f32x4 (&acc)[2][2][4][2], const Unit& u, int wr, int wc, int fr, int fq) const {
        const int row0 = u.pm * BM + wr * 64 + fr; int colt = u.pn * BM; bf16_t* base = O;
        float sc = 1.f; if (split_cols) { const int t = colt / split_cols; base += (size_t)t * split_stride; colt -= t * split_cols; if (t == 0) sc = scale0; }
        const int col0 = colt + wc * 32 + 8 * fq, bcol0 = u.pn * BM + wc * 32 + 8 * fq;
        f32x4 bv[2][2];
#pragma unroll
        for (int bj = 0; bj < 2; ++bj)
#pragma unroll
            for (int n = 0; n < 2; ++n) bv[bj][n] = bias ? *(const f32x4*)(bias + bcol0 + bj * HALF + 4 * n) : (f32x4){0.f, 0.f, 0.f, 0.f};
#pragma unroll
        for (int ai = 0; ai < 2; ++ai)
#pragma unroll
            for (int m = 0; m < 4; ++m) { bf16_t* rowp = base + (size_t)(row0 + ai * HALF + m * 16) * ldc + col0;
#pragma unroll
                for (int bj = 0; bj < 2; ++bj) { f32x4 v0 = acc[ai][bj][m][0] + bv[bj][0], v1 = acc[ai][bj][m][1] + bv[bj][1];
                    if (ACT == 1) { f32x2 a = gelu_pk((f32x2){v0[0], v0[1]}), b = gelu_pk((f32x2){v0[2], v0[3]}), c = gelu_pk((f32x2){v1[0], v1[1]}), d = gelu_pk((f32x2){v1[2], v1[3]});
                        v0 = (f32x4){a.x, a.y, b.x, b.y}; v1 = (f32x4){c.x, c.y, d.x, d.y}; }
                    v0 = v0 * sc; v1 = v1 * sc; u32x4 w; w.x = cvt_pk_bf16(v0[0], v0[1]); w.y = cvt_pk_bf16(v0[2], v0[3]); w.z = cvt_pk_bf16(v1[0], v1[1]); w.w = cvt_pk_bf16(v1[2], v1[3]);
                    *(u32x4*)(rowp + bj * HALF) = w; } }
    }
};
typedef unsigned u32x2 __attribute__((ext_vector_type(2)));
__device__ __forceinline__ float bf_lo(unsigned w) { return __uint_as_float(w << 16); }
__device__ __forceinline__ float bf_hi(unsigned w) { return __uint_as_float(w & 0xffff0000u); }
__device__ __forceinline__ float sigmoidf_(float x) { return 1.0f / (1.0f + __expf(-x)); }
struct EpiRes {
    static constexpr bool PERM = false, AFTER_DRAIN = false;
    const float* base; float* out; int ldc;
    __device__ __forceinline__ void operator()(const f32x4 (&acc)[2][2][4][2], const Unit& u, int wr, int wc, int fr, int fq) const {
        const int col0 = u.pn * BM + wc * 32 + 4 * fq;
#pragma unroll
        for (int ai = 0; ai < 2; ++ai)
#pragma unroll
            for (int m = 0; m < 4; ++m) { const size_t off = (size_t)(u.pm * BM + ai * HALF + wr * 64 + m * 16 + fr) * ldc + col0;
#pragma unroll
                for (int bj = 0; bj < 2; ++bj)
#pragma unroll
                    for (int n = 0; n < 2; ++n) { const f32x4 bs = *(const f32x4*)(base + off + bj * HALF + n * 16); *(f32x4*)(out + off + bj * HALF + n * 16) = bs + acc[ai][bj][m][n]; }
                asm volatile("" ::: "memory"); }
    }
};
struct EpiPle {
    static constexpr bool PERM = false, AFTER_DRAIN = false;
    const float* base; float* out; const bf16_t* pp; int ldc;
    __device__ __forceinline__ void operator()(const f32x4 (&acc)[2][2][4][2], const Unit& u, int wr, int wc, int fr, int fq) const {
        const int col0 = u.pn * BM + wc * 32 + 4 * fq;
#pragma unroll
        for (int ai = 0; ai < 2; ++ai)
#pragma unroll
            for (int m = 0; m < 4; ++m) { const size_t off = (size_t)(u.pm * BM + ai * HALF + wr * 64 + m * 16 + fr) * ldc + col0;
#pragma unroll
                for (int bj = 0; bj < 2; ++bj)
#pragma unroll
                    for (int n = 0; n < 2; ++n) { const f32x4 bs = *(const f32x4*)(base + off + bj * HALF + n * 16); const u32x2 pw = *(const u32x2*)(pp + off + bj * HALF + n * 16);
                        const f32x4 a = acc[ai][bj][m][n]; f32x4 o;
                        o[0] = bs[0] + bf_lo(pw.x) * sigmoidf_(a[0]); o[1] = bs[1] + bf_hi(pw.x) * sigmoidf_(a[1]);
                        o[2] = bs[2] + bf_lo(pw.y) * sigmoidf_(a[2]); o[3] = bs[3] + bf_hi(pw.y) * sigmoidf_(a[3]);
                        *(f32x4*)(out + off + bj * HALF + n * 16) = o; }
                asm volatile("" ::: "memory"); }
    }
};
struct EpiSwiglu {
    static constexpr bool PERM = true, AFTER_DRAIN = false;
    bf16_t* O; int ldc;
    __device__ __forceinline__ void operator()(const f32x4 (&acc)[2][2][4][2], const Unit& u, int wr, int wc, int fr, int fq) const {
        const int col0 = u.pn * HALF + wc * 32 + 8 * fq;
#pragma unroll
        for (int ai = 0; ai < 2; ++ai)
#pragma unroll
            for (int m = 0; m < 4; ++m) { bf16_t* rowp = O + (size_t)(u.pm * BM + ai * HALF + wr * 64 + m * 16 + fr) * ldc + col0;
                float r[8];
#pragma unroll
                for (int n = 0; n < 2; ++n)
#pragma unroll
                    for (int j = 0; j < 4; ++j) { const float g = acc[ai][0][m][n][j], up = acc[ai][1][m][n][j]; r[n * 4 + j] = g * sigmoidf_(g) * up; }
                u32x4 w; w.x = cvt_pk_bf16(r[0], r[1]); w.y = cvt_pk_bf16(r[2], r[3]); w.z = cvt_pk_bf16(r[4], r[5]); w.w = cvt_pk_bf16(r[6], r[7]);
                *(u32x4*)rowp = w; asm volatile("" ::: "memory"); }
    }
};
template <class Epi, class Sched, bool ALIGN_EPI = false, bool SP2 = false>
__device__ __forceinline__ void gemm_phase(PG8_LAS unsigned char* lds, const Gemm g, const Sched& S, const Epi& E) {
    int tid_ = threadIdx.x; asm volatile("" : "+v"(tid_));
    const int tid = tid_, wid = __builtin_amdgcn_readfirstlane(tid >> 6), lane = tid & 63, wr = wid >> 2, wc = wid & 3, fr = lane & 15, fq = lane >> 4;
    const int K = g.K, nt = K / BK;
    unsigned voffA[2], voffB[2];
#pragma unroll
    for (int i = 0; i < 2; ++i) { int R, C; stage_rc(tid * 16 + i * 8192, R, C); const int Rb = Epi::PERM ? ((R & ~31) + perm32(R & 31)) : R;
        voffA[i] = (unsigned)(R * K + C) * 2u; voffB[i] = (unsigned)(Rb * K + C) * 2u; }
    const size_t kstep = (size_t)(BK * 2);
    const size_t hstep = (size_t)HALF * K * 2;
    const size_t tstep = 2 * hstep;
    const unsigned ldsw = (unsigned)wid * 1024u;
    const int aoff = lds_byte(wr * 64 + fr, fq * 8), boff = lds_byte(wc * 32 + fr, fq * 8);
#define PG8_SA(b, h) (((b) * 2 + (h)) * HTB)
#define PG8_SB(b, h) ((4 + (b) * 2 + (h)) * HTB)
#define PG8_STAGE(bufoff, gbase, voff) do { _Pragma("unroll") for (int _i = 0; _i < 2; ++_i) \
        __builtin_amdgcn_global_load_lds((const unsigned*)((const char*)(gbase) + (voff)[_i]), (PG8_LAS unsigned*)(lds + (bufoff) + ldsw + _i * 8192), 16, 0, 0); } while (0)
#define PG8_LDA(dst, b, h) do { _Pragma("unroll") for (int m = 0; m < 4; ++m) _Pragma("unroll") for (int k = 0; k < 2; ++k) dst[m][k] = *(const PG8_LAS bf16x8*)(lds + PG8_SA(b, h) + aoff + m * 2048 + k * 1024); } while (0)
#define PG8_LDB(dst, b, h) do { _Pragma("unroll") for (int n = 0; n < 2; ++n) _Pragma("unroll") for (int k = 0; k < 2; ++k) dst[n][k] = *(const PG8_LAS bf16x8*)(lds + PG8_SB(b, h) + boff + n * 2048 + k * 1024); } while (0)
#define PG8_MMA(ai, bj, At, Bt) do { __builtin_amdgcn_s_setprio(1); _Pragma("unroll") for (int m = 0; m < 4; ++m) _Pragma("unroll") for (int n = 0; n < 2; ++n) _Pragma("unroll") for (int k = 0; k < 2; ++k) \
        acc[ai][bj][m][n] = __builtin_amdgcn_mfma_f32_16x16x32_bf16(Bt[n][k], At[m][k], acc[ai][bj][m][n], 0, 0, 0); __builtin_amdgcn_s_setprio(0); } while (0)
#define PG8_WAIT_V(n) asm volatile("s_waitcnt vmcnt(" #n ")" ::: "memory")
#define PG8_WAIT_L(n) asm volatile("s_waitcnt lgkmcnt(" #n ")" ::: "memory")
#define PG8_BAR __builtin_amdgcn_s_barrier()
#define PG8_SCHED __builtin_amdgcn_sched_barrier(0)
    Unit cur, nxt; int ui = 0;
    if (!S.next(0, cur)) return;
    f32x4 acc[2][2][4][2];
#pragma unroll
    for (int a = 0; a < 2; ++a)
#pragma unroll
        for (int b = 0; b < 2; ++b)
#pragma unroll
            for (int m = 0; m < 4; ++m)
#pragma unroll
                for (int n = 0; n < 2; ++n) acc[a][b][m][n] = (f32x4){0.f, 0.f, 0.f, 0.f};
    bf16x8 At[4][2], B0[2][2], B1[2][2];
    const char* cA = (const char*)g.A + (size_t)cur.pm * tstep; const char* cB = (const char*)g.Bt + (size_t)cur.pn * tstep;
    S.a_ready(cur);
    if constexpr (SP2) {
        PG8_STAGE(PG8_SB(0, 0), cB, voffB); PG8_STAGE(PG8_SB(0, 1), cB + hstep, voffB); PG8_STAGE(PG8_SA(0, 0), cA, voffA); PG8_STAGE(PG8_SA(0, 1), cA + hstep, voffA);
        if (wr == 1) PG8_BAR;
        PG8_WAIT_V(2); PG8_BAR;
        PG8_STAGE(PG8_SB(1, 0), cB + kstep, voffB); PG8_STAGE(PG8_SA(1, 0), cA + kstep, voffA); PG8_STAGE(PG8_SB(1, 1), cB + hstep + kstep, voffB);
        PG8_WAIT_V(6); PG8_BAR;
    } else {
        PG8_STAGE(PG8_SB(0, 0), cB, voffB); PG8_STAGE(PG8_SA(0, 0), cA, voffA); PG8_STAGE(PG8_SB(0, 1), cB + hstep, voffB); PG8_STAGE(PG8_SA(0, 1), cA + hstep, voffA);
        if (wr == 1) PG8_BAR;
        PG8_WAIT_V(4); PG8_BAR;
        PG8_STAGE(PG8_SB(1, 0), cB + kstep, voffB); PG8_STAGE(PG8_SA(1, 0), cA + kstep, voffA); PG8_STAGE(PG8_SB(1, 1), cB + hstep + kstep, voffB);
        PG8_WAIT_V(6); PG8_BAR;
    }
    for (;;) {
        const bool has_next = S.next(ui + 1, nxt);
        const char* nA = has_next ? (const char*)g.A + (size_t)nxt.pm * tstep : cA; const char* nB = has_next ? (const char*)g.Bt + (size_t)nxt.pn * tstep : cB;
        for (int t = 0; t < nt; t += 2) {
            const bool last = (t == nt - 2);
            const char* a1 = cA + (size_t)(t + 1) * kstep;
            const char* a2 = last ? nA : cA + (size_t)(t + 2) * kstep; const char* b2 = last ? nB : cB + (size_t)(t + 2) * kstep;
            const char* a3 = a2 + kstep; const char* b3 = b2 + kstep;
            if (last && has_next) S.a_ready(nxt);
            if constexpr (SP2) {
            PG8_LDB(B0, 0, 0); PG8_LDB(B1, 0, 1); PG8_SCHED; PG8_LDA(At, 0, 0); PG8_STAGE(PG8_SA(1, 1), a1 + hstep, voffA);
            PG8_WAIT_V(8); PG8_WAIT_L(0); PG8_BAR; PG8_MMA(0, 0, At, B0); PG8_MMA(0, 1, At, B1); PG8_BAR; PG8_SCHED;
            PG8_LDA(At, 0, 1); PG8_STAGE(PG8_SB(0, 0), b2, voffB); PG8_STAGE(PG8_SB(0, 1), b2 + hstep, voffB); PG8_STAGE(PG8_SA(0, 0), a2, voffA);
            PG8_WAIT_V(8); PG8_WAIT_L(0); PG8_BAR; PG8_MMA(1, 0, At, B0); PG8_MMA(1, 1, At, B1); PG8_BAR; PG8_SCHED;
            PG8_LDB(B0, 1, 0); PG8_LDB(B1, 1, 1); PG8_SCHED; PG8_LDA(At, 1, 0); PG8_STAGE(PG8_SA(0, 1), a2 + hstep, voffA);
            PG8_WAIT_V(8); PG8_WAIT_L(0); PG8_BAR; PG8_MMA(0, 0, At, B0); PG8_MMA(0, 1, At, B1); PG8_BAR; PG8_SCHED;
            PG8_LDA(At, 1, 1); PG8_STAGE(PG8_SB(1, 0), b3, voffB); PG8_STAGE(PG8_SB(1, 1), b3 + hstep, voffB); PG8_STAGE(PG8_SA(1, 0), a3, voffA);
            PG8_WAIT_V(8); PG8_WAIT_L(0); PG8_BAR; PG8_MMA(1, 0, At, B0); PG8_MMA(1, 1, At, B1); PG8_BAR; PG8_SCHED;
            } else {
            PG8_LDB(B0, 0, 0); PG8_SCHED; PG8_LDA(At, 0, 0); PG8_STAGE(PG8_SA(1, 1), a1 + hstep, voffA);
            PG8_WAIT_L(8); PG8_BAR; PG8_WAIT_L(0); PG8_MMA(0, 0, At, B0); PG8_BAR; PG8_SCHED;
            PG8_LDB(B1, 0, 1); PG8_STAGE(PG8_SB(0, 0), b2, voffB);
            PG8_BAR; PG8_WAIT_L(0); PG8_MMA(0, 1, At, B1); PG8_BAR;
            PG8_LDA(At, 0, 1); PG8_STAGE(PG8_SA(0, 0), a2, voffA);
            PG8_BAR; PG8_WAIT_L(0); PG8_MMA(1, 0, At, B0); PG8_BAR; PG8_SCHED;
            PG8_STAGE(PG8_SB(0, 1), b2 + hstep, voffB);
            PG8_WAIT_V(6); PG8_BAR; PG8_MMA(1, 1, At, B1); PG8_BAR;
            PG8_LDB(B0, 1, 0); PG8_SCHED; PG8_LDA(At, 1, 0); PG8_STAGE(PG8_SA(0, 1), a2 + hstep, voffA);
            PG8_WAIT_L(8); PG8_BAR; PG8_WAIT_L(0); PG8_MMA(0, 0, At, B0); PG8_BAR; PG8_SCHED;
            PG8_LDB(B1, 1, 1); PG8_STAGE(PG8_SB(1, 0), b3, voffB);
            PG8_BAR; PG8_WAIT_L(0); PG8_MMA(0, 1, At, B1); PG8_BAR;
            PG8_LDA(At, 1, 1); PG8_STAGE(PG8_SA(1, 0), a3, voffA);
            PG8_BAR; PG8_WAIT_L(0); PG8_MMA(1, 0, At, B0); PG8_BAR; PG8_SCHED;
            PG8_STAGE(PG8_SB(1, 1), b3 + hstep, voffB);
            PG8_WAIT_V(6); PG8_BAR; PG8_MMA(1, 1, At, B1); PG8_BAR;
            }
        }
        if constexpr (ALIGN_EPI) { if (wr == 0) PG8_BAR; }
        if constexpr (!Epi::AFTER_DRAIN) { E(acc, cur, wr, wc, fr, fq); S.done(cur); }
        if (!has_next) break;
#pragma unroll
        for (int a = 0; a < 2; ++a)
#pragma unroll
            for (int b = 0; b < 2; ++b)
#pragma unroll
                for (int m = 0; m < 4; ++m)
#pragma unroll
                    for (int n = 0; n < 2; ++n) acc[a][b][m][n] = (f32x4){0.f, 0.f, 0.f, 0.f};
        cur = nxt; cA = nA; cB = nB; ++ui;
        if constexpr (ALIGN_EPI) { if (wr == 1) PG8_BAR; }
    }
    PG8_WAIT_V(0);
    if constexpr (!ALIGN_EPI) { if (wr == 0) PG8_BAR; }
    PG8_BAR;
    if constexpr (Epi::AFTER_DRAIN) { E.fused(acc, cur, wr, wc, fr, fq, lds, wid, lane); S.done(cur); }
#undef PG8_SA
#undef PG8_SB
#undef PG8_STAGE
#undef PG8_LDA
#undef PG8_LDB
#undef PG8_MMA
#undef PG8_WAIT_V
#undef PG8_WAIT_L
#undef PG8_BAR
#undef PG8_SCHED
}
}

constexpr int M = 8192, DM = 2048, SEQ = 2048, NPROJ = 4608, DPROJ_SRC = 4616, DFF = 5632, NGU = 11264, DPLE = 256, DEPTH = 4;
constexpr size_t SZ_WIN = (size_t)NPROJ * DM * 2, SZ_WOUT = (size_t)DM * DM * 2, SZ_WGU = (size_t)NGU * DM * 2, SZ_WDN = (size_t)DM * DFF * 2, SZ_WPG = SZ_WOUT, SZ_WPP = (size_t)DM * DPLE * 2;
constexpr size_t OFF_WIN = 0, OFF_WOUT = OFF_WIN + SZ_WIN, OFF_WGU = OFF_WOUT + SZ_WOUT, OFF_WDN = OFF_WGU + SZ_WGU, OFF_WPG = OFF_WDN + SZ_WDN, OFF_WPP = OFF_WPG + SZ_WPG, SZ_LAYER = OFF_WPP + SZ_WPP;
constexpr size_t WS_W = 1u << 20, WS_XN = WS_W + DEPTH * SZ_LAYER, WS_PROJ = WS_XN + (size_t)M * DM * 2, WS_MIX = WS_PROJ + (size_t)M * NPROJ * 2, WS_ACT = WS_MIX + (size_t)M * DM * 2,
                 WS_PP = WS_ACT + (size_t)M * DFF * 2, WS_PBF = WS_PP + (size_t)M * DM * 2, WS_LOGF = WS_PBF + (size_t)DEPTH * M * DPLE * 2, WS_CUM = WS_LOGF + (size_t)M * 8 * 4, WS_END = WS_CUM + (size_t)M * 8 * 4;
constexpr int LDS_BYTES = 147456;
constexpr int XB_LDS_OFF = LDS_BYTES - 64;
constexpr size_t WS_BAR = 4096;
constexpr float EPS = 1e-6f;

typedef unsigned short bf16;
typedef unsigned v4u __attribute__((ext_vector_type(4)));
typedef unsigned v2u __attribute__((ext_vector_type(2)));
typedef float f32x4 __attribute__((ext_vector_type(4)));
#define LAS __attribute__((address_space(3)))
#define LDS_WAIT() asm volatile("s_waitcnt lgkmcnt(0)" ::: "memory")
#define OPAQUE_TID() int tid; { int t_ = threadIdx.x; asm volatile("" : "+v"(t_)); tid = t_; } const int lane = tid & 63, wave = __builtin_amdgcn_readfirstlane(tid >> 6); (void)lane; (void)wave

__device__ __forceinline__ unsigned f2bf(float f) { unsigned u = __builtin_bit_cast(unsigned, f); return (u + 0x7fffu + ((u >> 16) & 1u)) >> 16; }
__device__ __forceinline__ unsigned pk2(float lo, float hi) { return f2bf(lo) | (f2bf(hi) << 16); }
__device__ __forceinline__ float bflo(unsigned w) { return __uint_as_float(w << 16); }
__device__ __forceinline__ float bfhi(unsigned w) { return __uint_as_float(w & 0xffff0000u); }
__device__ __forceinline__ float bf2f(bf16 v) { return __uint_as_float((unsigned)v << 16); }
__device__ __forceinline__ float wave_sum(float v) {
#pragma unroll
    for (int o = 1; o < 64; o <<= 1) v += __shfl_xor(v, o);
    return v;
}
__device__ __forceinline__ float gelu_tanh(float x) { const float y2 = 1.5957691216057308f * (x + 0.044715f * x * x * x); return x / (1.0f + __expf(-y2)); }
__device__ __forceinline__ float log_sigmoid(float x) { return fminf(x, 0.f) - __logf(1.0f + __expf(-fabsf(x))); }

__device__ __forceinline__ unsigned char* opq_ptr(unsigned char* p) { asm volatile("" : "+s"(p)); return p; }
struct Args { const float* in[20]; float* out; unsigned char* ws; };
enum { I_X = 0, I_P, I_NORM_MIX, I_W_IN, I_Q_NORM, I_K_NORM, I_FBIAS, I_GV_NORM, I_G_WS, I_G_BS, I_POOL_W, I_POOL_SCALE, I_W_OUT, I_NORM_FFN, I_W_GATE, I_W_UP, I_W_DOWN, I_NORM_PLE, I_W_PG, I_W_PP };

struct TrItem { const float* src; bf16* dst; int ldw, K; };
__device__ __forceinline__ TrItem tr_decode(const Args& a, int it) {
    constexpr int I_IN = 16 * 36, I_OUT = 16 * 16, I_GU = 16 * 88, I_DN = 44 * 16, I_PG = 16 * 16, I_PPN = 2 * 16, I_L = I_IN + I_OUT + I_GU + I_DN + I_PG + I_PPN;
    const int L = it / I_L; int r = it - L * I_L;
    unsigned char* wl = a.ws + WS_W + (size_t)L * SZ_LAYER;
    TrItem t;
    if (r < I_IN) { const int kb = r / 36, nb = r - kb * 36, n0 = nb * 128, c0 = n0 < 3072 ? n0 : n0 + 8;
        t.ldw = DPROJ_SRC; t.K = DM; t.src = a.in[I_W_IN] + (size_t)L * DM * DPROJ_SRC + (size_t)kb * 128 * DPROJ_SRC + c0; t.dst = (bf16*)(wl + OFF_WIN) + (size_t)n0 * DM + kb * 128; }
    else if ((r -= I_IN) < I_OUT) { const int kb = r / 16, nb = r - kb * 16, n0 = nb * 128;
        t.ldw = DM; t.K = DM; t.src = a.in[I_W_OUT] + (size_t)L * DM * DM + (size_t)kb * 128 * DM + n0; t.dst = (bf16*)(wl + OFF_WOUT) + (size_t)n0 * DM + kb * 128; }
    else if ((r -= I_OUT) < I_GU) { const int kb = r / 88, nb = r - kb * 88, n0 = nb * 128, tt = nb >> 1, half = nb & 1;
        t.ldw = DFF; t.K = DM; t.src = (half ? a.in[I_W_UP] : a.in[I_W_GATE]) + (size_t)L * DM * DFF + (size_t)kb * 128 * DFF + tt * 128; t.dst = (bf16*)(wl + OFF_WGU) + (size_t)n0 * DM + kb * 128; }
    else if ((r -= I_GU) < I_DN) { const int kb = r / 16, nb = r - kb * 16, n0 = nb * 128;
        t.ldw = DM; t.K = DFF; t.src = a.in[I_W_DOWN] + (size_t)L * DFF * DM + (size_t)kb * 128 * DM + n0; t.dst = (bf16*)(wl + OFF_WDN) + (size_t)n0 * DFF + kb * 128; }
    else if ((r -= I_DN) < I_PG) { const int kb = r / 16, nb = r - kb * 16, n0 = nb * 128;
        t.ldw = DM; t.K = DM; t.src = a.in[I_W_PG] + (size_t)L * DM * DM + (size_t)kb * 128 * DM + n0; t.dst = (bf16*)(wl + OFF_WPG) + (size_t)n0 * DM + kb * 128; }
    else { r -= I_PG; const int kb = r / 16, nb = r - kb * 16, n0 = nb * 128;
        t.ldw = DM; t.K = DPLE; t.src = a.in[I_W_PP] + (size_t)L * DPLE * DM + (size_t)kb * 128 * DM + n0; t.dst = (bf16*)(wl + OFF_WPP) + (size_t)n0 * DPLE + kb * 128; }
    return t;
}
__device__ __forceinline__ void prologue_weights(const Args& a, LAS unsigned char* lds) {
    OPAQUE_TID();
    constexpr int NITEMS = DEPTH * (16 * 36 + 16 * 16 + 16 * 88 + 44 * 16 + 16 * 16 + 2 * 16);
    constexpr int RSB = 272;
    const int ng = tid & 31, kg = tid >> 5;
    const int orow = tid >> 4, och = tid & 15;
    f32x4 v[8];
    int it = blockIdx.x;
    TrItem cur;
    if (it < NITEMS) { cur = tr_decode(a, it);
#pragma unroll
        for (int r = 0; r < 8; ++r) v[r] = *(const f32x4*)(cur.src + (size_t)(8 * kg + r) * cur.ldw + 4 * ng); }
    while (it < NITEMS) {
#pragma unroll
        for (int j = 0; j < 4; ++j) { v4u o; o.x = pk2(v[0][j], v[1][j]); o.y = pk2(v[2][j], v[3][j]); o.z = pk2(v[4][j], v[5][j]); o.w = pk2(v[6][j], v[7][j]);
            *(LAS v4u*)(lds + (4 * ng + j) * RSB + 16 * kg) = o; }
        __syncthreads();
        const int nit = it + gridDim.x; const TrItem out = cur;
        if (nit < NITEMS) { cur = tr_decode(a, nit);
#pragma unroll
            for (int r = 0; r < 8; ++r) v[r] = *(const f32x4*)(cur.src + (size_t)(8 * kg + r) * cur.ldw + 4 * ng); }
#pragma unroll
        for (int j = 0; j < 4; ++j) { const int n = orow + 32 * j; const v4u o = *(const LAS v4u*)(lds + n * RSB + 16 * och);
            *(v4u*)(out.dst + (size_t)n * out.K + 8 * och) = o; }
        __syncthreads();
        it = nit;
    }
    { const size_t n8 = (size_t)DEPTH * M * DPLE / 8; const float* p = a.in[I_P]; bf16* pb = (bf16*)(a.ws + WS_PBF);
      for (size_t i = (size_t)blockIdx.x * 512 + tid; i < n8; i += (size_t)gridDim.x * 512) {
          const f32x4 x0 = *(const f32x4*)(p + i * 8), x1 = *(const f32x4*)(p + i * 8 + 4);
          v4u o; o.x = pk2(x0[0], x0[1]); o.y = pk2(x0[2], x0[3]); o.z = pk2(x1[0], x1[1]); o.w = pk2(x1[2], x1[3]);
          *(v4u*)(pb + i * 8) = o; } }
}

__device__ __forceinline__ void norm_phase(const float* h, const float* gain, bf16* xn, bool with_f, const float* win_l, const float* fbias, float* logf,
                                           unsigned char* lds) {
    OPAQUE_TID();
    float* wf = (float*)lds;
    if (with_f) {
        for (int c = tid; c < DM; c += 512) {
            const f32x4 x0 = *(const f32x4*)(win_l + (size_t)c * DPROJ_SRC + 3072), x1 = *(const f32x4*)(win_l + (size_t)c * DPROJ_SRC + 3076);
            wf[0 * DM + c] = x0[0]; wf[1 * DM + c] = x0[1]; wf[2 * DM + c] = x0[2]; wf[3 * DM + c] = x0[3];
            wf[4 * DM + c] = x1[0]; wf[5 * DM + c] = x1[1]; wf[6 * DM + c] = x1[2]; wf[7 * DM + c] = x1[3]; }
        __syncthreads();
    }
    const int gw = blockIdx.x * 8 + wave, NGW = gridDim.x * 8;
    f32x4 g[8];
#pragma unroll
    for (int j = 0; j < 8; ++j) g[j] = *(const f32x4*)(gain + 4 * lane + 256 * j);
    for (int row = gw; row < M; row += NGW) {
        const f32x4* xr = (const f32x4*)(h + (size_t)row * DM) + lane;
        f32x4 v[8]; float ss = 0.f;
#pragma unroll
        for (int j = 0; j < 8; ++j) { v[j] = xr[64 * j]; ss += (v[j][0] * v[j][0] + v[j][1] * v[j][1]) + (v[j][2] * v[j][2] + v[j][3] * v[j][3]); }
        ss = wave_sum(ss);
        const float rinv = 1.0f / sqrtf(ss * (1.0f / DM) + EPS);
        v2u* o8 = (v2u*)(xn + (size_t)row * DM) + lane;
#pragma unroll
        for (int j = 0; j < 8; ++j) { v[j] = v[j] * rinv * g[j]; v2u w; w.x = pk2(v[j][0], v[j][1]); w.y = pk2(v[j][2], v[j][3]); o8[64 * j] = w; }
        if (with_f) {
            float f[8];
#pragma unroll
            for (int hh = 0; hh < 8; ++hh) { float s = 0.f;
#pragma unroll
                for (int j = 0; j < 8; ++j) { const f32x4 w = *(const f32x4*)(wf + hh * DM + 4 * lane + 256 * j); s += (v[j][0] * w[0] + v[j][1] * w[1]) + (v[j][2] * w[2] + v[j][3] * w[3]); }
                f[hh] = wave_sum(s); asm volatile("" ::: "memory"); }
            float mine = f[0];
#pragma unroll
            for (int hh = 1; hh < 8; ++hh) mine = (lane == hh) ? f[hh] : mine;
            if (lane < 8) logf[(size_t)row * 8 + lane] = log_sigmoid(mine + fbias[lane]);
        }
    }
    if (with_f) __syncthreads();
}

__device__ __forceinline__ void post_phase(bf16* proj, const float* qg, const float* kg, const float* logf, float* cum) {
    OPAQUE_TID();
    const int gw = blockIdx.x * 8 + wave, NGW = gridDim.x * 8;
    const int d0 = 8 * (lane & 15);
    float gq[8], gk[8];
#pragma unroll
    for (int e = 0; e < 8; ++e) { gq[e] = qg[d0 + e]; gk[e] = kg[d0 + e]; }
    for (int row = gw; row < M; row += NGW) {
        v4u* pr = (v4u*)(proj + (size_t)row * NPROJ);
#pragma unroll
        for (int j = 0; j < 4; ++j) {
            const v4u w = pr[lane + 64 * j];
            float x[8] = {bflo(w.x), bfhi(w.x), bflo(w.y), bfhi(w.y), bflo(w.z), bfhi(w.z), bflo(w.w), bfhi(w.w)};
            float ss = 0.f;
#pragma unroll
            for (int e = 0; e < 8; ++e) ss += x[e] * x[e];
            ss += __shfl_xor(ss, 1); ss += __shfl_xor(ss, 2); ss += __shfl_xor(ss, 4); ss += __shfl_xor(ss, 8);
            const float rinv = 1.0f / sqrtf(ss * (1.0f / 128.0f) + EPS);
#pragma unroll
            for (int e = 0; e < 8; ++e) x[e] = x[e] * rinv * (j < 2 ? gq[e] : gk[e]);
            v4u o; o.x = pk2(x[0], x[1]); o.y = pk2(x[2], x[3]); o.z = pk2(x[4], x[5]); o.w = pk2(x[6], x[7]);
            pr[lane + 64 * j] = o;
        }
    }
    for (int bh = blockIdx.x; bh < 32; bh += gridDim.x) if (wave == 0) {
        const int b = bh >> 3, hh = bh & 7;
        float loc[32]; float run = 0.f;
#pragma unroll
        for (int i = 0; i < 32; ++i) { run += logf[((size_t)(b * SEQ + lane * 32 + i)) * 8 + hh]; loc[i] = run; }
        float inc = run;
#pragma unroll
        for (int o = 1; o < 64; o <<= 1) { const float t = __shfl_up(inc, o); if (lane >= o) inc += t; }
        const float excl = inc - run;
#pragma unroll
        for (int i = 0; i < 32; ++i) cum[(size_t)bh * SEQ + lane * 32 + i] = excl + loc[i];
    }
}

#define XB_TMO      128
#define XB_XCNT(j)  (256  + 64 * (j))
#define XB_XSUB(j)  (1280 + 64 * (j))
#define XB_XGEN(j)  (2304 + 64 * (j))
#define XB_TOP      3328
#define XB_TOPGEN   3392
#define XCD_BAR_WORDS 3456
#define XB_SPIN_CAP (1u << 18)

__device__ __forceinline__ unsigned xb_ld(unsigned* p)              { return __hip_atomic_load(p, __ATOMIC_RELAXED, __HIP_MEMORY_SCOPE_AGENT); }
__device__ __forceinline__ unsigned xb_add(unsigned* p, unsigned v) { return __hip_atomic_fetch_add(p, v, __ATOMIC_RELAXED, __HIP_MEMORY_SCOPE_AGENT); }
__device__ __forceinline__ unsigned xb_xcc_id() { return (unsigned)__builtin_amdgcn_s_getreg((3 << 11) | 20) & 0xFu; }
#define XB_SPIN(cond, bar) do { unsigned _sp = 0; while (cond) { __builtin_amdgcn_s_sleep(1); \
    if ((++_sp & 255u) == 0u) { if (xb_ld(&(bar)[XB_TMO])) break; if (_sp > XB_SPIN_CAP) { atomicAdd(&(bar)[XB_TMO], 1u); break; } } } } while (0)

struct XcdBarrier {
    unsigned* bar; unsigned x;
    volatile LAS unsigned* st;
};

__device__ __forceinline__ XcdBarrier xcd_barrier_post(unsigned* bar, volatile LAS unsigned* st) {
    XcdBarrier b; b.bar = bar; b.x = xb_xcc_id(); b.st = st;
    if (threadIdx.x == 0) (void)xb_add(&bar[XB_XCNT(b.x)], 1u);
    return b;
}
__device__ __forceinline__ void xcd_barrier_complete(unsigned* bar, unsigned x, unsigned& nloc, unsigned& nx) {
    const unsigned G = gridDim.x * gridDim.y * gridDim.z;
    unsigned sum, cnt, mine, sp = 0u;
    for (;;) {
        sum = 0u; cnt = 0u; mine = 0u;
#pragma unroll
        for (unsigned j = 0; j < 16; ++j) { const unsigned c = xb_ld(&bar[XB_XCNT(j)]); sum += c; cnt += (c > 0u) ? 1u : 0u; mine = (j == x) ? c : mine; }
        if (sum == G) break;
        __builtin_amdgcn_s_sleep(1);
        if ((++sp & 255u) == 0u) { if (xb_ld(&bar[XB_TMO])) break; if (sp > XB_SPIN_CAP) { atomicAdd(&bar[XB_TMO], 1u); break; } }
    }
    nloc = mine > 0u ? mine : 1u; nx = cnt > 0u ? cnt : 1u;
}

__device__ __forceinline__ void xcd_barrier(const XcdBarrier& b) {
    asm volatile("s_waitcnt vmcnt(0)" ::: "memory");
    __syncthreads();
    if (threadIdx.x == 0) {
        unsigned* bar = b.bar;
        __builtin_amdgcn_s_waitcnt(0);
        unsigned nloc = b.st[0], nx = b.st[1];
        if (nloc == 0u) { xcd_barrier_complete(bar, b.x, nloc, nx); b.st[0] = nloc; b.st[1] = nx; }
        const unsigned old = xb_add(&bar[XB_XSUB(b.x)], 1u);
        const unsigned gen = old / nloc;
        if (old + 1u == (gen + 1u) * nloc) {
            __builtin_amdgcn_fence(__ATOMIC_RELEASE, "agent");
            asm volatile("s_waitcnt vmcnt(0)" ::: "memory");
            const unsigned og = xb_add(&bar[XB_TOP], 1u);
            const unsigned tg = og / nx;
            if (og + 1u == (tg + 1u) * nx) xb_add(&bar[XB_TOPGEN], 1u);
            else XB_SPIN(xb_ld(&bar[XB_TOPGEN]) == tg, bar);
            __builtin_amdgcn_fence(__ATOMIC_ACQUIRE, "agent");
            xb_add(&bar[XB_XGEN(b.x)], 1u);
            asm volatile("s_waitcnt vmcnt(0)" ::: "memory");
        } else {
            XB_SPIN(xb_ld(&bar[XB_XGEN(b.x)]) == gen, bar);
            __builtin_amdgcn_fence(__ATOMIC_ACQUIRE, "agent");
            asm volatile("s_waitcnt vmcnt(0)" ::: "memory");
        }
    }
    __syncthreads();
}


typedef short mm_bf16x8 __attribute__((ext_vector_type(8)));
constexpr int MXS = 136;

__device__ __forceinline__ void gmlp_mfma(const bf16* proj, const float* vgain, const float* wsp, const float* bs, bf16* mix, unsigned char* lds_) {
    bf16* Wl = (bf16*)lds_;
    bf16* Vt = (bf16*)lds_ + 128 * MXS;
    for (int item = blockIdx.x; item < 256; item += gridDim.x) {
        OPAQUE_TID();
        const int g = item & 3, n = (item >> 2) & 15, b = item >> 6;
        const size_t row0 = (size_t)b * SEQ + n * 128;
        { const float* wg = wsp + (size_t)g * 128 * 128;
#pragma unroll 4
          for (int i = 0; i < 8; ++i) { const int e = (i * 512 + tid) * 4, t = e >> 7, s = e & 127;
              const f32x4 w = *(const f32x4*)(wg + e);
              v2u o; o.x = pk2(s <= t ? w[0] : 0.f, s + 1 <= t ? w[1] : 0.f); o.y = pk2(s + 2 <= t ? w[2] : 0.f, s + 3 <= t ? w[3] : 0.f);
              *(v2u*)(Wl + t * MXS + s) = o; } }
        for (int i = 0; i < 16; ++i) { const int s = wave * 16 + i;
            const unsigned w = *(const unsigned*)(proj + (row0 + s) * NPROJ + 3584 + g * 128 + 2 * lane);
            const float v0 = gelu_tanh(bflo(w)), v1 = gelu_tanh(bfhi(w));
            const float ss = wave_sum(v0 * v0 + v1 * v1); const float rinv = 1.0f / sqrtf(ss * (1.0f / 128.0f) + EPS);
            Vt[(2 * lane) * MXS + s] = (bf16)f2bf(v0 * rinv * vgain[g * 128 + 2 * lane]); Vt[(2 * lane + 1) * MXS + s] = (bf16)f2bf(v1 * rinv * vgain[g * 128 + 2 * lane + 1]); }
        __syncthreads();
        { const int fr = lane & 15, fq = lane >> 4;
          f32x4 acc[8];
#pragma unroll
          for (int cb = 0; cb < 8; ++cb) acc[cb] = (f32x4){0.f, 0.f, 0.f, 0.f};
          const int nkc = (16 * (wave + 1) + 31) >> 5;
          for (int kc = 0; kc < nkc; ++kc) {
              const mm_bf16x8 af = *(const mm_bf16x8*)(Wl + (16 * wave + fr) * MXS + kc * 32 + fq * 8);
#pragma unroll
              for (int cb = 0; cb < 8; ++cb) { const mm_bf16x8 bf = *(const mm_bf16x8*)(Vt + (16 * cb + fr) * MXS + kc * 32 + fq * 8);
                  acc[cb] = __builtin_amdgcn_mfma_f32_16x16x32_bf16(bf, af, acc[cb], 0, 0, 0); } }
          const int t = 16 * wave + fr; const float bt = bs[g * 128 + t];
#pragma unroll
          for (int cb = 0; cb < 8; ++cb) { const int c = 16 * cb + 4 * fq;
              const v2u uw = *(const v2u*)(proj + (row0 + t) * NPROJ + 3072 + g * 128 + c);
              v2u o; o.x = pk2(gelu_tanh(bflo(uw.x)) * (acc[cb][0] + bt), gelu_tanh(bfhi(uw.x)) * (acc[cb][1] + bt));
              o.y = pk2(gelu_tanh(bflo(uw.y)) * (acc[cb][2] + bt), gelu_tanh(bfhi(uw.y)) * (acc[cb][3] + bt));
              *(v2u*)(mix + (row0 + t) * DM + 1024 + g * 128 + c) = o; } }
        __syncthreads();
    }
}

__device__ __forceinline__ void pool_mfma(const bf16* proj, const float* pw, const float* pscale, bf16* mix, unsigned char* lds_) {
    bf16* Wt = (bf16*)lds_;
    bf16* Dl = (bf16*)lds_ + 128 * MXS;
    for (int item = blockIdx.x; item < 256; item += gridDim.x) {
        OPAQUE_TID();
        const int g = item & 3, tb = item >> 2; const size_t row0 = (size_t)tb * 128; const int sbase = (tb * 128) % SEQ;
        const int win = 2 << g;
        { const float* wg = pw + (size_t)g * 128 * 128;
#pragma unroll 4
          for (int i = 0; i < 8; ++i) { const int e = (i * 512 + tid) * 4, c = e >> 7, dd = e & 127;
              const f32x4 w = *(const f32x4*)(wg + e);
              Wt[(dd + 0) * MXS + c] = (bf16)f2bf(w[0]); Wt[(dd + 1) * MXS + c] = (bf16)f2bf(w[1]); Wt[(dd + 2) * MXS + c] = (bf16)f2bf(w[2]); Wt[(dd + 3) * MXS + c] = (bf16)f2bf(w[3]); } }
        { const int r0 = wave * 16; const bf16* xp = proj + 4096 + g * 128 + 2 * lane;
          float x0[31], x1[31];
#pragma unroll
          for (int k = 0; k < 31; ++k) { const int r = r0 - 15 + k; unsigned w = 0u;
              if (sbase + r >= 0) w = *(const unsigned*)(xp + (size_t)((long)row0 + r) * NPROJ);
              x0[k] = bflo(w); x1[k] = bfhi(w); }
#pragma unroll
          for (int i = 0; i < 16; ++i) { const int k = i + 15, s = sbase + r0 + i;
              float s0 = 0.f, s1 = 0.f;
#pragma unroll
              for (int j = 0; j < 16; ++j) { if (j < win) { s0 += x0[k - j]; s1 += x1[k - j]; } }
              const int cnt = (s + 1 < win) ? (s + 1) : win; const float ic = 1.0f / (float)cnt;
              *(unsigned*)(Dl + (r0 + i) * MXS + 2 * lane) = pk2(s0 * ic - x0[k], s1 * ic - x1[k]); } }
        __syncthreads();
        { const int fr = lane & 15, fq = lane >> 4;
          f32x4 acc[8];
#pragma unroll
          for (int db = 0; db < 8; ++db) acc[db] = (f32x4){0.f, 0.f, 0.f, 0.f};
#pragma unroll
          for (int kc = 0; kc < 4; ++kc) {
              const mm_bf16x8 af = *(const mm_bf16x8*)(Dl + (16 * wave + fr) * MXS + kc * 32 + fq * 8);
#pragma unroll
              for (int db = 0; db < 8; ++db) { const mm_bf16x8 bf = *(const mm_bf16x8*)(Wt + (16 * db + fr) * MXS + kc * 32 + fq * 8);
                  acc[db] = __builtin_amdgcn_mfma_f32_16x16x32_bf16(bf, af, acc[db], 0, 0, 0); } }
          const int s = 16 * wave + fr;
#pragma unroll
          for (int db = 0; db < 8; ++db) { const int dd = 16 * db + 4 * fq; const f32x4 sc = *(const f32x4*)(pscale + g * 128 + dd);
              v2u o; o.x = pk2(acc[db][0] * sc[0], acc[db][1] * sc[1]); o.y = pk2(acc[db][2] * sc[2], acc[db][3] * sc[3]);
              *(v2u*)(mix + (row0 + s) * DM + 1536 + g * 128 + dd) = o; } }
        __syncthreads();
    }
}

namespace fa {
constexpr int D = 128;
constexpr float THR = 8.f;
constexpr bool WSKIP = false;
constexpr int KVP = 4608, QP = 4608, OP = 2048;
constexpr float SCALE = 0.08838834764831845f;
constexpr int NW = 8, QBLK = 32, KVBLK = 64, QB = NW * QBLK;
constexpr int SHM_V = KVBLK * D * 2, SHM_K = KVBLK * D * 2;
constexpr int BIAS_OFF = 2 * SHM_V + 2 * SHM_K + NW * 64 * 4;
constexpr int Q_OFF = BIAS_OFF + 2048 * 4;
constexpr int FA_LDS_BYTES = Q_OFF + 8 * 8192;

typedef short bf16x8 __attribute__((ext_vector_type(8)));
typedef short s16x4 __attribute__((ext_vector_type(4)));
typedef float f32x16 __attribute__((ext_vector_type(16)));
typedef float f32x4 __attribute__((ext_vector_type(4)));
typedef unsigned u32x4 __attribute__((ext_vector_type(4)));
template <class A, class Bt> struct same_t { static constexpr bool v = false; };
template <class A> struct same_t<A, A> { static constexpr bool v = true; };

#define KSWZ(row, colB) ((row) * 256 + ((colB) ^ (((row) & 7) << 4)))
#define SBAR() __builtin_amdgcn_sched_barrier(0)
__device__ __forceinline__ int v_st(int k, int c) { const int kk = (k & ~0xC) | ((k & 4) << 1) | ((k & 8) >> 1); return ((kk >> 3) * 4 + (c >> 5)) * 512 + ((kk & 7) * 32 + (c & 31)) * 2; }
__device__ __forceinline__ int v_rd_base(int lane) { return ((lane & 3) << 3) | (((lane >> 2) & 3) << 6) | (((lane >> 4) & 1) << 5) | (((lane >> 5) & 1) << 8); }
constexpr int v_rd_off(int d0, int ks, int half) { return d0 * 512 + ks * 4096 + half * 2048; }
__device__ __forceinline__ int crow(int r, int hi) { return (r & 3) + 8 * (r >> 2) + 4 * hi; }
__device__ __forceinline__ unsigned cvtpk(float lo, float hi) {
    unsigned r; asm volatile("v_cvt_pk_bf16_f32 %0, %1, %2" : "=v"(r) : "v"(lo), "v"(hi)); return r;
}
__device__ __forceinline__ bf16x8 pack8(f32x4 a, f32x4 b) {
    u32x4 w = {cvtpk(a[0], a[1]), cvtpk(a[2], a[3]), cvtpk(b[0], b[1]), cvtpk(b[2], b[3])};
    return *reinterpret_cast<bf16x8*>(&w);
}
template <class T> __device__ __forceinline__ bf16x8 load8(const T* p) {
    if constexpr (same_t<T, float>::v) { return pack8(*(const f32x4*)p, *(const f32x4*)(p + 4)); }
    else { return *reinterpret_cast<const bf16x8*>(p); }
}
__device__ __forceinline__ void mask_tile(f32x16& p0, f32x16& p1, int dq, unsigned W) {
    const float NEG = -__builtin_inff();
#pragma unroll
    for (int r = 0; r < 16; ++r) {
        const int c = (r & 3) + 8 * (r >> 2);
        if ((unsigned)(dq - c) >= W) p0[r] = NEG;
        if ((unsigned)(dq - c - 32) >= W) p1[r] = NEG;
    }
}
__device__ __forceinline__ void partialSM(f32x16& p0, f32x16& p1, float& m_reg, float& mn, float& alpha) {
    float pmax = p0[0]; for (int r = 1; r < 16; ++r) pmax = fmaxf(pmax, p0[r]); for (int r = 0; r < 16; ++r) pmax = fmaxf(pmax, p1[r]);
    { auto rr = __builtin_amdgcn_permlane32_swap(__float_as_uint(pmax), __float_as_uint(pmax), false, false);
      pmax = fmaxf(__uint_as_float(rr[0]), __uint_as_float(rr[1])); }
    constexpr float C2 = 1.4426950408889634f * SCALE;
    if (__builtin_expect(__all((pmax - m_reg) * SCALE <= THR), 1)) { mn = m_reg; alpha = 1.f; }
    else { mn = fmaxf(m_reg, pmax); alpha = __builtin_amdgcn_exp2f((m_reg - mn) * C2); m_reg = mn; }
    const float mnL = -mn * C2;
    for (int r = 0; r < 16; ++r) p0[r] = fmaf(p0[r], C2, mnL); for (int r = 0; r < 16; ++r) p1[r] = fmaf(p1[r], C2, mnL);
    for (int r = 0; r < 16; ++r) p0[r] = __builtin_amdgcn_exp2f(p0[r]);
}
__device__ __forceinline__ void finishSM(f32x16& p0, f32x16& p1, float alpha, float& l_reg, bf16x8& pa0, bf16x8& pa1, bf16x8& pa2, bf16x8& pa3) {
    for (int r = 0; r < 16; ++r) p1[r] = __builtin_amdgcn_exp2f(p1[r]);
    float ps = 0; for (int r = 0; r < 16; ++r) ps += p0[r]; for (int r = 0; r < 16; ++r) ps += p1[r];
    { auto rr = __builtin_amdgcn_permlane32_swap(__float_as_uint(ps), __float_as_uint(ps), false, false);
      ps = __uint_as_float(rr[0]) + __uint_as_float(rr[1]); }
    l_reg = l_reg * alpha + ps;
#define PK4(P, B_, OUT) do { unsigned a0 = cvtpk(P[B_+0], P[B_+1]), a1 = cvtpk(P[B_+2], P[B_+3]);                          \
        unsigned b0 = cvtpk(P[B_+4], P[B_+5]), b1 = cvtpk(P[B_+6], P[B_+7]);                                             \
        auto r0 = __builtin_amdgcn_permlane32_swap(a0, b0, false, false); auto r1 = __builtin_amdgcn_permlane32_swap(a1, b1, false, false); \
        u32x4 w = {r0[0], r1[0], r0[1], r1[1]}; OUT = *reinterpret_cast<bf16x8*>(&w); } while (0)
    PK4(p0, 0, pa0); PK4(p0, 8, pa1); PK4(p1, 0, pa2); PK4(p1, 8, pa3);
#undef PK4
}
template <int KB, bool SK>
__device__ __forceinline__ void qkt(f32x16& p0, f32x16& p1, const char* K_lds, int r32, int hi, const char* Qw, bool act, const float* bt) {
    if (SK && !act) { const float NEG = -__builtin_inff();
#pragma unroll
        for (int r = 0; r < 16; ++r) { p0[r] = NEG; p1[r] = NEG; } return; }
#pragma unroll
    for (int g_ = 0; g_ < 4; ++g_) { const f32x4 b0_ = *(const f32x4*)(bt + 8 * g_), b1_ = *(const f32x4*)(bt + 32 + 8 * g_);
#pragma unroll
        for (int j_ = 0; j_ < 4; ++j_) { p0[4 * g_ + j_] = b0_[j_]; p1[4 * g_ + j_] = b1_[j_]; } }
    const char* kb[4];
#pragma unroll
    for (int dd = 0; dd < 4; ++dd) kb[dd] = K_lds + KB * SHM_K + KSWZ(r32, (dd * 16 + hi * 8) * 2);
#pragma unroll
    for (int d0 = 0; d0 < 8; ++d0) { const char* a = kb[d0 & 3] + (d0 >> 2) * 128;
        bf16x8 b0 = *reinterpret_cast<const bf16x8*>(a);
        bf16x8 b1 = *reinterpret_cast<const bf16x8*>(a + 32 * 256);
        const bf16x8 q_ = *reinterpret_cast<const bf16x8*>(Qw + KSWZ(r32, ((d0 & 3) * 16 + hi * 8) * 2) + (d0 >> 2) * 128);
        p0 = __builtin_amdgcn_mfma_f32_32x32x16_bf16(b0, q_, p0, 0, 0, 0);
        p1 = __builtin_amdgcn_mfma_f32_32x32x16_bf16(b1, q_, p1, 0, 0, 0); }
}
template <int VB, bool SK>
__device__ __forceinline__ void pv_tile(f32x16* o, int vb0, bf16x8 pa0, bf16x8 pa1, bf16x8 pa2, bf16x8 pa3, bool act) {
    if (SK && !act) return;
#define TRRD(dst, off) asm volatile("ds_read_b64_tr_b16 %0, %1 offset:%2" : "=&v"(dst) : "v"(vb0), "i"(off) : "memory")
#define PV_D0(d0) do { s16x4 l0, l1, l2, l3, h0, h1, h2, h3; constexpr int b_ = VB * SHM_V + v_rd_off(d0, 0, 0);     \
        TRRD(l0, b_); TRRD(h0, b_ + 2048); TRRD(l1, b_ + 4096); TRRD(h1, b_ + 6144); TRRD(l2, b_ + 8192); TRRD(h2, b_ + 10240); TRRD(l3, b_ + 12288); TRRD(h3, b_ + 14336); \
        asm volatile("s_waitcnt lgkmcnt(0)" ::: "memory"); SBAR();                 \
        o[d0] = __builtin_amdgcn_mfma_f32_32x32x16_bf16(pa0, (bf16x8){l0[0], l0[1], l0[2], l0[3], h0[0], h0[1], h0[2], h0[3]}, o[d0], 0, 0, 0);   \
        o[d0] = __builtin_amdgcn_mfma_f32_32x32x16_bf16(pa1, (bf16x8){l1[0], l1[1], l1[2], l1[3], h1[0], h1[1], h1[2], h1[3]}, o[d0], 0, 0, 0);   \
        o[d0] = __builtin_amdgcn_mfma_f32_32x32x16_bf16(pa2, (bf16x8){l2[0], l2[1], l2[2], l2[3], h2[0], h2[1], h2[2], h2[3]}, o[d0], 0, 0, 0);   \
        o[d0] = __builtin_amdgcn_mfma_f32_32x32x16_bf16(pa3, (bf16x8){l3[0], l3[1], l3[2], l3[3], h3[0], h3[1], h3[2], h3[3]}, o[d0], 0, 0, 0); } while (0)
    PV_D0(0); PV_D0(1); PV_D0(2); PV_D0(3);
#undef PV_D0
#undef TRRD
}

template <class TIn, class TOut> struct BlockRef { const TIn* Q; const TIn* K; const TIn* V; TOut* O; int P0; };
template <class TIn> struct Seam {
    bf16x8 st_v0, st_v1, st_k0, st_k1; f32x4 sf0, sf1, sf2, sf3;
    f32x4 tq[16];
};
__device__ __forceinline__ int swa_jlo(int P0, int W) { const int lowk = P0 - W + 1; return lowk > 0 ? lowk / KVBLK : 0; }
#define ROW(p, k0, rr) ((p) + (size_t)((k0) + (rr)) * KVP + sc)
#define VMW() asm volatile("s_waitcnt vmcnt(0)" ::: "memory")
#define VMWN(n) asm volatile("s_waitcnt vmcnt(%0)" :: "i"(n) : "memory")
#define SLOAD_H(Kp, Vp, k0) do { S.st_v0 = load8<TIn>(ROW(Vp, k0, sr)); S.st_v1 = load8<TIn>(ROW(Vp, k0, 32 + sr));              \
                         S.st_k0 = load8<TIn>(ROW(Kp, k0, sr)); S.st_k1 = load8<TIn>(ROW(Kp, k0, 32 + sr)); } while (0)
#define SWRITE_HK(bf) do { *(bf16x8*)(K_lds + (bf) * SHM_K + kws) = S.st_k0; *(bf16x8*)(K_lds + (bf) * SHM_K + kws + 32 * 256) = S.st_k1; } while (0)
#define SWRITE_HV(bf) do { *(bf16x8*)(V_lds + (bf) * SHM_V + vst0) = S.st_v0; *(bf16x8*)(V_lds + (bf) * SHM_V + vst1) = S.st_v1; } while (0)
#define SWRITE_H(bf) do { SWRITE_HV(bf); SWRITE_HK(bf); } while (0)
#define SLOAD_F(p, k0) do { S.sf0 = *(const f32x4*)ROW(p, k0, sr); S.sf1 = *(const f32x4*)(ROW(p, k0, sr) + 4);                \
                            S.sf2 = *(const f32x4*)ROW(p, k0, 32 + sr); S.sf3 = *(const f32x4*)(ROW(p, k0, 32 + sr) + 4); } while (0)
#define SWRITE_KF(bf) do { *(bf16x8*)(K_lds + (bf) * SHM_K + kws) = pack8(S.sf0, S.sf1); *(bf16x8*)(K_lds + (bf) * SHM_K + kws + 32 * 256) = pack8(S.sf2, S.sf3); } while (0)
#define SWRITE_VF(bf) do { *(bf16x8*)(V_lds + (bf) * SHM_V + vst0) = pack8(S.sf0, S.sf1); *(bf16x8*)(V_lds + (bf) * SHM_V + vst1) = pack8(S.sf2, S.sf3); } while (0)
template <class TIn, class TOut>
__device__ __forceinline__ void causal_swa_prime(const BlockRef<TIn, TOut>& cur, int W, char* lds, Seam<TIn>& S, int tid_in) {
    constexpr bool F32 = same_t<TIn, float>::v;
    const int tid = tid_in, wid = __builtin_amdgcn_readfirstlane(tid >> 6), lane = tid & 63, r32 = lane & 31, hi = lane >> 5;
    const int sr = tid >> 4, sc = (tid & 15) * 8, kws = KSWZ(sr, sc * 2); char* K_lds = lds + 2 * SHM_V;
    const int kb0 = swa_jlo(cur.P0, W) * KVBLK;
    { char* Qw_ = lds + Q_OFF + wid * 8192;
#pragma unroll
      for (int d0 = 0; d0 < 8; ++d0) *(bf16x8*)(Qw_ + KSWZ(r32, ((d0 & 3) * 16 + hi * 8) * 2) + (d0 >> 2) * 128) = load8<TIn>(cur.Q + (size_t)(wid * QBLK + r32) * QP + d0 * 16 + hi * 8); }
    if constexpr (F32) { SLOAD_F((const float*)cur.K, kb0); VMW(); SWRITE_KF(0); SBAR(); SLOAD_F((const float*)cur.V, kb0); }
    else { SLOAD_H(cur.K, cur.V, kb0); VMW(); SWRITE_HK(0); }
    __syncthreads();
}
template <class TIn, class TOut>
__device__ __forceinline__ void causal_swa_block(const BlockRef<TIn, TOut>& cur, const BlockRef<TIn, TOut>& nxt, int skv, int W, char* lds, Seam<TIn>& S, int tid_in) {
    constexpr bool F32 = same_t<TIn, float>::v;
    const int tid = tid_in, wid = __builtin_amdgcn_readfirstlane(tid >> 6), lane = tid & 63, r32 = lane & 31, hi = lane >> 5;
    const int j_lo = swa_jlo(cur.P0, W);
    int j_hi = (cur.P0 + QB - 1) / KVBLK + 1; if (j_hi > skv / KVBLK) j_hi = skv / KVBLK;
    const int NT = j_hi - j_lo;
    const int kbn = swa_jlo(nxt.P0, W) * KVBLK;
    const int qlo = cur.P0 + wid * QBLK, qm = qlo + r32 - 4 * hi;
    char* V_lds = lds; char* K_lds = lds + 2 * SHM_V;
    float* ws = (float*)(lds + 2 * SHM_V + 2 * SHM_K) + wid * 64; float* li_l = ws, * al_l = ws + 32;
    const float* bias_l = (const float*)(lds + BIAS_OFF) + 4 * hi;
    const char* Qw_lds = lds + Q_OFF + wid * 8192;
    float m_reg = -1e30f, l_reg = 0; f32x16 o[4] = {};
    const int sr = tid >> 4, sc = (tid & 15) * 8, vst0 = v_st(sr, sc), vst1 = v_st(32 + sr, sc), kws = KSWZ(sr, sc * 2);
    const int vb0 = (int)(uintptr_t)V_lds + v_rd_base(lane);
    const TIn* Kh = cur.K; const TIn* Vh = cur.V;
#define RESC(a) do { if (__any((a) < 1.f)) { if (hi == 0) al_l[r32] = (a); asm volatile("s_waitcnt lgkmcnt(0)" ::: "memory");              \
                     for (int d_ = 0; d_ < 4; ++d_) for (int r = 0; r < 16; ++r) o[d_][r] *= al_l[crow(r, hi)]; } } while (0)
#define KBASE(t) ((j_lo + (t)) * KVBLK)
#define ACT(t) (KBASE(t) <= qlo + QBLK - 1 && KBASE(t) + KVBLK - 1 >= qlo - W + 1)
#define MASKT(P0_, P1_, t) do { const int kb_ = KBASE(t); if ((!SK || ACT(t)) && (kb_ + KVBLK - 1 > qlo || kb_ <= qlo + QBLK - 1 - W)) mask_tile(P0_, P1_, qm - kb_, (unsigned)W); } while (0)
    constexpr int NQL = F32 ? 16 : 0;
    constexpr bool SK = WSKIP && !F32;
#define SEAM_K0() do { VMWN(NQL); if constexpr (F32) { SWRITE_KF(0); SBAR(); SLOAD_F((const float*)nxt.V, kbn); } else { SWRITE_HK(0); } SBAR(); } while (0)
    f32x16 pA0, pA1, pB0, pB1; float mnA, mnB, alA, alB; bf16x8 pa0, pa1, pa2, pa3;
    if constexpr (F32) { VMW(); SWRITE_VF(0); SBAR(); } else { SWRITE_HV(0); SBAR(); }
    if (NT > 1) { if constexpr (F32) SLOAD_F((const float*)Kh, KBASE(1)); else SLOAD_H(Kh, Vh, KBASE(1)); }
    SBAR(); qkt<0, SK>(pA0, pA1, K_lds, r32, hi, Qw_lds, ACT(0), bias_l + KBASE(0));
    if constexpr (F32) { if (NT > 1) { VMW(); SWRITE_KF(1); SBAR(); SLOAD_F((const float*)Vh, KBASE(1)); } }
    MASKT(pA0, pA1, 0); partialSM(pA0, pA1, m_reg, mnA, alA);
    if (NT > 1) { VMW(); if constexpr (F32) { SWRITE_VF(1); SBAR(); if (NT > 2) SLOAD_F((const float*)Kh, KBASE(2)); } else SWRITE_H(1); }
    __syncthreads();
#define HALF_STEP(PX0, PX1, mnX, alX, PY0, PY1, alY, t, KB, VB, SB) do {                                                      \
        SBAR(); qkt<KB, SK>(PX0, PX1, K_lds, r32, hi, Qw_lds, ACT(t), bias_l + KBASE(t));                                             \
        finishSM(PY0, PY1, alY, l_reg, pa0, pa1, pa2, pa3); SBAR();                                                           \
        if ((t) + 1 < NT) { if constexpr (F32) { VMW(); SWRITE_KF(SB); SBAR(); SLOAD_F((const float*)Vh, KBASE((t) + 1)); }  \
                            else { SLOAD_H(Kh, Vh, KBASE((t) + 1)); } SBAR(); }                                               \
        pv_tile<VB, SK>(o, vb0, pa0, pa1, pa2, pa3, ACT((t) - 1)); MASKT(PX0, PX1, (t)); partialSM(PX0, PX1, m_reg, mnX, alX);                                        \
        __syncthreads();                                                                                                      \
        if ((t) + 1 < NT) { VMW(); if constexpr (F32) { SWRITE_VF(SB); SBAR(); if ((t) + 2 < NT) SLOAD_F((const float*)Kh, KBASE((t) + 2)); } \
                            else { SWRITE_H(SB); } }                                                                          \
        RESC(alX); __syncthreads(); } while (0)
    for (int t = 1; t + 1 < NT; t += 2) {
        HALF_STEP(pB0, pB1, mnB, alB, pA0, pA1, alA, t, 1, 0, 0);
        HALF_STEP(pA0, pA1, mnA, alA, pB0, pB1, alB, t + 1, 0, 1, 1);
    }
    const bool even = (NT & 1) == 0;
    if (even) { SBAR(); qkt<1, SK>(pB0, pB1, K_lds, r32, hi, Qw_lds, ACT(NT - 1), bias_l + KBASE(NT - 1)); SBAR(); }
#define QROW(e) (nxt.Q + (size_t)(wid * QBLK + r32) * QP + ((e) >> 1) * 16 + hi * 8 + ((e) & 1) * 4)
    if constexpr (F32) { SLOAD_F((const float*)nxt.K, kbn); SBAR();
#pragma unroll
        for (int e = 0; e < 8; ++e) S.tq[e] = *(const f32x4*)QROW(e); }
    else { SLOAD_H(nxt.K, nxt.V, kbn); SBAR(); }
    SBAR();
    finishSM(pA0, pA1, alA, l_reg, pa0, pa1, pa2, pa3); SBAR();
    if constexpr (F32) {
#pragma unroll
        for (int e = 8; e < 16; ++e) S.tq[e] = *(const f32x4*)QROW(e); SBAR(); }
#undef QROW
    pv_tile<0, SK>(o, vb0, pa0, pa1, pa2, pa3, ACT(even ? NT - 2 : NT - 1));
    if (even) { MASKT(pB0, pB1, NT - 1); partialSM(pB0, pB1, m_reg, mnB, alB); __syncthreads(); RESC(alB);
        finishSM(pB0, pB1, alB, l_reg, pa0, pa1, pa2, pa3); SBAR(); pv_tile<1, SK>(o, vb0, pa0, pa1, pa2, pa3, ACT(NT - 1)); }
    SBAR(); SEAM_K0();
    if (hi == 0) li_l[r32] = l_reg; asm volatile("s_waitcnt lgkmcnt(0)" ::: "memory");
    float rli[16];
#pragma unroll
    for (int r = 0; r < 16; ++r) rli[r] = __builtin_amdgcn_rcpf(li_l[crow(r, hi)]);
    TOut* Ow = cur.O + (size_t)(wid * QBLK) * OP;
#pragma unroll
    for (int r = 0; r < 16; ++r) { const int orow = crow(r, hi);
#pragma unroll
        for (int d0 = 0; d0 < 4; ++d0) { const float v = o[d0][r] * rli[r];
            if constexpr (same_t<TOut, float>::v) { Ow[(size_t)orow * OP + d0 * 32 + r32] = v; }
            else { const float vn = __shfl_xor(v, 1);
                   if ((r32 & 1) == 0) *(unsigned*)(Ow + (size_t)orow * OP + d0 * 32 + r32) = cvtpk(v, vn); } } }
    if constexpr (F32) {
#pragma unroll
        for (int d0 = 0; d0 < 8; ++d0) (void)S.tq[2 * d0]; }
    __syncthreads();
#undef RESC
#undef KBASE
#undef ACT
#undef MASKT
#undef SEAM_K0
#undef HALF_STEP
}
#undef ROW
#undef VMW
#undef VMWN
#undef SLOAD_H
#undef SWRITE_HK
#undef SWRITE_HV
#undef SWRITE_H
#undef SLOAD_F
#undef SWRITE_KF
#undef SWRITE_VF

#undef KSWZ
#undef SBAR
}

__device__ __forceinline__ void attn_phase(const bf16* proj, const float* cum, bf16* mix, unsigned char* lds_) {
    char* lds = (char*)lds_;
    for (int item = blockIdx.x; item < 256; item += gridDim.x) {
        OPAQUE_TID();
        const int bh = (item & 7) * 4 + ((item >> 3) & 3), qb = 7 - (item >> 5);
        const int b = bh >> 3, hh = bh & 7;
        float* bias = (float*)(lds + fa::BIAS_OFF);
        const float* cb = cum + (size_t)bh * SEQ;
        const int nk = (qb + 1) * 256;
        for (int s = tid; s < nk; s += 512) bias[s] = -cb[s] * (1.0f / fa::SCALE);
        fa::BlockRef<bf16, bf16> cur;
        cur.Q = proj + (size_t)(b * SEQ + qb * 256) * NPROJ + hh * 128; cur.K = proj + (size_t)(b * SEQ) * NPROJ + 1024 + hh * 128; cur.V = cur.K + 1024;
        cur.O = mix + (size_t)(b * SEQ + qb * 256) * DM + hh * 128; cur.P0 = qb * 256;
        fa::Seam<bf16> S;
        fa::causal_swa_prime<bf16, bf16>(cur, SEQ, lds, S, tid);
        fa::causal_swa_block<bf16, bf16>(cur, cur, SEQ, SEQ, lds, S, tid);
    }
}

__global__ void __launch_bounds__(512, 2) fwd(Args a) {
    extern __shared__ __attribute__((aligned(16))) unsigned char lds[];
    cg::grid_group grid = cg::this_grid();
#define OPQ_WS() opq_ptr(a.ws)
#define XN ((bf16*)(OPQ_WS() + WS_XN))
#define PROJ ((bf16*)(OPQ_WS() + WS_PROJ))
#define MIX ((bf16*)(OPQ_WS() + WS_MIX))
#define ACT ((bf16*)(OPQ_WS() + WS_ACT))
#define PP ((bf16*)(OPQ_WS() + WS_PP))
#define PBF ((bf16*)(OPQ_WS() + WS_PBF))
#define LOGF ((float*)(OPQ_WS() + WS_LOGF))
#define CUM ((float*)(OPQ_WS() + WS_CUM))
#define H ((float*)opq_ptr((unsigned char*)a.out))
    PG8_LAS unsigned char* ring = (PG8_LAS unsigned char*)lds;
    const int G = gridDim.x, bx = blockIdx.x;
    { volatile LAS unsigned* st0 = (volatile LAS unsigned*)((LAS unsigned char*)lds + XB_LDS_OFF); if (threadIdx.x < 2) st0[threadIdx.x] = 0u; }
    __syncthreads();
    const XcdBarrier xbar = xcd_barrier_post((unsigned*)(a.ws + WS_BAR), (volatile LAS unsigned*)((LAS unsigned char*)lds + XB_LDS_OFF));
#define GRID_SYNC() xcd_barrier(xbar)

    for (int rep_ = 0; rep_ < REP_PRO; ++rep_) prologue_weights(a, (LAS unsigned char*)lds);
    norm_phase(a.in[I_X], a.in[I_NORM_MIX], XN, true, a.in[I_W_IN], a.in[I_FBIAS], LOGF, lds);
    grid.sync();

#pragma unroll 1
    for (int L = 0; L < DEPTH; ++L) {
#define WL(off) ((const bf16*)(OPQ_WS() + WS_W + (size_t)L * SZ_LAYER + (off)))
#define Win WL(OFF_WIN)
#define Wout WL(OFF_WOUT)
#define Wgu WL(OFF_WGU)
#define Wdn WL(OFF_WDN)
#define Wpg WL(OFF_WPG)
#define Wpp WL(OFF_WPP)
        for (int rep_ = 0; rep_ < REP_A; ++rep_) {
        { pg8::Gemm g{XN, Win, M, NPROJ, DM}; pg8::StaticOrder S; S.init(M, NPROJ, G, bx);
          pg8::EpiBf16<0> E{PROJ, NPROJ, nullptr, 0, 0, 1.f};
          pg8::gemm_phase<pg8::EpiBf16<0>, pg8::StaticOrder, true, true>(ring, g, S, E); }
        { pg8::Gemm g{PBF + (size_t)L * M * DPLE, Wpp, M, DM, DPLE}; pg8::StaticOrder S; S.init(M, DM, G, bx);
          pg8::EpiBf16<0> E{PP, DM, nullptr, 0, 0, 1.f};
          pg8::gemm_phase<pg8::EpiBf16<0>, pg8::StaticOrder, true, true>(ring, g, S, E); }
        }
        GRID_SYNC();
        post_phase(PROJ, a.in[I_Q_NORM] + L * 128, a.in[I_K_NORM] + L * 128, LOGF, CUM);
        GRID_SYNC();
        for (int rep_ = 0; rep_ < REP_C; ++rep_) {
        gmlp_mfma(PROJ, a.in[I_GV_NORM] + L * 512, a.in[I_G_WS] + (size_t)L * 4 * 128 * 128, a.in[I_G_BS] + L * 512, MIX, lds);
        pool_mfma(PROJ, a.in[I_POOL_W] + (size_t)L * 4 * 128 * 128, a.in[I_POOL_SCALE] + L * 512, MIX, lds);
        for (int rep2_ = 0; rep2_ < REP_ATT; ++rep2_) attn_phase(PROJ, CUM, MIX, lds);
        }
        for (int rep_ = 0; rep_ < REP_SYNC; ++rep_) GRID_SYNC();
        { pg8::Gemm g{MIX, Wout, M, DM, DM}; pg8::StaticOrder S; S.init(M, DM, G, bx);
          pg8::EpiRes E{L == 0 ? a.in[I_X] : H, H, DM};
          pg8::gemm_phase<pg8::EpiRes, pg8::StaticOrder, true, true>(ring, g, S, E); }
        GRID_SYNC();
        for (int rep_ = 0; rep_ < REP_N; ++rep_) norm_phase(H, a.in[I_NORM_FFN] + L * DM, XN, false, nullptr, nullptr, nullptr, lds);
        GRID_SYNC();
        for (int rep_ = 0; rep_ < REP_F; ++rep_) { pg8::Gemm g{XN, Wgu, M, NGU, DM}; pg8::StaticOrder S; S.init(M, NGU, G, bx);
          pg8::EpiSwiglu E{ACT, DFF};
          pg8::gemm_phase<pg8::EpiSwiglu, pg8::StaticOrder, true, true>(ring, g, S, E); }
        GRID_SYNC();
        { pg8::Gemm g{ACT, Wdn, M, DM, DFF}; pg8::StaticOrder S; S.init(M, DM, G, bx);
          pg8::EpiRes E{H, H, DM};
          pg8::gemm_phase<pg8::EpiRes, pg8::StaticOrder, true, true>(ring, g, S, E); }
        GRID_SYNC();
        for (int rep_ = 0; rep_ < REP_N; ++rep_) norm_phase(H, a.in[I_NORM_PLE] + L * DM, XN, false, nullptr, nullptr, nullptr, lds);
        GRID_SYNC();
        { pg8::Gemm g{XN, Wpg, M, DM, DM}; pg8::StaticOrder S; S.init(M, DM, G, bx);
          pg8::EpiPle E{H, H, PP, DM};
          pg8::gemm_phase<pg8::EpiPle, pg8::StaticOrder, true, true>(ring, g, S, E); }
        if (L + 1 < DEPTH) {
            GRID_SYNC();
            norm_phase(H, a.in[I_NORM_MIX] + (L + 1) * DM, XN, true, a.in[I_W_IN] + (size_t)(L + 1) * DM * DPROJ_SRC, a.in[I_FBIAS] + (L + 1) * 8, LOGF, lds);
            GRID_SYNC();
        }
    }
}

extern "C" void kernel_launch(void* const* d_in, const int* in_sizes, int n_in, void* d_out, int out_size, void* d_ws, size_t ws_size, hipStream_t stream) {
    static int grid = 0;
    if (grid == 0) {
        if (n_in != 20 || out_size != M * DM || ws_size < WS_END) { fprintf(stderr, "kernel_launch: unexpected shapes (n_in %d out %d ws %zu, need %zu)\n", n_in, out_size, ws_size, (size_t)WS_END); grid = -1; return; }
        int dev = 0, cus = 0, per_cu = 0;
        (void)hipGetDevice(&dev); (void)hipDeviceGetAttribute(&cus, hipDeviceAttributeMultiprocessorCount, dev);
        if (hipFuncSetAttribute((const void*)fwd, hipFuncAttributeMaxDynamicSharedMemorySize, LDS_BYTES) != hipSuccess) fprintf(stderr, "kernel_launch: hipFuncSetAttribute failed\n");
        if (hipOccupancyMaxActiveBlocksPerMultiprocessor(&per_cu, (const void*)fwd, 512, LDS_BYTES) != hipSuccess || per_cu < 1) { fprintf(stderr, "kernel_launch: occupancy query gave %d\n", per_cu); per_cu = 1; }
        (void)hipGetLastError();
        if (cus <= 0) cus = 256;
        grid = cus * per_cu;
    }
    if (grid < 0) return;
    Args a{};
    for (int i = 0; i < 20; ++i) a.in[i] = (const float*)d_in[i];
    a.out = (float*)d_out; a.ws = (unsigned char*)d_ws;
    if (hipMemsetAsync((char*)d_ws + WS_BAR, 0, XCD_BAR_WORDS * 4, stream) != hipSuccess) fprintf(stderr, "kernel_launch: memset of barrier words failed\n");
    void* args[] = {&a};
    hipError_t e = hipLaunchCooperativeKernel((void*)fwd, dim3(grid), dim3(512), args, LDS_BYTES, stream);
    if (e != hipSuccess) fprintf(stderr, "cooperative launch failed: %s (grid %d)\n", hipGetErrorString(e), grid);
}
```

```cpp
#include <hip/hip_runtime.h>
#include <hip/hip_cooperative_groups.h>
#include <cstdio>
#include <cstdint>
namespace cg = cooperative_groups;
#ifndef REP_PRO
#define REP_PRO 1
#define REP_A 1
#define REP_C 1
#define REP_ATT 1
#define REP_F 1
#define REP_N 1
#define REP_SYNC 1
#endif
namespace pg8 {
#define PG8_LAS __attribute__((address_space(3)))
typedef unsigned short bf16_t;
typedef short bf16x8 __attribute__((ext_vector_type(8)));
typedef float f32x4 __attribute__((ext_vector_type(4)));
typedef unsigned u32x4 __attribute__((ext_vector_type(4)));
constexpr int BM = 256, BK = 64, HALF = 128, HTB = HALF * BK * 2  , STAGE_BYTES = 8 * HTB, NXCD = 8, WGM = 8;

__host__ __device__ __forceinline__ int lds_byte(int r, int c) { const int st = (r >> 4) * 2 + (c >> 5), rr = r & 15, cc = c & 31, ob = rr * 64 + cc * 2; return st * 1024 + (ob ^ (((ob >> 9) & 1) << 5)); }
__host__ __device__ __forceinline__ void stage_rc(int b, int& R, int& C) { const int st = b / 1024, sb = b % 1024, swz = sb ^ (((sb >> 9) & 1) << 5); R = (st >> 1) * 16 + swz / 64; C = (st & 1) * 32 + (swz % 64) / 2; }
__host__ __device__ __forceinline__ int perm32(int rho) { const int n = rho >> 4, i = rho & 15; return 8 * (i >> 2) + 4 * n + (i & 3); }

struct Unit { int pm, pn; };
struct Gemm { const bf16_t* A; const bf16_t* Bt; int M, N, K; };

struct StaticOrder {
    int nM, nN, nwg, G, c;
    __host__ __device__ void init(int M, int N, int G_, int c_) { nM = M / BM; nN = N / BM; nwg = nM * nN; G = G_; c = c_; }
    __host__ __device__ bool next(int i, Unit& u) const {
        const long L = (long)i * G + c; if (L >= nwg) return false;
        int wgid = (int)L; { const int q = nwg / NXCD, r = nwg % NXCD, xcd = wgid % NXCD, off = wgid / NXCD; wgid = (xcd < r ? xcd * (q + 1) : r * (q + 1) + (xcd - r) * q) + off; }
        const int nig = WGM * nN, gid = wgid / nig, fm = gid * WGM, gsz = (nM - fm) < WGM ? (nM - fm) : WGM;
        u.pm = fm + ((wgid % nig) % gsz); u.pn = (wgid % nig) / gsz; return true;
    }
    __device__ __forceinline__ void a_ready(const Unit&) const {}
    __device__ __forceinline__ void done(const Unit&) const {}
};

__device__ __forceinline__ unsigned cvt_pk_bf16(float lo, float hi) { unsigned r; asm volatile("v_cvt_pk_bf16_f32 %0, %1, %2" : "=v"(r) : "v"(lo), "v"(hi)); return r; }
typedef float f32x2 __attribute__((ext_vector_type(2)));
__device__ __forceinline__ f32x2 gelu_pk(f32x2 v) {
    const f32x2 av = __builtin_elementwise_abs(v), d = av * 0.2316418882f + 1.0f;
    f32x2 t; t.x = __builtin_amdgcn_rcpf(d.x); t.y = __builtin_amdgcn_rcpf(d.y);
    f32x2 q = t * 0.5307027145f + (-0.7265760135f); q = q * t + 0.7107068705f; q = q * t + (-0.142248368f); q = q * t + 0.127414796f; q = q * t;
    const f32x2 s = (v * v) * (-0.72134752044f);
    f32x2 e; e.x = __builtin_amdgcn_exp2f(s.x); e.y = __builtin_amdgcn_exp2f(s.y);
    const f32x2 m = v * (q * e), r = v - m;
    f32x2 o; o.x = v.x < 0.f ? m.x : r.x; o.y = v.y < 0.f ? m.y : r.y; return o;
}

template <int ACT  > struct EpiBf16 {
    static constexpr bool PERM = true, AFTER_DRAIN = false; static_assert(ACT == 0 || ACT == 1, "EpiBf16: ACT is 0 (none) or 1 (gelu_pk)");
    bf16_t* O; int ldc; const float* bias; int split_cols; size_t split_stride; float scale0;
    __device__ __forceinline__ void operator()(const f32x4 (&acc)[2][2][4][2], const Unit& u, int wr, int wc, int fr, int fq) const {
        const int row0 = u.pm * BM + wr * 64 + fr; int colt = u.pn * BM; bf16_t* base = O;
        float sc = 1.f; if (split_cols) { const int t = colt / split_cols; base += (size_t)t * split_stride; colt -= t * split_cols; if (t == 0) sc = scale0; }
        const int col0 = colt + wc * 32 + 8 * fq, bcol0 = u.pn * BM + wc * 32 + 8 * fq;
        f32x4 bv[2][2];
#pragma unroll
        for (int bj = 0; bj < 2; ++bj)
#pragma unroll
            for (int n = 0; n < 2; ++n) bv[bj][n] = bias ? *(const f32x4*)(bias + bcol0 + bj * HALF + 4 * n) : (f32x4){0.f, 0.f, 0.f, 0.f};
#pragma unroll
        for (int ai = 0; ai < 2; ++ai)
#pragma unroll
            for (int m = 0; m < 4; ++m) { bf16_t* rowp = base + (size_t)(row0 + ai * HALF + m * 16) * ldc + col0;
#pragma unroll
                for (int bj = 0; bj < 2; ++bj) { f32x4 v0 = acc[ai][bj][m][0] + bv[bj][0], v1 = acc[ai][bj][m][1] + bv[bj][1];
                    if (ACT == 1) { f32x2 a = gelu_pk((f32x2){v0[0], v0[1]}), b = gelu_pk((f32x2){v0[2], v0[3]}), c = gelu_pk((f32x2){v1[0], v1[1]}), d = gelu_pk((f32x2){v1[2], v1[3]});
                        v0 = (f32x4){a.x, a.y, b.x, b.y}; v1 = (f32x4){c.x, c.y, d.x, d.y}; }
                    v0 = v0 * sc; v1 = v1 * sc; u32x4 w; w.x = cvt_pk_bf16(v0[0], v0[1]); w.y = cvt_pk_bf16(v0[2], v0[3]); w.z = cvt_pk_bf16(v1[0], v1[1]); w.w = cvt_pk_bf16(v1[2], v1[3]);
                    *(u32x4*)(rowp + bj * HALF) = w; } }
    }
};
typedef unsigned u32x2 __attribute__((ext_vector_type(2)));
__device__ __forceinline__ float bf_lo(unsigned w) { return __uint_as_float(w << 16); }
__device__ __forceinline__ float bf_hi(unsigned w) { return __uint_as_float(w & 0xffff0000u); }
__device__ __forceinline__ float sigmoidf_(float x) { return 1.0f / (1.0f + __expf(-x)); }
struct EpiRes {
    static constexpr bool PERM = false, AFTER_DRAIN = false;
    const float* base; float* out; int ldc;
    __device__ __forceinline__ void operator()(const f32x4 (&acc)[2][2][4][2], const Unit& u, int wr, int wc, int fr, int fq) const {
        const int col0 = u.pn * BM + wc * 32 + 4 * fq;
#pragma unroll
        for (int ai = 0; ai < 2; ++ai)
#pragma unroll
            for (int m = 0; m < 4; ++m) { const size_t off = (size_t)(u.pm * BM + ai * HALF + wr * 64 + m * 16 + fr) * ldc + col0;
#pragma unroll
                for (int bj = 0; bj < 2; ++bj)
#pragma unroll
                    for (int n = 0; n < 2; ++n) { const f32x4 bs = *(const f32x4*)(base + off + bj * HALF + n * 16); *(f32x4*)(out + off + bj * HALF + n * 16) = bs + acc[ai][bj][m][n]; }
                asm volatile("" ::: "memory"); }
    }
};
struct EpiPle {
    static constexpr bool PERM = false, AFTER_DRAIN = false;
    const float* base; float* out; const bf16_t* pp; int ldc;
    __device__ __forceinline__ void operator()(const f32x4 (&acc)[2][2][4][2], const Unit& u, int wr, int wc, int fr, int fq) const {
        const int col0 = u.pn * BM + wc * 32 + 4 * fq;
#pragma unroll
        for (int ai = 0; ai < 2; ++ai)
#pragma unroll
            for (int m = 0; m < 4; ++m) { const size_t off = (size_t)(u.pm * BM + ai * HALF + wr * 64 + m * 16 + fr) * ldc + col0;
#pragma unroll
                for (int bj = 0; bj < 2; ++bj)
#pragma unroll
                    for (int n = 0; n < 2; ++n) { const f32x4 bs = *(const f32x4*)(base + off + bj * HALF + n * 16); const u32x2 pw = *(const u32x2*)(pp + off + bj * HALF + n * 16);
                        const f32x4 a = acc[ai][bj][m][n]; f32x4 o;
                        o[0] = bs[0] + bf_lo(pw.x) * sigmoidf_(a[0]); o[1] = bs[1] + bf_hi(pw.x) * sigmoidf_(a[1]);
                        o[2] = bs[2] + bf_lo(pw.y) * sigmoidf_(a[2]); o[3] = bs[3] + bf_hi(pw.y) * sigmoidf_(a[3]);
                        *(f32x4*)(out + off + bj * HALF + n * 16) = o; }
                asm volatile("" ::: "memory"); }
    }
};
struct EpiSwiglu {
    static constexpr bool PERM = true, AFTER_DRAIN = false;
    bf16_t* O; int ldc;
    __device__ __forceinline__ void operator()(const f32x4 (&acc)[2][2][4][2], const Unit& u, int wr, int wc, int fr, int fq) const {
        const int col0 = u.pn * HALF + wc * 32 + 8 * fq;
#pragma unroll
        for (int ai = 0; ai < 2; ++ai)
#pragma unroll
            for (int m = 0; m < 4; ++m) { bf16_t* rowp = O + (size_t)(u.pm * BM + ai * HALF + wr * 64 + m * 16 + fr) * ldc + col0;
                float r[8];
#pragma unroll
                for (int n = 0; n < 2; ++n)
#pragma unroll
                    for (int j = 0; j < 4; ++j) { const float g = acc[ai][0][m][n][j], up = acc[ai][1][m][n][j]; r[n * 4 + j] = g * sigmoidf_(g) * up; }
                u32x4 w; w.x = cvt_pk_bf16(r[0], r[1]); w.y = cvt_pk_bf16(r[2], r[3]); w.z = cvt_pk_bf16(r[4], r[5]); w.w = cvt_pk_bf16(r[6], r[7]);
                *(u32x4*)rowp = w; asm volatile("" ::: "memory"); }
    }
};
template <class Epi, class Sched, bool ALIGN_EPI = false, bool SP2 = false>
__device__ __forceinline__ void gemm_phase(PG8_LAS unsigned char* lds, const Gemm g, const Sched& S, const Epi& E) {
    int tid_ = threadIdx.x; asm volatile("" : "+v"(tid_));
    const int tid = tid_, wid = __builtin_amdgcn_readfirstlane(tid >> 6), lane = tid & 63, wr = wid >> 2, wc = wid & 3, fr = lane & 15, fq = lane >> 4;
    const int K = g.K, nt = K / BK;
    unsigned voffA[2], voffB[2];
#pragma unroll
    for (int i = 0; i < 2; ++i) { int R, C; stage_rc(tid * 16 + i * 8192, R, C); const int Rb = Epi::PERM ? ((R & ~31) + perm32(R & 31)) : R;
        voffA[i] = (unsigned)(R * K + C) * 2u; voffB[i] = (unsigned)(Rb * K + C) * 2u; }
    const size_t kstep = (size_t)(BK * 2);
    const size_t hstep = (size_t)HALF * K * 2;
    const size_t tstep = 2 * hstep;
    const unsigned ldsw = (unsigned)wid * 1024u;
    const int aoff = lds_byte(wr * 64 + fr, fq * 8), boff = lds_byte(wc * 32 + fr, fq * 8);
#define PG8_SA(b, h) (((b) * 2 + (h)) * HTB)
#define PG8_SB(b, h) ((4 + (b) * 2 + (h)) * HTB)
#define PG8_STAGE(bufoff, gbase, voff) do { _Pragma("unroll") for (int _i = 0; _i < 2; ++_i) \
        __builtin_amdgcn_global_load_lds((const unsigned*)((const char*)(gbase) + (voff)[_i]), (PG8_LAS unsigned*)(lds + (bufoff) + ldsw + _i * 8192), 16, 0, 0); } while (0)
#define PG8_LDA(dst, b, h) do { _Pragma("unroll") for (int m = 0; m < 4; ++m) _Pragma("unroll") for (int k = 0; k < 2; ++k) dst[m][k] = *(const PG8_LAS bf16x8*)(lds + PG8_SA(b, h) + aoff + m * 2048 + k * 1024); } while (0)
#define PG8_LDB(dst, b, h) do { _Pragma("unroll") for (int n = 0; n < 2; ++n) _Pragma("unroll") for (int k = 0; k < 2; ++k) dst[n][k] = *(const PG8_LAS bf16x8*)(lds + PG8_SB(b, h) + boff + n * 2048 + k * 1024); } while (0)
#define PG8_MMA(ai, bj, At, Bt) do { __builtin_amdgcn_s_setprio(1); _Pragma("unroll") for (int m = 0; m < 4; ++m) _Pragma("unroll") for (int n = 0; n < 2; ++n) _Pragma("unroll") for (int k = 0; k < 2; ++k) \
        acc[ai][bj][m][n] = __builtin_amdgcn_mfma_f32_16x16x32_bf16(Bt[n][k], At[m][k], acc[ai][bj][m][n], 0, 0, 0); __builtin_amdgcn_s_setprio(0); } while (0)
#define PG8_WAIT_V(n) asm volatile("s_waitcnt vmcnt(" #n ")" ::: "memory")
#define PG8_WAIT_L(n) asm volatile("s_waitcnt lgkmcnt(" #n ")" ::: "memory")
#define PG8_BAR __builtin_amdgcn_s_barrier()
#define PG8_SCHED __builtin_amdgcn_sched_barrier(0)
    Unit cur, nxt; int ui = 0;
    if (!S.next(0, cur)) return;
    f32x4 acc[2][2][4][2];
#pragma unroll
    for (int a = 0; a < 2; ++a)
#pragma unroll
        for (int b = 0; b < 2; ++b)
#pragma unroll
            for (int m = 0; m < 4; ++m)
#pragma unroll
                for (int n = 0; n < 2; ++n) acc[a][b][m][n] = (f32x4){0.f, 0.f, 0.f, 0.f};
    bf16x8 At[4][2], B0[2][2], B1[2][2];
    const char* cA = (const char*)g.A + (size_t)cur.pm * tstep; const char* cB = (const char*)g.Bt + (size_t)cur.pn * tstep;
    S.a_ready(cur);
    if constexpr (SP2) {
        PG8_STAGE(PG8_SB(0, 0), cB, voffB); PG8_STAGE(PG8_SB(0, 1), cB + hstep, voffB); PG8_STAGE(PG8_SA(0, 0), cA, voffA); PG8_STAGE(PG8_SA(0, 1), cA + hstep, voffA);
        if (wr == 1) PG8_BAR;
        PG8_WAIT_V(2); PG8_BAR;
        PG8_STAGE(PG8_SB(1, 0), cB + kstep, voffB); PG8_STAGE(PG8_SA(1, 0), cA + kstep, voffA); PG8_STAGE(PG8_SB(1, 1), cB + hstep + kstep, voffB);
        PG8_WAIT_V(6); PG8_BAR;
    } else {
        PG8_STAGE(PG8_SB(0, 0), cB, voffB); PG8_STAGE(PG8_SA(0, 0), cA, voffA); PG8_STAGE(PG8_SB(0, 1), cB + hstep, voffB); PG8_STAGE(PG8_SA(0, 1), cA + hstep, voffA);
        if (wr == 1) PG8_BAR;
        PG8_WAIT_V(4); PG8_BAR;
        PG8_STAGE(PG8_SB(1, 0), cB + kstep, voffB); PG8_STAGE(PG8_SA(1, 0), cA + kstep, voffA); PG8_STAGE(PG8_SB(1, 1), cB + hstep + kstep, voffB);
        PG8_WAIT_V(6); PG8_BAR;
    }
    for (;;) {
        const bool has_next = S.next(ui + 1, nxt);
        const char* nA = has_next ? (const char*)g.A + (size_t)nxt.pm * tstep : cA; const char* nB = has_next ? (const char*)g.Bt + (size_t)nxt.pn * tstep : cB;
        for (int t = 0; t < nt; t += 2) {
            const bool last = (t == nt - 2);
            const char* a1 = cA + (size_t)(t + 1) * kstep;
            const char* a2 = last ? nA : cA + (size_t)(t + 2) * kstep; const char* b2 = last ? nB : cB + (size_t)(t + 2) * kstep;
            const char* a3 = a2 + kstep; const char* b3 = b2 + kstep;
            if (last && has_next) S.a_ready(nxt);
            if constexpr (SP2) {
            PG8_LDB(B0, 0, 0); PG8_LDB(B1, 0, 1); PG8_SCHED; PG8_LDA(At, 0, 0); PG8_STAGE(PG8_SA(1, 1), a1 + hstep, voffA);
            PG8_WAIT_V(8); PG8_WAIT_L(0); PG8_BAR; PG8_MMA(0, 0, At, B0); PG8_MMA(0, 1, At, B1); PG8_BAR; PG8_SCHED;
            PG8_LDA(At, 0, 1); PG8_STAGE(PG8_SB(0, 0), b2, voffB); PG8_STAGE(PG8_SB(0, 1), b2 + hstep, voffB); PG8_STAGE(PG8_SA(0, 0), a2, voffA);
            PG8_WAIT_V(8); PG8_WAIT_L(0); PG8_BAR; PG8_MMA(1, 0, At, B0); PG8_MMA(1, 1, At, B1); PG8_BAR; PG8_SCHED;
            PG8_LDB(B0, 1, 0); PG8_LDB(B1, 1, 1); PG8_SCHED; PG8_LDA(At, 1, 0); PG8_STAGE(PG8_SA(0, 1), a2 + hstep, voffA);
            PG8_WAIT_V(8); PG8_WAIT_L(0); PG8_BAR; PG8_MMA(0, 0, At, B0); PG8_MMA(0, 1, At, B1); PG8_BAR; PG8_SCHED;
            PG8_LDA(At, 1, 1); PG8_STAGE(PG8_SB(1, 0), b3, voffB); PG8_STAGE(PG8_SB(1, 1), b3 + hstep, voffB); PG8_STAGE(PG8_SA(1, 0), a3, voffA);
            PG8_WAIT_V(8); PG8_WAIT_L(0); PG8_BAR; PG8_MMA(1, 0, At, B0); PG8_MMA(1, 1, At, B1); PG8_BAR; PG8_SCHED;
            } else {
            PG8_LDB(B0, 0, 0); PG8_SCHED; PG8_LDA(At, 0, 0); PG8_STAGE(PG8_SA(1, 1), a1 + hstep, voffA);
            PG8_WAIT_L(8); PG8_BAR; PG8_WAIT_L(0); PG8_MMA(0, 0, At, B0); PG8_BAR; PG8_SCHED;
            PG8_LDB(B1, 0, 1); PG8_STAGE(PG8_SB(0, 0), b2, voffB);
            PG8_BAR; PG8_WAIT_L(0); PG8_MMA(0, 1, At, B1); PG8_BAR;
            PG8_LDA(At, 0, 1); PG8_STAGE(PG8_SA(0, 0), a2, voffA);
            PG8_BAR; PG8_WAIT_L(0); PG8_MMA(1, 0, At, B0); PG8_BAR; PG8_SCHED;
            PG8_STAGE(PG8_SB(0, 1), b2 + hstep, voffB);
            PG8_WAIT_V(6); PG8_BAR; PG8_MMA(1, 1, At, B1); PG8_BAR;
            PG8_LDB(B0, 1, 0); PG8_SCHED; PG8_LDA(At, 1, 0); PG8_STAGE(PG8_SA(0, 1), a2 + hstep, voffA);
            PG8_WAIT_L(8); PG8_BAR; PG8_WAIT_L(0); PG8_MMA(0, 0, At, B0); PG8_BAR; PG8_SCHED;
            PG8_LDB(B1, 1, 1); PG8_STAGE(PG8_SB(1, 0), b3, voffB);
            PG8_BAR; PG8_WAIT_L(0); PG8_MMA(0, 1, At, B1); PG8_BAR;
            PG8_LDA(At, 1, 1); PG8_STAGE(PG8_SA(1, 0), a3, voffA);
            PG8_BAR; PG8_WAIT_L(0); PG8_MMA(1, 0, At, B0); PG8_BAR; PG8_SCHED;
            PG8_STAGE(PG8_SB(1, 1), b3 + hstep, voffB);
            PG8_WAIT_V(6); PG8_BAR; PG8_MMA(1, 1, At, B1); PG8_BAR;
            }
        }
        if constexpr (ALIGN_EPI) { if (wr == 0) PG8_BAR; }
        if constexpr (!Epi::AFTER_DRAIN) { E(acc, cur, wr, wc, fr, fq); S.done(cur); }
        if (!has_next) break;
#pragma unroll
        for (int a = 0; a < 2; ++a)
#pragma unroll
            for (int b = 0; b < 2; ++b)
#pragma unroll
                for (int m = 0; m < 4; ++m)
#pragma unroll
                    for (int n = 0; n < 2; ++n) acc[a][b][m][n] = (f32x4){0.f, 0.f, 0.f, 0.f};
        cur = nxt; cA = nA; cB = nB; ++ui;
        if constexpr (ALIGN_EPI) { if (wr == 1) PG8_BAR; }
    }
    PG8_WAIT_V(0);
    if constexpr (!ALIGN_EPI) { if (wr == 0) PG8_BAR; }
    PG8_BAR;
    if constexpr (Epi::AFTER_DRAIN) { E.fused(acc, cur, wr, wc, fr, fq, lds, wid, lane); S.done(cur); }
#undef PG8_SA
#undef PG8_SB
#undef PG8_STAGE
#undef PG8_LDA
#undef PG8_LDB
#undef PG8_MMA
#undef PG8_WAIT_V
#undef PG8_WAIT_L
#undef PG8_BAR
#undef PG8_SCHED
}
}

constexpr int M = 8192, DM = 2048, SEQ = 2048, NPROJ = 4608, DPROJ_SRC = 4616, DFF = 5632, NGU = 11264, DPLE = 256, DEPTH = 4;
constexpr size_t SZ_WIN = (size_t)NPROJ * DM * 2, SZ_WOUT = (size_t)DM * DM * 2, SZ_WGU = (size_t)NGU * DM * 2, SZ_WDN = (size_t)DM * DFF * 2, SZ_WPG = SZ_WOUT, SZ_WPP = (size_t)DM * DPLE * 2;
constexpr size_t OFF_WIN = 0, OFF_WOUT = OFF_WIN + SZ_WIN, OFF_WGU = OFF_WOUT + SZ_WOUT, OFF_WDN = OFF_WGU + SZ_WGU, OFF_WPG = OFF_WDN + SZ_WDN, OFF_WPP = OFF_WPG + SZ_WPG, SZ_LAYER = OFF_WPP + SZ_WPP;
constexpr size_t WS_W = 1u << 20, WS_XN = WS_W + DEPTH * SZ_LAYER, WS_PROJ = WS_XN + (size_t)M * DM * 2, WS_MIX = WS_PROJ + (size_t)M * NPROJ * 2, WS_ACT = WS_MIX + (size_t)M * DM * 2,
                 WS_PP = WS_ACT + (size_t)M * DFF * 2, WS_PBF = WS_PP + (size_t)M * DM * 2, WS_LOGF = WS_PBF + (size_t)DEPTH * M * DPLE * 2, WS_CUM = WS_LOGF + (size_t)M * 8 * 4, WS_END = WS_CUM + (size_t)M * 8 * 4;
constexpr int LDS_BYTES = 147456;
constexpr int XB_LDS_OFF = LDS_BYTES - 64;
constexpr size_t WS_BAR = 4096;
constexpr float EPS = 1e-6f;

typedef unsigned short bf16;
typedef unsigned v4u __attribute__((ext_vector_type(4)));
typedef unsigned v2u __attribute__((ext_vector_type(2)));
typedef float f32x4 __attribute__((ext_vector_type(4)));
#define LAS __attribute__((address_space(3)))
#define LDS_WAIT() asm volatile("s_waitcnt lgkmcnt(0)" ::: "memory")
#define OPAQUE_TID() int tid; { int t_ = threadIdx.x; asm volatile("" : "+v"(t_)); tid = t_; } const int lane = tid & 63, wave = __builtin_amdgcn_readfirstlane(tid >> 6); (void)lane; (void)wave

__device__ __forceinline__ unsigned f2bf(float f) { unsigned u = __builtin_bit_cast(unsigned, f); return (u + 0x7fffu + ((u >> 16) & 1u)) >> 16; }
__device__ __forceinline__ unsigned pk2(float lo, float hi) { return f2bf(lo) | (f2bf(hi) << 16); }
__device__ __forceinline__ float bflo(unsigned w) { return __uint_as_float(w << 16); }
__device__ __forceinline__ float bfhi(unsigned w) { return __uint_as_float(w & 0xffff0000u); }
__device__ __forceinline__ float bf2f(bf16 v) { return __uint_as_float((unsigned)v << 16); }
__device__ __forceinline__ float wave_sum(float v) {
#pragma unroll
    for (int o = 1; o < 64; o <<= 1) v += __shfl_xor(v, o);
    return v;
}
__device__ __forceinline__ float gelu_tanh(float x) { const float y2 = 1.5957691216057308f * (x + 0.044715f * x * x * x); return x / (1.0f + __expf(-y2)); }
__device__ __forceinline__ float log_sigmoid(float x) { return fminf(x, 0.f) - __logf(1.0f + __expf(-fabsf(x))); }

__device__ __forceinline__ unsigned char* opq_ptr(unsigned char* p) { asm volatile("" : "+s"(p)); return p; }
struct Args { const float* in[20]; float* out; unsigned char* ws; };
enum { I_X = 0, I_P, I_NORM_MIX, I_W_IN, I_Q_NORM, I_K_NORM, I_FBIAS, I_GV_NORM, I_G_WS, I_G_BS, I_POOL_W, I_POOL_SCALE, I_W_OUT, I_NORM_FFN, I_W_GATE, I_W_UP, I_W_DOWN, I_NORM_PLE, I_W_PG, I_W_PP };

struct TrItem { const float* src; bf16* dst; int ldw, K; };
__device__ __forceinline__ TrItem tr_decode(const Args& a, int it) {
    constexpr int I_IN = 16 * 36, I_OUT = 16 * 16, I_GU = 16 * 88, I_DN = 44 * 16, I_PG = 16 * 16, I_PPN = 2 * 16, I_L = I_IN + I_OUT + I_GU + I_DN + I_PG + I_PPN;
    const int L = it / I_L; int r = it - L * I_L;
    unsigned char* wl = a.ws + WS_W + (size_t)L * SZ_LAYER;
    TrItem t;
    if (r < I_IN) { const int kb = r / 36, nb = r - kb * 36, n0 = nb * 128, c0 = n0 < 3072 ? n0 : n0 + 8;
        t.ldw = DPROJ_SRC; t.K = DM; t.src = a.in[I_W_IN] + (size_t)L * DM * DPROJ_SRC + (size_t)kb * 128 * DPROJ_SRC + c0; t.dst = (bf16*)(wl + OFF_WIN) + (size_t)n0 * DM + kb * 128; }
    else if ((r -= I_IN) < I_OUT) { const int kb = r / 16, nb = r - kb * 16, n0 = nb * 128;
        t.ldw = DM; t.K = DM; t.src = a.in[I_W_OUT] + (size_t)L * DM * DM + (size_t)kb * 128 * DM + n0; t.dst = (bf16*)(wl + OFF_WOUT) + (size_t)n0 * DM + kb * 128; }
    else if ((r -= I_OUT) < I_GU) { const int kb = r / 88, nb = r - kb * 88, n0 = nb * 128, tt = nb >> 1, half = nb & 1;
        t.ldw = DFF; t.K = DM; t.src = (half ? a.in[I_W_UP] : a.in[I_W_GATE]) + (size_t)L * DM * DFF + (size_t)kb * 128 * DFF + tt * 128; t.dst = (bf16*)(wl + OFF_WGU) + (size_t)n0 * DM + kb * 128; }
    else if ((r -= I_GU) < I_DN) { const int kb = r / 16, nb = r - kb * 16, n0 = nb * 128;
        t.ldw = DM; t.K = DFF; t.src = a.in[I_W_DOWN] + (size_t)L * DFF * DM + (size_t)kb * 128 * DM + n0; t.dst = (bf16*)(wl + OFF_WDN) + (size_t)n0 * DFF + kb * 128; }
    else if ((r -= I_DN) < I_PG) { const int kb = r / 16, nb = r - kb * 16, n0 = nb * 128;
        t.ldw = DM; t.K = DM; t.src = a.in[I_W_PG] + (size_t)L * DM * DM + (size_t)kb * 128 * DM + n0; t.dst = (bf16*)(wl + OFF_WPG) + (size_t)n0 * DM + kb * 128; }
    else { r -= I_PG; const int kb = r / 16, nb = r - kb * 16, n0 = nb * 128;
        t.ldw = DM; t.K = DPLE; t.src = a.in[I_W_PP] + (size_t)L * DPLE * DM + (size_t)kb * 128 * DM + n0; t.dst = (bf16*)(wl + OFF_WPP) + (size_t)n0 * DPLE + kb * 128; }
    return t;
}
constexpr int I_LAYER = 16 * 36 + 16 * 16 + 16 * 88 + 44 * 16 + 16 * 16 + 2 * 16;
__device__ __forceinline__ void convert_weights(const Args& a, LAS unsigned char* lds, int it_lo, int it_hi, int wg_i, int wg_n) {
    OPAQUE_TID();
    const int NITEMS = it_hi;
    constexpr int RSB = 272;
    const int ng = tid & 31, kg = tid >> 5;
    const int orow = tid >> 4, och = tid & 15;
    f32x4 v[8];
    int it = it_lo + wg_i;
    TrItem cur;
    if (it < NITEMS) { cur = tr_decode(a, it);
#pragma unroll
        for (int r = 0; r < 8; ++r) v[r] = *(const f32x4*)(cur.src + (size_t)(8 * kg + r) * cur.ldw + 4 * ng); }
    while (it < NITEMS) {
#pragma unroll
        for (int j = 0; j < 4; ++j) { v4u o; o.x = pk2(v[0][j], v[1][j]); o.y = pk2(v[2][j], v[3][j]); o.z = pk2(v[4][j], v[5][j]); o.w = pk2(v[6][j], v[7][j]);
            *(LAS v4u*)(lds + (4 * ng + j) * RSB + 16 * kg) = o; }
        __syncthreads();
        const int nit = it + wg_n; const TrItem out = cur;
        if (nit < NITEMS) { cur = tr_decode(a, nit);
#pragma unroll
            for (int r = 0; r < 8; ++r) v[r] = *(const f32x4*)(cur.src + (size_t)(8 * kg + r) * cur.ldw + 4 * ng); }
#pragma unroll
        for (int j = 0; j < 4; ++j) { const int n = orow + 32 * j; const v4u o = *(const LAS v4u*)(lds + n * RSB + 16 * och);
            *(v4u*)(out.dst + (size_t)n * out.K + 8 * och) = o; }
        __syncthreads();
        it = nit;
    }
}

__device__ __forceinline__ void convert_p(const Args& a) {
    OPAQUE_TID();
    { const size_t n8 = (size_t)DEPTH * M * DPLE / 8; const float* p = a.in[I_P]; bf16* pb = (bf16*)(a.ws + WS_PBF);
      for (size_t i = (size_t)blockIdx.x * 512 + tid; i < n8; i += (size_t)gridDim.x * 512) {
          const f32x4 x0 = *(const f32x4*)(p + i * 8), x1 = *(const f32x4*)(p + i * 8 + 4);
          v4u o; o.x = pk2(x0[0], x0[1]); o.y = pk2(x0[2], x0[3]); o.z = pk2(x1[0], x1[1]); o.w = pk2(x1[2], x1[3]);
          *(v4u*)(pb + i * 8) = o; } }
}

__device__ __forceinline__ void norm_phase(const float* h, const float* gain, bf16* xn, bool with_f, const float* win_l, const float* fbias, float* logf,
                                           unsigned char* lds) {
    OPAQUE_TID();
    float* wf = (float*)lds;
    if (with_f) {
        for (int c = tid; c < DM; c += 512) {
            const f32x4 x0 = *(const f32x4*)(win_l + (size_t)c * DPROJ_SRC + 3072), x1 = *(const f32x4*)(win_l + (size_t)c * DPROJ_SRC + 3076);
            wf[0 * DM + c] = x0[0]; wf[1 * DM + c] = x0[1]; wf[2 * DM + c] = x0[2]; wf[3 * DM + c] = x0[3];
            wf[4 * DM + c] = x1[0]; wf[5 * DM + c] = x1[1]; wf[6 * DM + c] = x1[2]; wf[7 * DM + c] = x1[3]; }
        __syncthreads();
    }
    const int gw = blockIdx.x * 8 + wave, NGW = gridDim.x * 8;
    f32x4 g[8];
#pragma unroll
    for (int j = 0; j < 8; ++j) g[j] = *(const f32x4*)(gain + 4 * lane + 256 * j);
    for (int row = gw; row < M; row += NGW) {
        const f32x4* xr = (const f32x4*)(h + (size_t)row * DM) + lane;
        f32x4 v[8]; float ss = 0.f;
#pragma unroll
        for (int j = 0; j < 8; ++j) { v[j] = xr[64 * j]; ss += (v[j][0] * v[j][0] + v[j][1] * v[j][1]) + (v[j][2] * v[j][2] + v[j][3] * v[j][3]); }
        ss = wave_sum(ss);
        const float rinv = 1.0f / sqrtf(ss * (1.0f / DM) + EPS);
        v2u* o8 = (v2u*)(xn + (size_t)row * DM) + lane;
#pragma unroll
        for (int j = 0; j < 8; ++j) { v[j] = v[j] * rinv * g[j]; v2u w; w.x = pk2(v[j][0], v[j][1]); w.y = pk2(v[j][2], v[j][3]); o8[64 * j] = w; }
        if (with_f) {
            float f[8];
#pragma unroll
            for (int hh = 0; hh < 8; ++hh) { float s = 0.f;
#pragma unroll
                for (int j = 0; j < 8; ++j) { const f32x4 w = *(const f32x4*)(wf + hh * DM + 4 * lane + 256 * j); s += (v[j][0] * w[0] + v[j][1] * w[1]) + (v[j][2] * w[2] + v[j][3] * w[3]); }
                f[hh] = wave_sum(s); asm volatile("" ::: "memory"); }
            float mine = f[0];
#pragma unroll
            for (int hh = 1; hh < 8; ++hh) mine = (lane == hh) ? f[hh] : mine;
            if (lane < 8) logf[(size_t)row * 8 + lane] = log_sigmoid(mine + fbias[lane]);
        }
    }
    if (with_f) __syncthreads();
}

__device__ __forceinline__ void post_phase(bf16* proj, const float* qg, const float* kg, const float* logf, float* cum) {
    OPAQUE_TID();
    const int gw = blockIdx.x * 8 + wave, NGW = gridDim.x * 8;
    const int d0 = 8 * (lane & 15);
    float gq[8], gk[8];
#pragma unroll
    for (int e = 0; e < 8; ++e) { gq[e] = qg[d0 + e]; gk[e] = kg[d0 + e]; }
    for (int row = gw; row < M; row += NGW) {
        v4u* pr = (v4u*)(proj + (size_t)row * NPROJ);
#pragma unroll
        for (int j = 0; j < 4; ++j) {
            const v4u w = pr[lane + 64 * j];
            float x[8] = {bflo(w.x), bfhi(w.x), bflo(w.y), bfhi(w.y), bflo(w.z), bfhi(w.z), bflo(w.w), bfhi(w.w)};
            float ss = 0.f;
#pragma unroll
            for (int e = 0; e < 8; ++e) ss += x[e] * x[e];
            ss += __shfl_xor(ss, 1); ss += __shfl_xor(ss, 2); ss += __shfl_xor(ss, 4); ss += __shfl_xor(ss, 8);
            const float rinv = 1.0f / sqrtf(ss * (1.0f / 128.0f) + EPS);
#pragma unroll
            for (int e = 0; e < 8; ++e) x[e] = x[e] * rinv * (j < 2 ? gq[e] : gk[e]);
            v4u o; o.x = pk2(x[0], x[1]); o.y = pk2(x[2], x[3]); o.z = pk2(x[4], x[5]); o.w = pk2(x[6], x[7]);
            pr[lane + 64 * j] = o;
        }
    }
    for (int bh = blockIdx.x; bh < 32; bh += gridDim.x) if (wave == 0) {
        const int b = bh >> 3, hh = bh & 7;
        float loc[32]; float run = 0.f;
#pragma unroll
        for (int i = 0; i < 32; ++i) { run += logf[((size_t)(b * SEQ + lane * 32 + i)) * 8 + hh]; loc[i] = run; }
        float inc = run;
#pragma unroll
        for (int o = 1; o < 64; o <<= 1) { const float t = __shfl_up(inc, o); if (lane >= o) inc += t; }
        const float excl = inc - run;
#pragma unroll
        for (int i = 0; i < 32; ++i) cum[(size_t)bh * SEQ + lane * 32 + i] = excl + loc[i];
    }
}

#define XB_TMO      128
#define XB_XCNT(j)  (256  + 64 * (j))
#define XB_XSUB(j)  (1280 + 64 * (j))
#define XB_XGEN(j)  (2304 + 64 * (j))
#define XB_TOP      3328
#define XB_TOPGEN   3392
#define XCD_BAR_WORDS 3456
#define XB_SPIN_CAP (1u << 18)

__device__ __forceinline__ unsigned xb_ld(unsigned* p)              { return __hip_atomic_load(p, __ATOMIC_RELAXED, __HIP_MEMORY_SCOPE_AGENT); }
__device__ __forceinline__ unsigned xb_add(unsigned* p, unsigned v) { return __hip_atomic_fetch_add(p, v, __ATOMIC_RELAXED, __HIP_MEMORY_SCOPE_AGENT); }
__device__ __forceinline__ unsigned xb_xcc_id() { return (unsigned)__builtin_amdgcn_s_getreg((3 << 11) | 20) & 0xFu; }
#define XB_SPIN(cond, bar) do { unsigned _sp = 0; while (cond) { __builtin_amdgcn_s_sleep(1); \
    if ((++_sp & 255u) == 0u) { if (xb_ld(&(bar)[XB_TMO])) break; if (_sp > XB_SPIN_CAP) { atomicAdd(&(bar)[XB_TMO], 1u); break; } } } } while (0)

struct XcdBarrier {
    unsigned* bar; unsigned x;
    volatile LAS unsigned* st;
};

__device__ __forceinline__ XcdBarrier xcd_barrier_post(unsigned* bar, volatile LAS unsigned* st) {
    XcdBarrier b; b.bar = bar; b.x = xb_xcc_id(); b.st = st;
    if (threadIdx.x == 0) (void)xb_add(&bar[XB_XCNT(b.x)], 1u);
    return b;
}
__device__ __forceinline__ void xcd_barrier_complete(unsigned* bar, unsigned x, unsigned& nloc, unsigned& nx) {
    const unsigned G = gridDim.x * gridDim.y * gridDim.z;
    unsigned sum, cnt, mine, sp = 0u;
    for (;;) {
        sum = 0u; cnt = 0u; mine = 0u;
#pragma unroll
        for (unsigned j = 0; j < 16; ++j) { const unsigned c = xb_ld(&bar[XB_XCNT(j)]); sum += c; cnt += (c > 0u) ? 1u : 0u; mine = (j == x) ? c : mine; }
        if (sum == G) break;
        __builtin_amdgcn_s_sleep(1);
        if ((++sp & 255u) == 0u) { if (xb_ld(&bar[XB_TMO])) break; if (sp > XB_SPIN_CAP) { atomicAdd(&bar[XB_TMO], 1u); break; } }
    }
    nloc = mine > 0u ? mine : 1u; nx = cnt > 0u ? cnt : 1u;
}

__device__ __forceinline__ void xcd_barrier(const XcdBarrier& b) {
    asm volatile("s_waitcnt vmcnt(0)" ::: "memory");
    __syncthreads();
    if (threadIdx.x == 0) {
        unsigned* bar = b.bar;
        __builtin_amdgcn_s_waitcnt(0);
        unsigned nloc = b.st[0], nx = b.st[1];
        if (nloc == 0u) { xcd_barrier_complete(bar, b.x, nloc, nx); b.st[0] = nloc; b.st[1] = nx; }
        const unsigned old = xb_add(&bar[XB_XSUB(b.x)], 1u);
        const unsigned gen = old / nloc;
        if (old + 1u == (gen + 1u) * nloc) {
            __builtin_amdgcn_fence(__ATOMIC_RELEASE, "agent");
            asm volatile("s_waitcnt vmcnt(0)" ::: "memory");
            const unsigned og = xb_add(&bar[XB_TOP], 1u);
            const unsigned tg = og / nx;
            if (og + 1u == (tg + 1u) * nx) xb_add(&bar[XB_TOPGEN], 1u);
            else XB_SPIN(xb_ld(&bar[XB_TOPGEN]) == tg, bar);
            __builtin_amdgcn_fence(__ATOMIC_ACQUIRE, "agent");
            xb_add(&bar[XB_XGEN(b.x)], 1u);
            asm volatile("s_waitcnt vmcnt(0)" ::: "memory");
        } else {
            XB_SPIN(xb_ld(&bar[XB_XGEN(b.x)]) == gen, bar);
            __builtin_amdgcn_fence(__ATOMIC_ACQUIRE, "agent");
            asm volatile("s_waitcnt vmcnt(0)" ::: "memory");
        }
    }
    __syncthreads();
}


typedef short mm_bf16x8 __attribute__((ext_vector_type(8)));
constexpr int MXS = 136;

__device__ __forceinline__ void gmlp_mfma(const bf16* proj, const float* vgain, const float* wsp, const float* bs, bf16* mix, unsigned char* lds_) {
    bf16* Wl = (bf16*)lds_;
    bf16* Vt = (bf16*)lds_ + 128 * MXS;
    const int half_ = gridDim.x >> 1;
    if ((int)blockIdx.x < half_) return;
    for (int item = blockIdx.x - half_; item < 256; item += gridDim.x - half_) {
        OPAQUE_TID();
        const int g = item & 3, n = (item >> 2) & 15, b = item >> 6;
        const size_t row0 = (size_t)b * SEQ + n * 128;
        { const float* wg = wsp + (size_t)g * 128 * 128;
#pragma unroll 4
          for (int i = 0; i < 8; ++i) { const int e = (i * 512 + tid) * 4, t = e >> 7, s = e & 127;
              const f32x4 w = *(const f32x4*)(wg + e);
              v2u o; o.x = pk2(s <= t ? w[0] : 0.f, s + 1 <= t ? w[1] : 0.f); o.y = pk2(s + 2 <= t ? w[2] : 0.f, s + 3 <= t ? w[3] : 0.f);
              *(v2u*)(Wl + t * MXS + s) = o; } }
        for (int i = 0; i < 16; ++i) { const int s = wave * 16 + i;
            const unsigned w = *(const unsigned*)(proj + (row0 + s) * NPROJ + 3584 + g * 128 + 2 * lane);
            const float v0 = gelu_tanh(bflo(w)), v1 = gelu_tanh(bfhi(w));
            const float ss = wave_sum(v0 * v0 + v1 * v1); const float rinv = 1.0f / sqrtf(ss * (1.0f / 128.0f) + EPS);
            Vt[(2 * lane) * MXS + s] = (bf16)f2bf(v0 * rinv * vgain[g * 128 + 2 * lane]); Vt[(2 * lane + 1) * MXS + s] = (bf16)f2bf(v1 * rinv * vgain[g * 128 + 2 * lane + 1]); }
        __syncthreads();
        { const int fr = lane & 15, fq = lane >> 4;
          f32x4 acc[8];
#pragma unroll
          for (int cb = 0; cb < 8; ++cb) acc[cb] = (f32x4){0.f, 0.f, 0.f, 0.f};
          const int nkc = (16 * (wave + 1) + 31) >> 5;
          for (int kc = 0; kc < nkc; ++kc) {
              const mm_bf16x8 af = *(const mm_bf16x8*)(Wl + (16 * wave + fr) * MXS + kc * 32 + fq * 8);
#pragma unroll
              for (int cb = 0; cb < 8; ++cb) { const mm_bf16x8 bf = *(const mm_bf16x8*)(Vt + (16 * cb + fr) * MXS + kc * 32 + fq * 8);
                  acc[cb] = __builtin_amdgcn_mfma_f32_16x16x32_bf16(bf, af, acc[cb], 0, 0, 0); } }
          const int t = 16 * wave + fr; const float bt = bs[g * 128 + t];
#pragma unroll
          for (int cb = 0; cb < 8; ++cb) { const int c = 16 * cb + 4 * fq;
              const v2u uw = *(const v2u*)(proj + (row0 + t) * NPROJ + 3072 + g * 128 + c);
              v2u o; o.x = pk2(gelu_tanh(bflo(uw.x)) * (acc[cb][0] + bt), gelu_tanh(bfhi(uw.x)) * (acc[cb][1] + bt));
              o.y = pk2(gelu_tanh(bflo(uw.y)) * (acc[cb][2] + bt), gelu_tanh(bfhi(uw.y)) * (acc[cb][3] + bt));
              *(v2u*)(mix + (row0 + t) * DM + 1024 + g * 128 + c) = o; } }
        __syncthreads();
    }
}

__device__ __forceinline__ void pool_mfma(const bf16* proj, const float* pw, const float* pscale, bf16* mix, unsigned char* lds_) {
    bf16* Wt = (bf16*)lds_;
    bf16* Dl = (bf16*)lds_ + 128 * MXS;
    const int half_ = gridDim.x >> 1;
    if ((int)blockIdx.x < half_) return;
    for (int item = blockIdx.x - half_; item < 256; item += gridDim.x - half_) {
        OPAQUE_TID();
        const int g = item & 3, tb = item >> 2; const size_t row0 = (size_t)tb * 128; const int sbase = (tb * 128) % SEQ;
        const int win = 2 << g;
        { const float* wg = pw + (size_t)g * 128 * 128;
#pragma unroll 4
          for (int i = 0; i < 8; ++i) { const int e = (i * 512 + tid) * 4, c = e >> 7, dd = e & 127;
              const f32x4 w = *(const f32x4*)(wg + e);
              Wt[(dd + 0) * MXS + c] = (bf16)f2bf(w[0]); Wt[(dd + 1) * MXS + c] = (bf16)f2bf(w[1]); Wt[(dd + 2) * MXS + c] = (bf16)f2bf(w[2]); Wt[(dd + 3) * MXS + c] = (bf16)f2bf(w[3]); } }
        { const int r0 = wave * 16; const bf16* xp = proj + 4096 + g * 128 + 2 * lane;
          float x0[31], x1[31];
#pragma unroll
          for (int k = 0; k < 31; ++k) { const int r = r0 - 15 + k; unsigned w = 0u;
              if (sbase + r >= 0) w = *(const unsigned*)(xp + (size_t)((long)row0 + r) * NPROJ);
              x0[k] = bflo(w); x1[k] = bfhi(w); }
#pragma unroll
          for (int i = 0; i < 16; ++i) { const int k = i + 15, s = sbase + r0 + i;
              float s0 = 0.f, s1 = 0.f;
#pragma unroll
              for (int j = 0; j < 16; ++j) { if (j < win) { s0 += x0[k - j]; s1 += x1[k - j]; } }
              const int cnt = (s + 1 < win) ? (s + 1) : win; const float ic = 1.0f / (float)cnt;
              *(unsigned*)(Dl + (r0 + i) * MXS + 2 * lane) = pk2(s0 * ic - x0[k], s1 * ic - x1[k]); } }
        __syncthreads();
        { const int fr = lane & 15, fq = lane >> 4;
          f32x4 acc[8];
#pragma unroll
          for (int db = 0; db < 8; ++db) acc[db] = (f32x4){0.f, 0.f, 0.f, 0.f};
#pragma unroll
          for (int kc = 0; kc < 4; ++kc) {
              const mm_bf16x8 af = *(const mm_bf16x8*)(Dl + (16 * wave + fr) * MXS + kc * 32 + fq * 8);
#pragma unroll
              for (int db = 0; db < 8; ++db) { const mm_bf16x8 bf = *(const mm_bf16x8*)(Wt + (16 * db + fr) * MXS + kc * 32 + fq * 8);
                  acc[db] = __builtin_amdgcn_mfma_f32_16x16x32_bf16(bf, af, acc[db], 0, 0, 0); } }
          const int s = 16 * wave + fr;
#pragma unroll
          for (int db = 0; db < 8; ++db) { const int dd = 16 * db + 4 * fq; const f32x4 sc = *(const f32x4*)(pscale + g * 128 + dd);
              v2u o; o.x = pk2(acc[db][0] * sc[0], acc[db][1] * sc[1]); o.y = pk2(acc[db][2] * sc[2], acc[db][3] * sc[3]);
              *(v2u*)(mix + (row0 + s) * DM + 1536 + g * 128 + dd) = o; } }
        __syncthreads();
    }
}

namespace fa {
constexpr int D = 128;
constexpr float THR = 8.f;
constexpr bool WSKIP = false;
constexpr int KVP = 4608, QP = 4608, OP = 2048;
constexpr float SCALE = 0.08838834764831845f;
constexpr int NW = 8, QBLK = 32, KVBLK = 64, QB = NW * QBLK;
constexpr int SHM_V = KVBLK * D * 2, SHM_K = KVBLK * D * 2;
constexpr int BIAS_OFF = 2 * SHM_V + 2 * SHM_K + NW * 64 * 4;
constexpr int Q_OFF = BIAS_OFF + 2048 * 4;
constexpr int FA_LDS_BYTES = Q_OFF + 8 * 8192;

typedef short bf16x8 __attribute__((ext_vector_type(8)));
typedef short s16x4 __attribute__((ext_vector_type(4)));
typedef float f32x16 __attribute__((ext_vector_type(16)));
typedef float f32x4 __attribute__((ext_vector_type(4)));
typedef unsigned u32x4 __attribute__((ext_vector_type(4)));
template <class A, class Bt> struct same_t { static constexpr bool v = false; };
template <class A> struct same_t<A, A> { static constexpr bool v = true; };

#define KSWZ(row, colB) ((row) * 256 + ((colB) ^ (((row) & 7) << 4)))
#define SBAR() __builtin_amdgcn_sched_barrier(0)
__device__ __forceinline__ int v_st(int k, int c) { const int kk = (k & ~0xC) | ((k & 4) << 1) | ((k & 8) >> 1); return ((kk >> 3) * 4 + (c >> 5)) * 512 + ((kk & 7) * 32 + (c & 31)) * 2; }
__device__ __forceinline__ int v_rd_base(int lane) { return ((lane & 3) << 3) | (((lane >> 2) & 3) << 6) | (((lane >> 4) & 1) << 5) | (((lane >> 5) & 1) << 8); }
constexpr int v_rd_off(int d0, int ks, int half) { return d0 * 512 + ks * 4096 + half * 2048; }
__device__ __forceinline__ int crow(int r, int hi) { return (r & 3) + 8 * (r >> 2) + 4 * hi; }
__device__ __forceinline__ unsigned cvtpk(float lo, float hi) {
    unsigned r; asm volatile("v_cvt_pk_bf16_f32 %0, %1, %2" : "=v"(r) : "v"(lo), "v"(hi)); return r;
}
__device__ __forceinline__ bf16x8 pack8(f32x4 a, f32x4 b) {
    u32x4 w = {cvtpk(a[0], a[1]), cvtpk(a[2], a[3]), cvtpk(b[0], b[1]), cvtpk(b[2], b[3])};
    return *reinterpret_cast<bf16x8*>(&w);
}
template <class T> __device__ __forceinline__ bf16x8 load8(const T* p) {
    if constexpr (same_t<T, float>::v) { return pack8(*(const f32x4*)p, *(const f32x4*)(p + 4)); }
    else { return *reinterpret_cast<const bf16x8*>(p); }
}
__device__ __forceinline__ void mask_tile(f32x16& p0, f32x16& p1, int dq, unsigned W) {
    const float NEG = -__builtin_inff();
#pragma unroll
    for (int r = 0; r < 16; ++r) {
        const int c = (r & 3) + 8 * (r >> 2);
        if ((unsigned)(dq - c) >= W) p0[r] = NEG;
        if ((unsigned)(dq - c - 32) >= W) p1[r] = NEG;
    }
}
__device__ __forceinline__ void partialSM(f32x16& p0, f32x16& p1, float& m_reg, float& mn, float& alpha) {
    float pmax = p0[0]; for (int r = 1; r < 16; ++r) pmax = fmaxf(pmax, p0[r]); for (int r = 0; r < 16; ++r) pmax = fmaxf(pmax, p1[r]);
    { auto rr = __builtin_amdgcn_permlane32_swap(__float_as_uint(pmax), __float_as_uint(pmax), false, false);
      pmax = fmaxf(__uint_as_float(rr[0]), __uint_as_float(rr[1])); }
    constexpr float C2 = 1.4426950408889634f * SCALE;
    if (__builtin_expect(__all((pmax - m_reg) * SCALE <= THR), 1)) { mn = m_reg; alpha = 1.f; }
    else { mn = fmaxf(m_reg, pmax); alpha = __builtin_amdgcn_exp2f((m_reg - mn) * C2); m_reg = mn; }
    const float mnL = -mn * C2;
    for (int r = 0; r < 16; ++r) p0[r] = fmaf(p0[r], C2, mnL); for (int r = 0; r < 16; ++r) p1[r] = fmaf(p1[r], C2, mnL);
    for (int r = 0; r < 16; ++r) p0[r] = __builtin_amdgcn_exp2f(p0[r]);
}
__device__ __forceinline__ void finishSM(f32x16& p0, f32x16& p1, float alpha, float& l_reg, bf16x8& pa0, bf16x8& pa1, bf16x8& pa2, bf16x8& pa3) {
    for (int r = 0; r < 16; ++r) p1[r] = __builtin_amdgcn_exp2f(p1[r]);
    float ps = 0; for (int r = 0; r < 16; ++r) ps += p0[r]; for (int r = 0; r < 16; ++r) ps += p1[r];
    { auto rr = __builtin_amdgcn_permlane32_swap(__float_as_uint(ps), __float_as_uint(ps), false, false);
      ps = __uint_as_float(rr[0]) + __uint_as_float(rr[1]); }
    l_reg = l_reg * alpha + ps;
#define PK4(P, B_, OUT) do { unsigned a0 = cvtpk(P[B_+0], P[B_+1]), a1 = cvtpk(P[B_+2], P[B_+3]);                          \
        unsigned b0 = cvtpk(P[B_+4], P[B_+5]), b1 = cvtpk(P[B_+6], P[B_+7]);                                             \
        auto r0 = __builtin_amdgcn_permlane32_swap(a0, b0, false, false); auto r1 = __builtin_amdgcn_permlane32_swap(a1, b1, false, false); \
        u32x4 w = {r0[0], r1[0], r0[1], r1[1]}; OUT = *reinterpret_cast<bf16x8*>(&w); } while (0)
    PK4(p0, 0, pa0); PK4(p0, 8, pa1); PK4(p1, 0, pa2); PK4(p1, 8, pa3);
#undef PK4
}
template <int KB, bool SK>
__device__ __forceinline__ void qkt(f32x16& p0, f32x16& p1, const char* K_lds, int r32, int hi, const char* Qw, bool act, const float* bt) {
    if (SK && !act) { const float NEG = -__builtin_inff();
#pragma unroll
        for (int r = 0; r < 16; ++r) { p0[r] = NEG; p1[r] = NEG; } return; }
#pragma unroll
    for (int g_ = 0; g_ < 4; ++g_) { const f32x4 b0_ = *(const f32x4*)(bt + 8 * g_), b1_ = *(const f32x4*)(bt + 32 + 8 * g_);
#pragma unroll
        for (int j_ = 0; j_ < 4; ++j_) { p0[4 * g_ + j_] = b0_[j_]; p1[4 * g_ + j_] = b1_[j_]; } }
    const char* kb[4];
#pragma unroll
    for (int dd = 0; dd < 4; ++dd) kb[dd] = K_lds + KB * SHM_K + KSWZ(r32, (dd * 16 + hi * 8) * 2);
#pragma unroll
    for (int d0 = 0; d0 < 8; ++d0) { const char* a = kb[d0 & 3] + (d0 >> 2) * 128;
        bf16x8 b0 = *reinterpret_cast<const bf16x8*>(a);
        bf16x8 b1 = *reinterpret_cast<const bf16x8*>(a + 32 * 256);
        const bf16x8 q_ = *reinterpret_cast<const bf16x8*>(Qw + KSWZ(r32, ((d0 & 3) * 16 + hi * 8) * 2) + (d0 >> 2) * 128);
        p0 = __builtin_amdgcn_mfma_f32_32x32x16_bf16(b0, q_, p0, 0, 0, 0);
        p1 = __builtin_amdgcn_mfma_f32_32x32x16_bf16(b1, q_, p1, 0, 0, 0); }
}
template <int VB, bool SK>
__device__ __forceinline__ void pv_tile(f32x16* o, int vb0, bf16x8 pa0, bf16x8 pa1, bf16x8 pa2, bf16x8 pa3, bool act) {
    if (SK && !act) return;
#define TRRD(dst, off) asm volatile("ds_read_b64_tr_b16 %0, %1 offset:%2" : "=&v"(dst) : "v"(vb0), "i"(off) : "memory")
#define PV_D0(d0) do { s16x4 l0, l1, l2, l3, h0, h1, h2, h3; constexpr int b_ = VB * SHM_V + v_rd_off(d0, 0, 0);     \
        TRRD(l0, b_); TRRD(h0, b_ + 2048); TRRD(l1, b_ + 4096); TRRD(h1, b_ + 6144); TRRD(l2, b_ + 8192); TRRD(h2, b_ + 10240); TRRD(l3, b_ + 12288); TRRD(h3, b_ + 14336); \
        asm volatile("s_waitcnt lgkmcnt(0)" ::: "memory"); SBAR();                 \
        o[d0] = __builtin_amdgcn_mfma_f32_32x32x16_bf16(pa0, (bf16x8){l0[0], l0[1], l0[2], l0[3], h0[0], h0[1], h0[2], h0[3]}, o[d0], 0, 0, 0);   \
        o[d0] = __builtin_amdgcn_mfma_f32_32x32x16_bf16(pa1, (bf16x8){l1[0], l1[1], l1[2], l1[3], h1[0], h1[1], h1[2], h1[3]}, o[d0], 0, 0, 0);   \
        o[d0] = __builtin_amdgcn_mfma_f32_32x32x16_bf16(pa2, (bf16x8){l2[0], l2[1], l2[2], l2[3], h2[0], h2[1], h2[2], h2[3]}, o[d0], 0, 0, 0);   \
        o[d0] = __builtin_amdgcn_mfma_f32_32x32x16_bf16(pa3, (bf16x8){l3[0], l3[1], l3[2], l3[3], h3[0], h3[1], h3[2], h3[3]}, o[d0], 0, 0, 0); } while (0)
    PV_D0(0); PV_D0(1); PV_D0(2); PV_D0(3);
#undef PV_D0
#undef TRRD
}

template <class TIn, class TOut> struct BlockRef { const TIn* Q; const TIn* K; const TIn* V; TOut* O; int P0; };
template <class TIn> struct Seam {
    bf16x8 st_v0, st_v1, st_k0, st_k1; f32x4 sf0, sf1, sf2, sf3;
    f32x4 tq[16];
};
__device__ __forceinline__ int swa_jlo(int P0, int W) { const int lowk = P0 - W + 1; return lowk > 0 ? lowk / KVBLK : 0; }
#define ROW(p, k0, rr) ((p) + (size_t)((k0) + (rr)) * KVP + sc)
#define VMW() asm volatile("s_waitcnt vmcnt(0)" ::: "memory")
#define VMWN(n) asm volatile("s_waitcnt vmcnt(%0)" :: "i"(n) : "memory")
#define SLOAD_H(Kp, Vp, k0) do { S.st_v0 = load8<TIn>(ROW(Vp, k0, sr)); S.st_v1 = load8<TIn>(ROW(Vp, k0, 32 + sr));              \
                         S.st_k0 = load8<TIn>(ROW(Kp, k0, sr)); S.st_k1 = load8<TIn>(ROW(Kp, k0, 32 + sr)); } while (0)
#define SWRITE_HK(bf) do { *(bf16x8*)(K_lds + (bf) * SHM_K + kws) = S.st_k0; *(bf16x8*)(K_lds + (bf) * SHM_K + kws + 32 * 256) = S.st_k1; } while (0)
#define SWRITE_HV(bf) do { *(bf16x8*)(V_lds + (bf) * SHM_V + vst0) = S.st_v0; *(bf16x8*)(V_lds + (bf) * SHM_V + vst1) = S.st_v1; } while (0)
#define SWRITE_H(bf) do { SWRITE_HV(bf); SWRITE_HK(bf); } while (0)
#define SLOAD_F(p, k0) do { S.sf0 = *(const f32x4*)ROW(p, k0, sr); S.sf1 = *(const f32x4*)(ROW(p, k0, sr) + 4);                \
                            S.sf2 = *(const f32x4*)ROW(p, k0, 32 + sr); S.sf3 = *(const f32x4*)(ROW(p, k0, 32 + sr) + 4); } while (0)
#define SWRITE_KF(bf) do { *(bf16x8*)(K_lds + (bf) * SHM_K + kws) = pack8(S.sf0, S.sf1); *(bf16x8*)(K_lds + (bf) * SHM_K + kws + 32 * 256) = pack8(S.sf2, S.sf3); } while (0)
#define SWRITE_VF(bf) do { *(bf16x8*)(V_lds + (bf) * SHM_V + vst0) = pack8(S.sf0, S.sf1); *(bf16x8*)(V_lds + (bf) * SHM_V + vst1) = pack8(S.sf2, S.sf3); } while (0)
template <class TIn, class TOut>
__device__ __forceinline__ void causal_swa_prime(const BlockRef<TIn, TOut>& cur, int W, char* lds, Seam<TIn>& S, int tid_in) {
    constexpr bool F32 = same_t<TIn, float>::v;
    const int tid = tid_in, wid = __builtin_amdgcn_readfirstlane(tid >> 6), lane = tid & 63, r32 = lane & 31, hi = lane >> 5;
    const int sr = tid >> 4, sc = (tid & 15) * 8, kws = KSWZ(sr, sc * 2); char* K_lds = lds + 2 * SHM_V;
    const int kb0 = swa_jlo(cur.P0, W) * KVBLK;
    { char* Qw_ = lds + Q_OFF + wid * 8192;
#pragma unroll
      for (int d0 = 0; d0 < 8; ++d0) *(bf16x8*)(Qw_ + KSWZ(r32, ((d0 & 3) * 16 + hi * 8) * 2) + (d0 >> 2) * 128) = load8<TIn>(cur.Q + (size_t)(wid * QBLK + r32) * QP + d0 * 16 + hi * 8); }
    if constexpr (F32) { SLOAD_F((const float*)cur.K, kb0); VMW(); SWRITE_KF(0); SBAR(); SLOAD_F((const float*)cur.V, kb0); }
    else { SLOAD_H(cur.K, cur.V, kb0); VMW(); SWRITE_HK(0); }
    __syncthreads();
}
template <class TIn, class TOut>
__device__ __forceinline__ void causal_swa_block(const BlockRef<TIn, TOut>& cur, const BlockRef<TIn, TOut>& nxt, int skv, int W, char* lds, Seam<TIn>& S, int tid_in) {
    constexpr bool F32 = same_t<TIn, float>::v;
    const int tid = tid_in, wid = __builtin_amdgcn_readfirstlane(tid >> 6), lane = tid & 63, r32 = lane & 31, hi = lane >> 5;
    const int j_lo = swa_jlo(cur.P0, W);
    int j_hi = (cur.P0 + QB - 1) / KVBLK + 1; if (j_hi > skv / KVBLK) j_hi = skv / KVBLK;
    const int NT = j_hi - j_lo;
    const int kbn = swa_jlo(nxt.P0, W) * KVBLK;
    const int qlo = cur.P0 + wid * QBLK, qm = qlo + r32 - 4 * hi;
    char* V_lds = lds; char* K_lds = lds + 2 * SHM_V;
    float* ws = (float*)(lds + 2 * SHM_V + 2 * SHM_K) + wid * 64; float* li_l = ws, * al_l = ws + 32;
    const float* bias_l = (const float*)(lds + BIAS_OFF) + 4 * hi;
    const char* Qw_lds = lds + Q_OFF + wid * 8192;
    float m_reg = -1e30f, l_reg = 0; f32x16 o[4] = {};
    const int sr = tid >> 4, sc = (tid & 15) * 8, vst0 = v_st(sr, sc), vst1 = v_st(32 + sr, sc), kws = KSWZ(sr, sc * 2);
    const int vb0 = (int)(uintptr_t)V_lds + v_rd_base(lane);
    const TIn* Kh = cur.K; const TIn* Vh = cur.V;
#define RESC(a) do { if (__any((a) < 1.f)) { if (hi == 0) al_l[r32] = (a); asm volatile("s_waitcnt lgkmcnt(0)" ::: "memory");              \
                     for (int d_ = 0; d_ < 4; ++d_) for (int r = 0; r < 16; ++r) o[d_][r] *= al_l[crow(r, hi)]; } } while (0)
#define KBASE(t) ((j_lo + (t)) * KVBLK)
#define ACT(t) (KBASE(t) <= qlo + QBLK - 1 && KBASE(t) + KVBLK - 1 >= qlo - W + 1)
#define MASKT(P0_, P1_, t) do { const int kb_ = KBASE(t); if ((!SK || ACT(t)) && (kb_ + KVBLK - 1 > qlo || kb_ <= qlo + QBLK - 1 - W)) mask_tile(P0_, P1_, qm - kb_, (unsigned)W); } while (0)
    constexpr int NQL = F32 ? 16 : 0;
    constexpr bool SK = WSKIP && !F32;
#define SEAM_K0() do { VMWN(NQL); if constexpr (F32) { SWRITE_KF(0); SBAR(); SLOAD_F((const float*)nxt.V, kbn); } else { SWRITE_HK(0); } SBAR(); } while (0)
    f32x16 pA0, pA1, pB0, pB1; float mnA, mnB, alA, alB; bf16x8 pa0, pa1, pa2, pa3;
    if constexpr (F32) { VMW(); SWRITE_VF(0); SBAR(); } else { SWRITE_HV(0); SBAR(); }
    if (NT > 1) { if constexpr (F32) SLOAD_F((const float*)Kh, KBASE(1)); else SLOAD_H(Kh, Vh, KBASE(1)); }
    SBAR(); qkt<0, SK>(pA0, pA1, K_lds, r32, hi, Qw_lds, ACT(0), bias_l + KBASE(0));
    if constexpr (F32) { if (NT > 1) { VMW(); SWRITE_KF(1); SBAR(); SLOAD_F((const float*)Vh, KBASE(1)); } }
    MASKT(pA0, pA1, 0); partialSM(pA0, pA1, m_reg, mnA, alA);
    if (NT > 1) { VMW(); if constexpr (F32) { SWRITE_VF(1); SBAR(); if (NT > 2) SLOAD_F((const float*)Kh, KBASE(2)); } else SWRITE_H(1); }
    __syncthreads();
#define HALF_STEP(PX0, PX1, mnX, alX, PY0, PY1, alY, t, KB, VB, SB) do {                                                      \
        SBAR(); qkt<KB, SK>(PX0, PX1, K_lds, r32, hi, Qw_lds, ACT(t), bias_l + KBASE(t));                                             \
        finishSM(PY0, PY1, alY, l_reg, pa0, pa1, pa2, pa3); SBAR();                                                           \
        if ((t) + 1 < NT) { if constexpr (F32) { VMW(); SWRITE_KF(SB); SBAR(); SLOAD_F((const float*)Vh, KBASE((t) + 1)); }  \
                            else { SLOAD_H(Kh, Vh, KBASE((t) + 1)); } SBAR(); }                                               \
        pv_tile<VB, SK>(o, vb0, pa0, pa1, pa2, pa3, ACT((t) - 1)); MASKT(PX0, PX1, (t)); partialSM(PX0, PX1, m_reg, mnX, alX);                                        \
        __syncthreads();                                                                                                      \
        if ((t) + 1 < NT) { VMW(); if constexpr (F32) { SWRITE_VF(SB); SBAR(); if ((t) + 2 < NT) SLOAD_F((const float*)Kh, KBASE((t) + 2)); } \
                            else { SWRITE_H(SB); } }                                                                          \
        RESC(alX); __syncthreads(); } while (0)
    for (int t = 1; t + 1 < NT; t += 2) {
        HALF_STEP(pB0, pB1, mnB, alB, pA0, pA1, alA, t, 1, 0, 0);
        HALF_STEP(pA0, pA1, mnA, alA, pB0, pB1, alB, t + 1, 0, 1, 1);
    }
    const bool even = (NT & 1) == 0;
    if (even) { SBAR(); qkt<1, SK>(pB0, pB1, K_lds, r32, hi, Qw_lds, ACT(NT - 1), bias_l + KBASE(NT - 1)); SBAR(); }
#define QROW(e) (nxt.Q + (size_t)(wid * QBLK + r32) * QP + ((e) >> 1) * 16 + hi * 8 + ((e) & 1) * 4)
    if constexpr (F32) { SLOAD_F((const float*)nxt.K, kbn); SBAR();
#pragma unroll
        for (int e = 0; e < 8; ++e) S.tq[e] = *(const f32x4*)QROW(e); }
    else { SLOAD_H(nxt.K, nxt.V, kbn); SBAR(); }
    SBAR();
    finishSM(pA0, pA1, alA, l_reg, pa0, pa1, pa2, pa3); SBAR();
    if constexpr (F32) {
#pragma unroll
        for (int e = 8; e < 16; ++e) S.tq[e] = *(const f32x4*)QROW(e); SBAR(); }
#undef QROW
    pv_tile<0, SK>(o, vb0, pa0, pa1, pa2, pa3, ACT(even ? NT - 2 : NT - 1));
    if (even) { MASKT(pB0, pB1, NT - 1); partialSM(pB0, pB1, m_reg, mnB, alB); __syncthreads(); RESC(alB);
        finishSM(pB0, pB1, alB, l_reg, pa0, pa1, pa2, pa3); SBAR(); pv_tile<1, SK>(o, vb0, pa0, pa1, pa2, pa3, ACT(NT - 1)); }
    SBAR(); SEAM_K0();
    if (hi == 0) li_l[r32] = l_reg; asm volatile("s_waitcnt lgkmcnt(0)" ::: "memory");
    float rli[16];
#pragma unroll
    for (int r = 0; r < 16; ++r) rli[r] = __builtin_amdgcn_rcpf(li_l[crow(r, hi)]);
    TOut* Ow = cur.O + (size_t)(wid * QBLK) * OP;
#pragma unroll
    for (int r = 0; r < 16; ++r) { const int orow = crow(r, hi);
#pragma unroll
        for (int d0 = 0; d0 < 4; ++d0) { const float v = o[d0][r] * rli[r];
            if constexpr (same_t<TOut, float>::v) { Ow[(size_t)orow * OP + d0 * 32 + r32] = v; }
            else { const float vn = __shfl_xor(v, 1);
                   if ((r32 & 1) == 0) *(unsigned*)(Ow + (size_t)orow * OP + d0 * 32 + r32) = cvtpk(v, vn); } } }
    if constexpr (F32) {
#pragma unroll
        for (int d0 = 0; d0 < 8; ++d0) (void)S.tq[2 * d0]; }
    __syncthreads();
#undef RESC
#undef KBASE
#undef ACT
#undef MASKT
#undef SEAM_K0
#undef HALF_STEP
}
#undef ROW
#undef VMW
#undef VMWN
#undef SLOAD_H
#undef SWRITE_HK
#undef SWRITE_HV
#undef SWRITE_H
#undef SLOAD_F
#undef SWRITE_KF
#undef SWRITE_VF

#undef KSWZ
#undef SBAR
}

__device__ __forceinline__ void attn_phase(const bf16* proj, const float* cum, bf16* mix, unsigned char* lds_) {
    char* lds = (char*)lds_;
    for (int item = blockIdx.x; item < 256; item += gridDim.x) {
        OPAQUE_TID();
        const int bh = (item & 7) * 4 + ((item >> 3) & 3), qb = 7 - (item >> 5);
        const int b = bh >> 3, hh = bh & 7;
        float* bias = (float*)(lds + fa::BIAS_OFF);
        const float* cb = cum + (size_t)bh * SEQ;
        const int nk = (qb + 1) * 256;
        for (int s = tid; s < nk; s += 512) bias[s] = -cb[s] * (1.0f / fa::SCALE);
        fa::BlockRef<bf16, bf16> cur;
        cur.Q = proj + (size_t)(b * SEQ + qb * 256) * NPROJ + hh * 128; cur.K = proj + (size_t)(b * SEQ) * NPROJ + 1024 + hh * 128; cur.V = cur.K + 1024;
        cur.O = mix + (size_t)(b * SEQ + qb * 256) * DM + hh * 128; cur.P0 = qb * 256;
        fa::Seam<bf16> S;
        fa::causal_swa_prime<bf16, bf16>(cur, SEQ, lds, S, tid);
        fa::causal_swa_block<bf16, bf16>(cur, cur, SEQ, SEQ, lds, S, tid);
    }
}

__global__ void __launch_bounds__(512, 2) fwd(Args a) {
    extern __shared__ __attribute__((aligned(16))) unsigned char lds[];
    cg::grid_group grid = cg::this_grid();
#define OPQ_WS() opq_ptr(a.ws)
#define XN ((bf16*)(OPQ_WS() + WS_XN))
#define PROJ ((bf16*)(OPQ_WS() + WS_PROJ))
#define MIX ((bf16*)(OPQ_WS() + WS_MIX))
#define ACT ((bf16*)(OPQ_WS() + WS_ACT))
#define PP ((bf16*)(OPQ_WS() + WS_PP))
#define PBF ((bf16*)(OPQ_WS() + WS_PBF))
#define LOGF ((float*)(OPQ_WS() + WS_LOGF))
#define CUM ((float*)(OPQ_WS() + WS_CUM))
#define H ((float*)opq_ptr((unsigned char*)a.out))
    PG8_LAS unsigned char* ring = (PG8_LAS unsigned char*)lds;
    const int G = gridDim.x, bx = blockIdx.x;
    { volatile LAS unsigned* st0 = (volatile LAS unsigned*)((LAS unsigned char*)lds + XB_LDS_OFF); if (threadIdx.x < 2) st0[threadIdx.x] = 0u; }
    __syncthreads();
    const XcdBarrier xbar = xcd_barrier_post((unsigned*)(a.ws + WS_BAR), (volatile LAS unsigned*)((LAS unsigned char*)lds + XB_LDS_OFF));
#define GRID_SYNC() xcd_barrier(xbar)
    constexpr int CONV_SPLIT = 1940;

    convert_weights(a, (LAS unsigned char*)lds, 0, I_LAYER, bx, G);
    convert_p(a);
    norm_phase(a.in[I_X], a.in[I_NORM_MIX], XN, true, a.in[I_W_IN], a.in[I_FBIAS], LOGF, lds);
    grid.sync();

#pragma unroll 1
    for (int L = 0; L < DEPTH; ++L) {
#define WL(off) ((const bf16*)(OPQ_WS() + WS_W + (size_t)L * SZ_LAYER + (off)))
#define Win WL(OFF_WIN)
#define Wout WL(OFF_WOUT)
#define Wgu WL(OFF_WGU)
#define Wdn WL(OFF_WDN)
#define Wpg WL(OFF_WPG)
#define Wpp WL(OFF_WPP)
        for (int rep_ = 0; rep_ < REP_A; ++rep_) {
        { pg8::Gemm g{XN, Win, M, NPROJ, DM}; pg8::StaticOrder S; S.init(M, NPROJ, G, bx);
          pg8::EpiBf16<0> E{PROJ, NPROJ, nullptr, 0, 0, 1.f};
          pg8::gemm_phase<pg8::EpiBf16<0>, pg8::StaticOrder, true, true>(ring, g, S, E); }
        { pg8::Gemm g{PBF + (size_t)L * M * DPLE, Wpp, M, DM, DPLE}; pg8::StaticOrder S; S.init(M, DM, G, bx);
          pg8::EpiBf16<0> E{PP, DM, nullptr, 0, 0, 1.f};
          pg8::gemm_phase<pg8::EpiBf16<0>, pg8::StaticOrder, true, true>(ring, g, S, E); }
        }
        if (L + 1 < DEPTH) {
            const int ntile = (M / 256) * (NPROJ / 256), maxu = (ntile + G - 1) / G, rem = ntile - (maxu - 1) * G, first_idle = (rem >= G) ? 0 : rem;
            if (bx >= first_idle) convert_weights(a, (LAS unsigned char*)lds, (L + 1) * I_LAYER, (L + 1) * I_LAYER + CONV_SPLIT, bx - first_idle, G - first_idle);
        }
        GRID_SYNC();
        post_phase(PROJ, a.in[I_Q_NORM] + L * 128, a.in[I_K_NORM] + L * 128, LOGF, CUM);
        GRID_SYNC();
        for (int rep_ = 0; rep_ < REP_C; ++rep_) {
        gmlp_mfma(PROJ, a.in[I_GV_NORM] + L * 512, a.in[I_G_WS] + (size_t)L * 4 * 128 * 128, a.in[I_G_BS] + L * 512, MIX, lds);
        pool_mfma(PROJ, a.in[I_POOL_W] + (size_t)L * 4 * 128 * 128, a.in[I_POOL_SCALE] + L * 512, MIX, lds);
        for (int rep2_ = 0; rep2_ < REP_ATT; ++rep2_) attn_phase(PROJ, CUM, MIX, lds);
        }
        for (int rep_ = 0; rep_ < REP_SYNC; ++rep_) GRID_SYNC();
        { pg8::Gemm g{MIX, Wout, M, DM, DM}; pg8::StaticOrder S; S.init(M, DM, G, bx);
          pg8::EpiRes E{L == 0 ? a.in[I_X] : H, H, DM};
          pg8::gemm_phase<pg8::EpiRes, pg8::StaticOrder, true, true>(ring, g, S, E); }
        GRID_SYNC();
        for (int rep_ = 0; rep_ < REP_N; ++rep_) norm_phase(H, a.in[I_NORM_FFN] + L * DM, XN, false, nullptr, nullptr, nullptr, lds);
        GRID_SYNC();
        for (int rep_ = 0; rep_ < REP_F; ++rep_) { pg8::Gemm g{XN, Wgu, M, NGU, DM}; pg8::StaticOrder S; S.init(M, NGU, G, bx);
          pg8::EpiSwiglu E{ACT, DFF};
          pg8::gemm_phase<pg8::EpiSwiglu, pg8::StaticOrder, true, true>(ring, g, S, E); }
        if (L + 1 < DEPTH) {
            const int ntile = (M / 256) * (NGU / 256), maxu = (ntile + G - 1) / G, rem = ntile - (maxu - 1) * G, first_idle = (rem >= G) ? 0 : rem;
            if (bx >= first_idle) convert_weights(a, (LAS unsigned char*)lds, (L + 1) * I_LAYER + CONV_SPLIT, (L + 2) * I_LAYER, bx - first_idle, G - first_idle);
        }
        GRID_SYNC();
        { pg8::Gemm g{ACT, Wdn, M, DM, DFF}; pg8::StaticOrder S; S.init(M, DM, G, bx);
          pg8::EpiRes E{H, H, DM};
          pg8::gemm_phase<pg8::EpiRes, pg8::StaticOrder, true, true>(ring, g, S, E); }
        GRID_SYNC();
        for (int rep_ = 0; rep_ < REP_N; ++rep_) norm_phase(H, a.in[I_NORM_PLE] + L * DM, XN, false, nullptr, nullptr, nullptr, lds);
        GRID_SYNC();
        { pg8::Gemm g{XN, Wpg, M, DM, DM}; pg8::StaticOrder S; S.init(M, DM, G, bx);
          pg8::EpiPle E{H, H, PP, DM};
          pg8::gemm_phase<pg8::EpiPle, pg8::StaticOrder, true, true>(ring, g, S, E); }
        if (L + 1 < DEPTH) {
            GRID_SYNC();
            norm_phase(H, a.in[I_NORM_MIX] + (L + 1) * DM, XN, true, a.in[I_W_IN] + (size_t)(L + 1) * DM * DPROJ_SRC, a.in[I_FBIAS] + (L + 1) * 8, LOGF, lds);
            GRID_SYNC();
        }
    }
}

extern "C" void kernel_launch(void* const* d_in, const int* in_sizes, int n_in, void* d_out, int out_size, void* d_ws, size_t ws_size, hipStream_t stream) {
    static int grid = 0;
    if (grid == 0) {
        if (n_in != 20 || out_size != M * DM || ws_size < WS_END) { fprintf(stderr, "kernel_launch: unexpected shapes (n_in %d out %d ws %zu, need %zu)\n", n_in, out_size, ws_size, (size_t)WS_END); grid = -1; return; }
        int dev = 0, cus = 0, per_cu = 0;
        (void)hipGetDevice(&dev); (void)hipDeviceGetAttribute(&cus, hipDeviceAttributeMultiprocessorCount, dev);
        if (hipFuncSetAttribute((const void*)fwd, hipFuncAttributeMaxDynamicSharedMemorySize, LDS_BYTES) != hipSuccess) fprintf(stderr, "kernel_launch: hipFuncSetAttribute failed\n");
        if (hipOccupancyMaxActiveBlocksPerMultiprocessor(&per_cu, (const void*)fwd, 512, LDS_BYTES) != hipSuccess || per_cu < 1) { fprintf(stderr, "kernel_launch: occupancy query gave %d\n", per_cu); per_cu = 1; }
        (void)hipGetLastError();
        if (cus <= 0) cus = 256;
        grid = cus * per_cu;
    }
    if (grid < 0) return;
    Args a{};
    for (int i = 0; i < 20; ++i) a.in[i] = (const float*)d_in[i];
    a.out = (float*)d_out; a.ws = (unsigned char*)d_ws;
    if (hipMemsetAsync((char*)d_ws + WS_BAR, 0, XCD_BAR_WORDS * 4, stream) != hipSuccess) fprintf(stderr, "kernel_launch: memset of barrier words failed\n");
    void* args[] = {&a};
    hipError_t e = hipLaunchCooperativeKernel((void*)fwd, dim3(grid), dim3(512), args, LDS_BYTES, stream);
    if (e != hipSuccess) fprintf(stderr, "cooperative launch failed: %s (grid %d)\n", hipGetErrorString(e), grid);
}
```

```cpp
#include <hip/hip_runtime.h>
#include <hip/hip_cooperative_groups.h>
#include <cstdio>
#include <cstdint>
namespace cg = cooperative_groups;
#ifndef REP_PRO
#define REP_PRO 1
#define REP_A 1
#define REP_C 1
#define REP_ATT 1
#define REP_F 1
#define REP_N 1
#define REP_SYNC 1
#endif
namespace pg8 {
#define PG8_LAS __attribute__((address_space(3)))
typedef unsigned short bf16_t;
typedef short bf16x8 __attribute__((ext_vector_type(8)));
typedef float f32x4 __attribute__((ext_vector_type(4)));
typedef unsigned u32x4 __attribute__((ext_vector_type(4)));
constexpr int BM = 256, BK = 64, HALF = 128, HTB = HALF * BK * 2  , STAGE_BYTES = 8 * HTB, NXCD = 8, WGM = 8;

__host__ __device__ __forceinline__ int lds_byte(int r, int c) { const int st = (r >> 4) * 2 + (c >> 5), rr = r & 15, cc = c & 31, ob = rr * 64 + cc * 2; return st * 1024 + (ob ^ (((ob >> 9) & 1) << 5)); }
__host__ __device__ __forceinline__ void stage_rc(int b, int& R, int& C) { const int st = b / 1024, sb = b % 1024, swz = sb ^ (((sb >> 9) & 1) << 5); R = (st >> 1) * 16 + swz / 64; C = (st & 1) * 32 + (swz % 64) / 2; }
__host__ __device__ __forceinline__ int perm32(int rho) { const int n = rho >> 4, i = rho & 15; return 8 * (i >> 2) + 4 * n + (i & 3); }

struct Unit { int pm, pn; };
struct Gemm { const bf16_t* A; const bf16_t* Bt; int M, N, K; };

struct StaticOrder {
    int nM, nN, nwg, G, c;
    __host__ __device__ void init(int M, int N, int G_, int c_) { nM = M / BM; nN = N / BM; nwg = nM * nN; G = G_; c = c_; }
    __host__ __device__ bool next(int i, Unit& u) const {
        const long L = (long)i * G + c; if (L >= nwg) return false;
        int wgid = (int)L; { const int q = nwg / NXCD, r = nwg % NXCD, xcd = wgid % NXCD, off = wgid / NXCD; wgid = (xcd < r ? xcd * (q + 1) : r * (q + 1) + (xcd - r) * q) + off; }
        const int nig = WGM * nN, gid = wgid / nig, fm = gid * WGM, gsz = (nM - fm) < WGM ? (nM - fm) : WGM;
        u.pm = fm + ((wgid % nig) % gsz); u.pn = (wgid % nig) / gsz; return true;
    }
    __device__ __forceinline__ void a_ready(const Unit&) const {}
    __device__ __forceinline__ void done(const Unit&) const {}
};

__device__ __forceinline__ unsigned cvt_pk_bf16(float lo, float hi) { unsigned r; asm volatile("v_cvt_pk_bf16_f32 %0, %1, %2" : "=v"(r) : "v"(lo), "v"(hi)); return r; }
typedef float f32x2 __attribute__((ext_vector_type(2)));
__device__ __forceinline__ f32x2 gelu_pk(f32x2 v) {
    const f32x2 av = __builtin_elementwise_abs(v), d = av * 0.2316418882f + 1.0f;
    f32x2 t; t.x = __builtin_amdgcn_rcpf(d.x); t.y = __builtin_amdgcn_rcpf(d.y);
    f32x2 q = t * 0.5307027145f + (-0.7265760135f); q = q * t + 0.7107068705f; q = q * t + (-0.142248368f); q = q * t + 0.127414796f; q = q * t;
    const f32x2 s = (v * v) * (-0.72134752044f);
    f32x2 e; e.x = __builtin_amdgcn_exp2f(s.x); e.y = __builtin_amdgcn_exp2f(s.y);
    const f32x2 m = v * (q * e), r = v - m;
    f32x2 o; o.x = v.x < 0.f ? m.x : r.x; o.y = v.y < 0.f ? m.y : r.y; return o;
}

template <int ACT  > struct EpiBf16 {
    static constexpr bool PERM = true, AFTER_DRAIN = false; static_assert(ACT == 0 || ACT == 1, "EpiBf16: ACT is 0 (none) or 1 (gelu_pk)");
    bf16_t* O; int ldc; const float* bias; int split_cols; size_t split_stride; float scale0;
    __device__ __forceinline__ void operator()(const f32x4 (&acc)[2][2][4][2], const Unit& u, int wr, int wc, int fr, int fq) const {
        const int row0 = u.pm * BM + wr * 64 + fr; int colt = u.pn * BM; bf16_t* base = O;
        float sc = 1.f; if (split_cols) { const int t = colt / split_cols; base += (size_t)t * split_stride; colt -= t * split_cols; if (t == 0) sc = scale0; }
        const int col0 = colt + wc * 32 + 8 * fq, bcol0 = u.pn * BM + wc * 32 + 8 * fq;
        f32x4 bv[2][2];
#pragma unroll
        for (int bj = 0; bj < 2; ++bj)
#pragma unroll
            for (int n = 0; n < 2; ++n) bv[bj][n] = bias ? *(const f32x4*)(bias + bcol0 + bj * HALF + 4 * n) : (f32x4){0.f, 0.f, 0.f, 0.f};
#pragma unroll
        for (int ai = 0; ai < 2; ++ai)
#pragma unroll
            for (int m = 0; m < 4; ++m) { bf16_t* rowp = base + (size_t)(row0 + ai * HALF + m * 16) * ldc + col0;
#pragma unroll
                for (int bj = 0; bj < 2; ++bj) { f32x4 v0 = acc[ai][bj][m][0] + bv[bj][0], v1 = acc[ai][bj][m][1] + bv[bj][1];
                    if (ACT == 1) { f32x2 a = gelu_pk((f32x2){v0[0], v0[1]}), b = gelu_pk((f32x2){v0[2], v0[3]}), c = gelu_pk((f32x2){v1[0], v1[1]}), d = gelu_pk((f32x2){v1[2], v1[3]});
                        v0 = (f32x4){a.x, a.y, b.x, b.y}; v1 = (f32x4){c.x, c.y, d.x, d.y}; }
                    v0 = v0 * sc; v1 = v1 * sc; u32x4 w; w.x = cvt_pk_bf16(v0[0], v0[1]); w.y = cvt_pk_bf16(v0[2], v0[3]); w.z = cvt_pk_bf16(v1[0], v1[1]); w.w = cvt_pk_bf16(v1[2], v1[3]);
                    *(u32x4*)(rowp + bj * HALF) = w; } }
    }
};
typedef unsigned u32x2 __attribute__((ext_vector_type(2)));
__device__ __forceinline__ float bf_lo(unsigned w) { return __uint_as_float(w << 16); }
__device__ __forceinline__ float bf_hi(unsigned w) { return __uint_as_float(w & 0xffff0000u); }
__device__ __forceinline__ float sigmoidf_(float x) { return 1.0f / (1.0f + __expf(-x)); }
struct EpiRes {
    static constexpr bool PERM = false, AFTER_DRAIN = false;
    const float* base; float* out; int ldc;
    __device__ __forceinline__ void operator()(const f32x4 (&acc)[2][2][4][2], const Unit& u, int wr, int wc, int fr, int fq) const {
        const int col0 = u.pn * BM + wc * 32 + 4 * fq;
#pragma unroll
        for (int ai = 0; ai < 2; ++ai)
#pragma unroll
            for (int m = 0; m < 4; ++m) { const size_t off = (size_t)(u.pm * BM + ai * HALF + wr * 64 + m * 16 + fr) * ldc + col0;
#pragma unroll
                for (int bj = 0; bj < 2; ++bj)
#pragma unroll
                    for (int n = 0; n < 2; ++n) { const f32x4 bs = *(const f32x4*)(base + off + bj * HALF + n * 16); *(f32x4*)(out + off + bj * HALF + n * 16) = bs + acc[ai][bj][m][n]; }
                asm volatile("" ::: "memory"); }
    }
};
struct EpiPle {
    static constexpr bool PERM = false, AFTER_DRAIN = false;
    const float* base; float* out; const bf16_t* pp; int ldc;
    __device__ __forceinline__ void operator()(const f32x4 (&acc)[2][2][4][2], const Unit& u, int wr, int wc, int fr, int fq) const {
        const int col0 = u.pn * BM + wc * 32 + 4 * fq;
#pragma unroll
        for (int ai = 0; ai < 2; ++ai)
#pragma unroll
            for (int m = 0; m < 4; ++m) { const size_t off = (size_t)(u.pm * BM + ai * HALF + wr * 64 + m * 16 + fr) * ldc + col0;
#pragma unroll
                for (int bj = 0; bj < 2; ++bj)
#pragma unroll
                    for (int n = 0; n < 2; ++n) { const f32x4 bs = *(const f32x4*)(base + off + bj * HALF + n * 16); const u32x2 pw = *(const u32x2*)(pp + off + bj * HALF + n * 16);
                        const f32x4 a = acc[ai][bj][m][n]; f32x4 o;
                        o[0] = bs[0] + bf_lo(pw.x) * sigmoidf_(a[0]); o[1] = bs[1] + bf_hi(pw.x) * sigmoidf_(a[1]);
                        o[2] = bs[2] + bf_lo(pw.y) * sigmoidf_(a[2]); o[3] = bs[3] + bf_hi(pw.y) * sigmoidf_(a[3]);
                        *(f32x4*)(out + off + bj * HALF + n * 16) = o; }
                asm volatile("" ::: "memory"); }
    }
};
struct EpiSwiglu {
    static constexpr bool PERM = true, AFTER_DRAIN = false;
    bf16_t* O; int ldc;
    __device__ __forceinline__ void operator()(const f32x4 (&acc)[2][2][4][2], const Unit& u, int wr, int wc, int fr, int fq) const {
        const int col0 = u.pn * HALF + wc * 32 + 8 * fq;
#pragma unroll
        for (int ai = 0; ai < 2; ++ai)
#pragma unroll
            for (int m = 0; m < 4; ++m) { bf16_t* rowp = O + (size_t)(u.pm * BM + ai * HALF + wr * 64 + m * 16 + fr) * ldc + col0;
                float r[8];
#pragma unroll
                for (int n = 0; n < 2; ++n)
#pragma unroll
                    for (int j = 0; j < 4; ++j) { const float g = acc[ai][0][m][n][j], up = acc[ai][1][m][n][j]; r[n * 4 + j] = g * sigmoidf_(g) * up; }
                u32x4 w; w.x = cvt_pk_bf16(r[0], r[1]); w.y = cvt_pk_bf16(r[2], r[3]); w.z = cvt_pk_bf16(r[4], r[5]); w.w = cvt_pk_bf16(r[6], r[7]);
                *(u32x4*)rowp = w; asm volatile("" ::: "memory"); }
    }
};
struct EpiProjQK {
    static constexpr bool PERM = true, AFTER_DRAIN = false;
    bf16_t* O; int ldc; const float* qg; const float* kg; PG8_LAS float* P;
    __device__ __forceinline__ void operator()(const f32x4 (&acc)[2][2][4][2], const Unit& u, int wr, int wc, int fr_in, int fq_in) const {
        int fr = fr_in, fq = fq_in; asm volatile("" : "+v"(fr), "+v"(fq));
        const int row0 = u.pm * BM + wr * 64 + fr, col0 = u.pn * BM + wc * 32 + 8 * fq;
        if (u.pn < 8) {
#pragma unroll
            for (int ai = 0; ai < 2; ++ai)
#pragma unroll
                for (int m = 0; m < 4; ++m)
#pragma unroll
                    for (int bj = 0; bj < 2; ++bj) { const f32x4 a0 = acc[ai][bj][m][0], a1 = acc[ai][bj][m][1];
                        float s = ((a0[0] * a0[0] + a0[1] * a0[1]) + (a0[2] * a0[2] + a0[3] * a0[3])) + ((a1[0] * a1[0] + a1[1] * a1[1]) + (a1[2] * a1[2] + a1[3] * a1[3]));
                        s += __shfl_xor(s, 16); s += __shfl_xor(s, 32);
                        if (fq == 0) P[((ai * HALF + wr * 64 + m * 16 + fr) * 2 + bj) * 4 + wc] = s; }
            asm volatile("s_waitcnt lgkmcnt(0)" ::: "memory"); __builtin_amdgcn_s_barrier(); asm volatile("" ::: "memory");
            const float* gp = (u.pn < 4 ? qg : kg) + wc * 32 + 8 * fq;
            const f32x4 g0 = *(const f32x4*)gp, g1 = *(const f32x4*)(gp + 4);
#pragma unroll
            for (int ai = 0; ai < 2; ++ai)
#pragma unroll
                for (int m = 0; m < 4; ++m) { bf16_t* rowp = O + (size_t)(row0 + ai * HALF + m * 16) * ldc + col0;
#pragma unroll
                    for (int bj = 0; bj < 2; ++bj) { const f32x4 pp = *(const PG8_LAS f32x4*)(P + ((ai * HALF + wr * 64 + m * 16 + fr) * 2 + bj) * 4);
                        const float rinv = rsqrtf(((pp[0] + pp[1]) + (pp[2] + pp[3])) * (1.0f / 128.0f) + 1e-6f);
                        const f32x4 v0 = acc[ai][bj][m][0] * rinv * g0, v1 = acc[ai][bj][m][1] * rinv * g1;
                        u32x4 w; w.x = cvt_pk_bf16(v0[0], v0[1]); w.y = cvt_pk_bf16(v0[2], v0[3]); w.z = cvt_pk_bf16(v1[0], v1[1]); w.w = cvt_pk_bf16(v1[2], v1[3]);
                        *(u32x4*)(rowp + bj * HALF) = w; } }
            asm volatile("s_waitcnt lgkmcnt(0)" ::: "memory"); __builtin_amdgcn_s_barrier(); asm volatile("" ::: "memory");
        } else {
#pragma unroll
            for (int ai = 0; ai < 2; ++ai)
#pragma unroll
                for (int m = 0; m < 4; ++m) { bf16_t* rowp = O + (size_t)(row0 + ai * HALF + m * 16) * ldc + col0;
#pragma unroll
                    for (int bj = 0; bj < 2; ++bj) { const f32x4 v0 = acc[ai][bj][m][0], v1 = acc[ai][bj][m][1];
                        u32x4 w; w.x = cvt_pk_bf16(v0[0], v0[1]); w.y = cvt_pk_bf16(v0[2], v0[3]); w.z = cvt_pk_bf16(v1[0], v1[1]); w.w = cvt_pk_bf16(v1[2], v1[3]);
                        *(u32x4*)(rowp + bj * HALF) = w; } }
        }
    }
};
template <class Epi, class Sched, bool ALIGN_EPI = false, bool SP2 = false>
__device__ __forceinline__ void gemm_phase(PG8_LAS unsigned char* lds, const Gemm g, const Sched& S, const Epi& E) {
    int tid_ = threadIdx.x; asm volatile("" : "+v"(tid_));
    const int tid = tid_, wid = __builtin_amdgcn_readfirstlane(tid >> 6), lane = tid & 63, wr = wid >> 2, wc = wid & 3, fr = lane & 15, fq = lane >> 4;
    const int K = g.K, nt = K / BK;
    unsigned voffA[2], voffB[2];
#pragma unroll
    for (int i = 0; i < 2; ++i) { int R, C; stage_rc(tid * 16 + i * 8192, R, C); const int Rb = Epi::PERM ? ((R & ~31) + perm32(R & 31)) : R;
        voffA[i] = (unsigned)(R * K + C) * 2u; voffB[i] = (unsigned)(Rb * K + C) * 2u; }
    const size_t kstep = (size_t)(BK * 2);
    const size_t hstep = (size_t)HALF * K * 2;
    const size_t tstep = 2 * hstep;
    const unsigned ldsw = (unsigned)wid * 1024u;
    const int aoff = lds_byte(wr * 64 + fr, fq * 8), boff = lds_byte(wc * 32 + fr, fq * 8);
#define PG8_SA(b, h) (((b) * 2 + (h)) * HTB)
#define PG8_SB(b, h) ((4 + (b) * 2 + (h)) * HTB)
#define PG8_STAGE(bufoff, gbase, voff) do { _Pragma("unroll") for (int _i = 0; _i < 2; ++_i) \
        __builtin_amdgcn_global_load_lds((const unsigned*)((const char*)(gbase) + (voff)[_i]), (PG8_LAS unsigned*)(lds + (bufoff) + ldsw + _i * 8192), 16, 0, 0); } while (0)
#define PG8_LDA(dst, b, h) do { _Pragma("unroll") for (int m = 0; m < 4; ++m) _Pragma("unroll") for (int k = 0; k < 2; ++k) dst[m][k] = *(const PG8_LAS bf16x8*)(lds + PG8_SA(b, h) + aoff + m * 2048 + k * 1024); } while (0)
#define PG8_LDB(dst, b, h) do { _Pragma("unroll") for (int n = 0; n < 2; ++n) _Pragma("unroll") for (int k = 0; k < 2; ++k) dst[n][k] = *(const PG8_LAS bf16x8*)(lds + PG8_SB(b, h) + boff + n * 2048 + k * 1024); } while (0)
#define PG8_MMA(ai, bj, At, Bt) do { __builtin_amdgcn_s_setprio(1); _Pragma("unroll") for (int m = 0; m < 4; ++m) _Pragma("unroll") for (int n = 0; n < 2; ++n) _Pragma("unroll") for (int k = 0; k < 2; ++k) \
        acc[ai][bj][m][n] = __builtin_amdgcn_mfma_f32_16x16x32_bf16(Bt[n][k], At[m][k], acc[ai][bj][m][n], 0, 0, 0); __builtin_amdgcn_s_setprio(0); } while (0)
#define PG8_WAIT_V(n) asm volatile("s_waitcnt vmcnt(" #n ")" ::: "memory")
#define PG8_WAIT_L(n) asm volatile("s_waitcnt lgkmcnt(" #n ")" ::: "memory")
#define PG8_BAR __builtin_amdgcn_s_barrier()
#define PG8_SCHED __builtin_amdgcn_sched_barrier(0)
    Unit cur, nxt; int ui = 0;
    if (!S.next(0, cur)) return;
    f32x4 acc[2][2][4][2];
#pragma unroll
    for (int a = 0; a < 2; ++a)
#pragma unroll
        for (int b = 0; b < 2; ++b)
#pragma unroll
            for (int m = 0; m < 4; ++m)
#pragma unroll
                for (int n = 0; n < 2; ++n) acc[a][b][m][n] = (f32x4){0.f, 0.f, 0.f, 0.f};
    bf16x8 At[4][2], B0[2][2], B1[2][2];
    const char* cA = (const char*)g.A + (size_t)cur.pm * tstep; const char* cB = (const char*)g.Bt + (size_t)cur.pn * tstep;
    S.a_ready(cur);
    if constexpr (SP2) {
        PG8_STAGE(PG8_SB(0, 0), cB, voffB); PG8_STAGE(PG8_SB(0, 1), cB + hstep, voffB); PG8_STAGE(PG8_SA(0, 0), cA, voffA); PG8_STAGE(PG8_SA(0, 1), cA + hstep, voffA);
        if (wr == 1) PG8_BAR;
        PG8_WAIT_V(2); PG8_BAR;
        PG8_STAGE(PG8_SB(1, 0), cB + kstep, voffB); PG8_STAGE(PG8_SA(1, 0), cA + kstep, voffA); PG8_STAGE(PG8_SB(1, 1), cB + hstep + kstep, voffB);
        PG8_WAIT_V(6); PG8_BAR;
    } else {
        PG8_STAGE(PG8_SB(0, 0), cB, voffB); PG8_STAGE(PG8_SA(0, 0), cA, voffA); PG8_STAGE(PG8_SB(0, 1), cB + hstep, voffB); PG8_STAGE(PG8_SA(0, 1), cA + hstep, voffA);
        if (wr == 1) PG8_BAR;
        PG8_WAIT_V(4); PG8_BAR;
        PG8_STAGE(PG8_SB(1, 0), cB + kstep, voffB); PG8_STAGE(PG8_SA(1, 0), cA + kstep, voffA); PG8_STAGE(PG8_SB(1, 1), cB + hstep + kstep, voffB);
        PG8_WAIT_V(6); PG8_BAR;
    }
    for (;;) {
        const bool has_next = S.next(ui + 1, nxt);
        const char* nA = has_next ? (const char*)g.A + (size_t)nxt.pm * tstep : cA; const char* nB = has_next ? (const char*)g.Bt + (size_t)nxt.pn * tstep : cB;
        for (int t = 0; t < nt; t += 2) {
            const bool last = (t == nt - 2);
            const char* a1 = cA + (size_t)(t + 1) * kstep;
            const char* a2 = last ? nA : cA + (size_t)(t + 2) * kstep; const char* b2 = last ? nB : cB + (size_t)(t + 2) * kstep;
            const char* a3 = a2 + kstep; const char* b3 = b2 + kstep;
            if (last && has_next) S.a_ready(nxt);
            if constexpr (SP2) {
            PG8_LDB(B0, 0, 0); PG8_LDB(B1, 0, 1); PG8_SCHED; PG8_LDA(At, 0, 0); PG8_STAGE(PG8_SA(1, 1), a1 + hstep, voffA);
            PG8_WAIT_V(8); PG8_WAIT_L(0); PG8_BAR; PG8_MMA(0, 0, At, B0); PG8_MMA(0, 1, At, B1); PG8_BAR; PG8_SCHED;
            PG8_LDA(At, 0, 1); PG8_STAGE(PG8_SB(0, 0), b2, voffB); PG8_STAGE(PG8_SB(0, 1), b2 + hstep, voffB); PG8_STAGE(PG8_SA(0, 0), a2, voffA);
            PG8_WAIT_V(8); PG8_WAIT_L(0); PG8_BAR; PG8_MMA(1, 0, At, B0); PG8_MMA(1, 1, At, B1); PG8_BAR; PG8_SCHED;
            PG8_LDB(B0, 1, 0); PG8_LDB(B1, 1, 1); PG8_SCHED; PG8_LDA(At, 1, 0); PG8_STAGE(PG8_SA(0, 1), a2 + hstep, voffA);
            PG8_WAIT_V(8); PG8_WAIT_L(0); PG8_BAR; PG8_MMA(0, 0, At, B0); PG8_MMA(0, 1, At, B1); PG8_BAR; PG8_SCHED;
            PG8_LDA(At, 1, 1); PG8_STAGE(PG8_SB(1, 0), b3, voffB); PG8_STAGE(PG8_SB(1, 1), b3 + hstep, voffB); PG8_STAGE(PG8_SA(1, 0), a3, voffA);
            PG8_WAIT_V(8); PG8_WAIT_L(0); PG8_BAR; PG8_MMA(1, 0, At, B0); PG8_MMA(1, 1, At, B1); PG8_BAR; PG8_SCHED;
            } else {
            PG8_LDB(B0, 0, 0); PG8_SCHED; PG8_LDA(At, 0, 0); PG8_STAGE(PG8_SA(1, 1), a1 + hstep, voffA);
            PG8_WAIT_L(8); PG8_BAR; PG8_WAIT_L(0); PG8_MMA(0, 0, At, B0); PG8_BAR; PG8_SCHED;
            PG8_LDB(B1, 0, 1); PG8_STAGE(PG8_SB(0, 0), b2, voffB);
            PG8_BAR; PG8_WAIT_L(0); PG8_MMA(0, 1, At, B1); PG8_BAR;
            PG8_LDA(At, 0, 1); PG8_STAGE(PG8_SA(0, 0), a2, voffA);
            PG8_BAR; PG8_WAIT_L(0); PG8_MMA(1, 0, At, B0); PG8_BAR; PG8_SCHED;
            PG8_STAGE(PG8_SB(0, 1), b2 + hstep, voffB);
            PG8_WAIT_V(6); PG8_BAR; PG8_MMA(1, 1, At, B1); PG8_BAR;
            PG8_LDB(B0, 1, 0); PG8_SCHED; PG8_LDA(At, 1, 0); PG8_STAGE(PG8_SA(0, 1), a2 + hstep, voffA);
            PG8_WAIT_L(8); PG8_BAR; PG8_WAIT_L(0); PG8_MMA(0, 0, At, B0); PG8_BAR; PG8_SCHED;
            PG8_LDB(B1, 1, 1); PG8_STAGE(PG8_SB(1, 0), b3, voffB);
            PG8_BAR; PG8_WAIT_L(0); PG8_MMA(0, 1, At, B1); PG8_BAR;
            PG8_LDA(At, 1, 1); PG8_STAGE(PG8_SA(1, 0), a3, voffA);
            PG8_BAR; PG8_WAIT_L(0); PG8_MMA(1, 0, At, B0); PG8_BAR; PG8_SCHED;
            PG8_STAGE(PG8_SB(1, 1), b3 + hstep, voffB);
            PG8_WAIT_V(6); PG8_BAR; PG8_MMA(1, 1, At, B1); PG8_BAR;
            }
        }
        if constexpr (ALIGN_EPI) { if (wr == 0) PG8_BAR; }
        if constexpr (!Epi::AFTER_DRAIN) { int te_ = threadIdx.x; asm volatile("" : "+v"(te_)); const int fr_e = te_ & 15, fq_e = (te_ >> 4) & 3;
            E(acc, cur, wr, wc, fr_e, fq_e); S.done(cur); }
        if (!has_next) break;
#pragma unroll
        for (int a = 0; a < 2; ++a)
#pragma unroll
            for (int b = 0; b < 2; ++b)
#pragma unroll
                for (int m = 0; m < 4; ++m)
#pragma unroll
                    for (int n = 0; n < 2; ++n) acc[a][b][m][n] = (f32x4){0.f, 0.f, 0.f, 0.f};
        cur = nxt; cA = nA; cB = nB; ++ui;
        if constexpr (ALIGN_EPI) { if (wr == 1) PG8_BAR; }
    }
    PG8_WAIT_V(0);
    if constexpr (!ALIGN_EPI) { if (wr == 0) PG8_BAR; }
    PG8_BAR;
    if constexpr (Epi::AFTER_DRAIN) { E.fused(acc, cur, wr, wc, fr, fq, lds, wid, lane); S.done(cur); }
#undef PG8_SA
#undef PG8_SB
#undef PG8_STAGE
#undef PG8_LDA
#undef PG8_LDB
#undef PG8_MMA
#undef PG8_WAIT_V
#undef PG8_WAIT_L
#undef PG8_BAR
#undef PG8_SCHED
}
}

constexpr int M = 8192, DM = 2048, SEQ = 2048, NPROJ = 4608, DPROJ_SRC = 4616, DFF = 5632, NGU = 11264, DPLE = 256, DEPTH = 4;
constexpr size_t SZ_WIN = (size_t)NPROJ * DM * 2, SZ_WOUT = (size_t)DM * DM * 2, SZ_WGU = (size_t)NGU * DM * 2, SZ_WDN = (size_t)DM * DFF * 2, SZ_WPG = SZ_WOUT, SZ_WPP = (size_t)DM * DPLE * 2;
constexpr size_t OFF_WIN = 0, OFF_WOUT = OFF_WIN + SZ_WIN, OFF_WGU = OFF_WOUT + SZ_WOUT, OFF_WDN = OFF_WGU + SZ_WGU, OFF_WPG = OFF_WDN + SZ_WDN, OFF_WPP = OFF_WPG + SZ_WPG, SZ_LAYER = OFF_WPP + SZ_WPP;
constexpr size_t WS_W = 1u << 20, WS_XN = WS_W + DEPTH * SZ_LAYER, WS_PROJ = WS_XN + (size_t)M * DM * 2, WS_MIX = WS_PROJ + (size_t)M * NPROJ * 2, WS_ACT = WS_MIX + (size_t)M * DM * 2,
                 WS_PP = WS_ACT + (size_t)M * DFF * 2, WS_PBF = WS_PP + (size_t)M * DM * 2, WS_LOGF = WS_PBF + (size_t)DEPTH * M * DPLE * 2, WS_CUM = WS_LOGF + (size_t)M * 8 * 4, WS_END = WS_CUM + (size_t)M * 8 * 4;
constexpr int LDS_BYTES = 147456;
constexpr int XB_LDS_OFF = LDS_BYTES - 64;
constexpr size_t WS_BAR = 4096;
constexpr float EPS = 1e-6f;

typedef unsigned short bf16;
typedef unsigned v4u __attribute__((ext_vector_type(4)));
typedef unsigned v2u __attribute__((ext_vector_type(2)));
typedef float f32x4 __attribute__((ext_vector_type(4)));
#define LAS __attribute__((address_space(3)))
#define LDS_WAIT() asm volatile("s_waitcnt lgkmcnt(0)" ::: "memory")
#define OPAQUE_TID() int tid; { int t_ = threadIdx.x; asm volatile("" : "+v"(t_)); tid = t_; } const int lane = tid & 63, wave = __builtin_amdgcn_readfirstlane(tid >> 6); (void)lane; (void)wave

__device__ __forceinline__ unsigned f2bf(float f) { unsigned u = __builtin_bit_cast(unsigned, f); return (u + 0x7fffu + ((u >> 16) & 1u)) >> 16; }
__device__ __forceinline__ unsigned pk2(float lo, float hi) { return f2bf(lo) | (f2bf(hi) << 16); }
__device__ __forceinline__ float bflo(unsigned w) { return __uint_as_float(w << 16); }
__device__ __forceinline__ float bfhi(unsigned w) { return __uint_as_float(w & 0xffff0000u); }
__device__ __forceinline__ float bf2f(bf16 v) { return __uint_as_float((unsigned)v << 16); }
__device__ __forceinline__ float wave_sum(float v) {
#pragma unroll
    for (int o = 1; o < 64; o <<= 1) v += __shfl_xor(v, o);
    return v;
}
__device__ __forceinline__ float gelu_tanh(float x) { const float y2 = 1.5957691216057308f * (x + 0.044715f * x * x * x); return x / (1.0f + __expf(-y2)); }
__device__ __forceinline__ float log_sigmoid(float x) { return fminf(x, 0.f) - __logf(1.0f + __expf(-fabsf(x))); }

__device__ __forceinline__ unsigned char* opq_ptr(unsigned char* p) { asm volatile("" : "+s"(p)); return p; }
struct Args { const float* in[20]; float* out; unsigned char* ws; };
enum { I_X = 0, I_P, I_NORM_MIX, I_W_IN, I_Q_NORM, I_K_NORM, I_FBIAS, I_GV_NORM, I_G_WS, I_G_BS, I_POOL_W, I_POOL_SCALE, I_W_OUT, I_NORM_FFN, I_W_GATE, I_W_UP, I_W_DOWN, I_NORM_PLE, I_W_PG, I_W_PP };

struct TrItem { const float* src; bf16* dst; int ldw, K; };
__device__ __forceinline__ TrItem tr_decode(const Args& a, int it) {
    constexpr int I_IN = 16 * 36, I_OUT = 16 * 16, I_GU = 16 * 88, I_DN = 44 * 16, I_PG = 16 * 16, I_PPN = 2 * 16, I_L = I_IN + I_OUT + I_GU + I_DN + I_PG + I_PPN;
    const int L = it / I_L; int r = it - L * I_L;
    unsigned char* wl = a.ws + WS_W + (size_t)L * SZ_LAYER;
    TrItem t;
    if (r < I_IN) { const int kb = r / 36, nb = r - kb * 36, n0 = nb * 128, c0 = n0 < 3072 ? n0 : n0 + 8;
        t.ldw = DPROJ_SRC; t.K = DM; t.src = a.in[I_W_IN] + (size_t)L * DM * DPROJ_SRC + (size_t)kb * 128 * DPROJ_SRC + c0; t.dst = (bf16*)(wl + OFF_WIN) + (size_t)n0 * DM + kb * 128; }
    else if ((r -= I_IN) < I_OUT) { const int kb = r / 16, nb = r - kb * 16, n0 = nb * 128;
        t.ldw = DM; t.K = DM; t.src = a.in[I_W_OUT] + (size_t)L * DM * DM + (size_t)kb * 128 * DM + n0; t.dst = (bf16*)(wl + OFF_WOUT) + (size_t)n0 * DM + kb * 128; }
    else if ((r -= I_OUT) < I_GU) { const int kb = r / 88, nb = r - kb * 88, n0 = nb * 128, tt = nb >> 1, half = nb & 1;
        t.ldw = DFF; t.K = DM; t.src = (half ? a.in[I_W_UP] : a.in[I_W_GATE]) + (size_t)L * DM * DFF + (size_t)kb * 128 * DFF + tt * 128; t.dst = (bf16*)(wl + OFF_WGU) + (size_t)n0 * DM + kb * 128; }
    else if ((r -= I_GU) < I_DN) { const int kb = r / 16, nb = r - kb * 16, n0 = nb * 128;
        t.ldw = DM; t.K = DFF; t.src = a.in[I_W_DOWN] + (size_t)L * DFF * DM + (size_t)kb * 128 * DM + n0; t.dst = (bf16*)(wl + OFF_WDN) + (size_t)n0 * DFF + kb * 128; }
    else if ((r -= I_DN) < I_PG) { const int kb = r / 16, nb = r - kb * 16, n0 = nb * 128;
        t.ldw = DM; t.K = DM; t.src = a.in[I_W_PG] + (size_t)L * DM * DM + (size_t)kb * 128 * DM + n0; t.dst = (bf16*)(wl + OFF_WPG) + (size_t)n0 * DM + kb * 128; }
    else { r -= I_PG; const int kb = r / 16, nb = r - kb * 16, n0 = nb * 128;
        t.ldw = DM; t.K = DPLE; t.src = a.in[I_W_PP] + (size_t)L * DPLE * DM + (size_t)kb * 128 * DM + n0; t.dst = (bf16*)(wl + OFF_WPP) + (size_t)n0 * DPLE + kb * 128; }
    return t;
}
constexpr int I_LAYER = 16 * 36 + 16 * 16 + 16 * 88 + 44 * 16 + 16 * 16 + 2 * 16;
__device__ __forceinline__ void convert_weights(const Args& a, LAS unsigned char* lds, int it_lo, int it_hi, int wg_i, int wg_n) {
    OPAQUE_TID();
    const int NITEMS = it_hi;
    constexpr int RSB = 272;
    const int ng = tid & 31, kg = tid >> 5;
    const int orow = tid >> 4, och = tid & 15;
    f32x4 v[8];
    int it = it_lo + wg_i;
    TrItem cur;
    if (it < NITEMS) { cur = tr_decode(a, it);
#pragma unroll
        for (int r = 0; r < 8; ++r) v[r] = *(const f32x4*)(cur.src + (size_t)(8 * kg + r) * cur.ldw + 4 * ng); }
    while (it < NITEMS) {
#pragma unroll
        for (int j = 0; j < 4; ++j) { v4u o; o.x = pk2(v[0][j], v[1][j]); o.y = pk2(v[2][j], v[3][j]); o.z = pk2(v[4][j], v[5][j]); o.w = pk2(v[6][j], v[7][j]);
            *(LAS v4u*)(lds + (4 * ng + j) * RSB + 16 * kg) = o; }
        __syncthreads();
        const int nit = it + wg_n; const TrItem out = cur;
        if (nit < NITEMS) { cur = tr_decode(a, nit);
#pragma unroll
            for (int r = 0; r < 8; ++r) v[r] = *(const f32x4*)(cur.src + (size_t)(8 * kg + r) * cur.ldw + 4 * ng); }
#pragma unroll
        for (int j = 0; j < 4; ++j) { const int n = orow + 32 * j; const v4u o = *(const LAS v4u*)(lds + n * RSB + 16 * och);
            *(v4u*)(out.dst + (size_t)n * out.K + 8 * och) = o; }
        __syncthreads();
        it = nit;
    }
}

__device__ __forceinline__ void convert_p(const Args& a) {
    OPAQUE_TID();
    { const size_t n8 = (size_t)DEPTH * M * DPLE / 8; const float* p = a.in[I_P]; bf16* pb = (bf16*)(a.ws + WS_PBF);
      for (size_t i = (size_t)blockIdx.x * 512 + tid; i < n8; i += (size_t)gridDim.x * 512) {
          const f32x4 x0 = *(const f32x4*)(p + i * 8), x1 = *(const f32x4*)(p + i * 8 + 4);
          v4u o; o.x = pk2(x0[0], x0[1]); o.y = pk2(x0[2], x0[3]); o.z = pk2(x1[0], x1[1]); o.w = pk2(x1[2], x1[3]);
          *(v4u*)(pb + i * 8) = o; } }
}

__device__ __forceinline__ void norm_phase(const float* h, const float* gain, bf16* xn, bool with_f, const float* win_l, const float* fbias, float* logf,
                                           unsigned char* lds) {
    OPAQUE_TID();
    float* wf = (float*)lds;
    if (with_f) {
        for (int c = tid; c < DM; c += 512) {
            const f32x4 x0 = *(const f32x4*)(win_l + (size_t)c * DPROJ_SRC + 3072), x1 = *(const f32x4*)(win_l + (size_t)c * DPROJ_SRC + 3076);
            wf[0 * DM + c] = x0[0]; wf[1 * DM + c] = x0[1]; wf[2 * DM + c] = x0[2]; wf[3 * DM + c] = x0[3];
            wf[4 * DM + c] = x1[0]; wf[5 * DM + c] = x1[1]; wf[6 * DM + c] = x1[2]; wf[7 * DM + c] = x1[3]; }
        __syncthreads();
    }
    const int gw = blockIdx.x * 8 + wave, NGW = gridDim.x * 8;
    f32x4 g[8];
#pragma unroll
    for (int j = 0; j < 8; ++j) g[j] = *(const f32x4*)(gain + 4 * lane + 256 * j);
    for (int row = gw; row < M; row += NGW) {
        const f32x4* xr = (const f32x4*)(h + (size_t)row * DM) + lane;
        f32x4 v[8]; float ss = 0.f;
#pragma unroll
        for (int j = 0; j < 8; ++j) { v[j] = xr[64 * j]; ss += (v[j][0] * v[j][0] + v[j][1] * v[j][1]) + (v[j][2] * v[j][2] + v[j][3] * v[j][3]); }
        ss = wave_sum(ss);
        const float rinv = 1.0f / sqrtf(ss * (1.0f / DM) + EPS);
        v2u* o8 = (v2u*)(xn + (size_t)row * DM) + lane;
#pragma unroll
        for (int j = 0; j < 8; ++j) { v[j] = v[j] * rinv * g[j]; v2u w; w.x = pk2(v[j][0], v[j][1]); w.y = pk2(v[j][2], v[j][3]); o8[64 * j] = w; }
        if (with_f) {
            float f[8];
#pragma unroll
            for (int hh = 0; hh < 8; ++hh) { float s = 0.f;
#pragma unroll
                for (int j = 0; j < 8; ++j) { const f32x4 w = *(const f32x4*)(wf + hh * DM + 4 * lane + 256 * j); s += (v[j][0] * w[0] + v[j][1] * w[1]) + (v[j][2] * w[2] + v[j][3] * w[3]); }
                f[hh] = wave_sum(s); asm volatile("" ::: "memory"); }
            float mine = f[0];
#pragma unroll
            for (int hh = 1; hh < 8; ++hh) mine = (lane == hh) ? f[hh] : mine;
            if (lane < 8) logf[(size_t)row * 8 + lane] = log_sigmoid(mine + fbias[lane]);
        }
    }
    if (with_f) __syncthreads();
}

__device__ __forceinline__ void post_phase(bf16* proj, const float* qg, const float* kg, const float* logf, float* cum) {
    OPAQUE_TID();
    const int gw = blockIdx.x * 8 + wave, NGW = gridDim.x * 8;
    const int d0 = 8 * (lane & 15);
    float gq[8], gk[8];
#pragma unroll
    for (int e = 0; e < 8; ++e) { gq[e] = qg[d0 + e]; gk[e] = kg[d0 + e]; }
    for (int row = gw; row < M; row += NGW) {
        v4u* pr = (v4u*)(proj + (size_t)row * NPROJ);
#pragma unroll
        for (int j = 0; j < 4; ++j) {
            const v4u w = pr[lane + 64 * j];
            float x[8] = {bflo(w.x), bfhi(w.x), bflo(w.y), bfhi(w.y), bflo(w.z), bfhi(w.z), bflo(w.w), bfhi(w.w)};
            float ss = 0.f;
#pragma unroll
            for (int e = 0; e < 8; ++e) ss += x[e] * x[e];
            ss += __shfl_xor(ss, 1); ss += __shfl_xor(ss, 2); ss += __shfl_xor(ss, 4); ss += __shfl_xor(ss, 8);
            const float rinv = 1.0f / sqrtf(ss * (1.0f / 128.0f) + EPS);
#pragma unroll
            for (int e = 0; e < 8; ++e) x[e] = x[e] * rinv * (j < 2 ? gq[e] : gk[e]);
            v4u o; o.x = pk2(x[0], x[1]); o.y = pk2(x[2], x[3]); o.z = pk2(x[4], x[5]); o.w = pk2(x[6], x[7]);
            pr[lane + 64 * j] = o;
        }
    }
    for (int bh = blockIdx.x; bh < 32; bh += gridDim.x) if (wave == 0) {
        const int b = bh >> 3, hh = bh & 7;
        float loc[32]; float run = 0.f;
#pragma unroll
        for (int i = 0; i < 32; ++i) { run += logf[((size_t)(b * SEQ + lane * 32 + i)) * 8 + hh]; loc[i] = run; }
        float inc = run;
#pragma unroll
        for (int o = 1; o < 64; o <<= 1) { const float t = __shfl_up(inc, o); if (lane >= o) inc += t; }
        const float excl = inc - run;
#pragma unroll
        for (int i = 0; i < 32; ++i) cum[(size_t)bh * SEQ + lane * 32 + i] = excl + loc[i];
    }
}

#define XB_TMO      128
#define XB_XCNT(j)  (256  + 64 * (j))
#define XB_XSUB(j)  (1280 + 64 * (j))
#define XB_XGEN(j)  (2304 + 64 * (j))
#define XB_TOP      3328
#define XB_TOPGEN   3392
#define XCD_BAR_WORDS 3456
#define XB_SPIN_CAP (1u << 18)

__device__ __forceinline__ unsigned xb_ld(unsigned* p)              { return __hip_atomic_load(p, __ATOMIC_RELAXED, __HIP_MEMORY_SCOPE_AGENT); }
__device__ __forceinline__ unsigned xb_add(unsigned* p, unsigned v) { return __hip_atomic_fetch_add(p, v, __ATOMIC_RELAXED, __HIP_MEMORY_SCOPE_AGENT); }
__device__ __forceinline__ unsigned xb_xcc_id() { return (unsigned)__builtin_amdgcn_s_getreg((3 << 11) | 20) & 0xFu; }
#define XB_SPIN(cond, bar) do { unsigned _sp = 0; while (cond) { __builtin_amdgcn_s_sleep(1); \
    if ((++_sp & 255u) == 0u) { if (xb_ld(&(bar)[XB_TMO])) break; if (_sp > XB_SPIN_CAP) { atomicAdd(&(bar)[XB_TMO], 1u); break; } } } } while (0)

struct XcdBarrier {
    unsigned* bar; unsigned x;
    volatile LAS unsigned* st;
};

__device__ __forceinline__ XcdBarrier xcd_barrier_post(unsigned* bar, volatile LAS unsigned* st) {
    XcdBarrier b; b.bar = bar; b.x = xb_xcc_id(); b.st = st;
    if (threadIdx.x == 0) (void)xb_add(&bar[XB_XCNT(b.x)], 1u);
    return b;
}
__device__ __forceinline__ void xcd_barrier_complete(unsigned* bar, unsigned x, unsigned& nloc, unsigned& nx) {
    const unsigned G = gridDim.x * gridDim.y * gridDim.z;
    unsigned sum, cnt, mine, sp = 0u;
    for (;;) {
        sum = 0u; cnt = 0u; mine = 0u;
#pragma unroll
        for (unsigned j = 0; j < 16; ++j) { const unsigned c = xb_ld(&bar[XB_XCNT(j)]); sum += c; cnt += (c > 0u) ? 1u : 0u; mine = (j == x) ? c : mine; }
        if (sum == G) break;
        __builtin_amdgcn_s_sleep(1);
        if ((++sp & 255u) == 0u) { if (xb_ld(&bar[XB_TMO])) break; if (sp > XB_SPIN_CAP) { atomicAdd(&bar[XB_TMO], 1u); break; } }
    }
    nloc = mine > 0u ? mine : 1u; nx = cnt > 0u ? cnt : 1u;
}

__device__ __forceinline__ void xcd_barrier(const XcdBarrier& b) {
    asm volatile("s_waitcnt vmcnt(0)" ::: "memory");
    __syncthreads();
    if (threadIdx.x == 0) {
        unsigned* bar = b.bar;
        __builtin_amdgcn_s_waitcnt(0);
        unsigned nloc = b.st[0], nx = b.st[1];
        if (nloc == 0u) { xcd_barrier_complete(bar, b.x, nloc, nx); b.st[0] = nloc; b.st[1] = nx; }
        const unsigned old = xb_add(&bar[XB_XSUB(b.x)], 1u);
        const unsigned gen = old / nloc;
        if (old + 1u == (gen + 1u) * nloc) {
            __builtin_amdgcn_fence(__ATOMIC_RELEASE, "agent");
            asm volatile("s_waitcnt vmcnt(0)" ::: "memory");
            const unsigned og = xb_add(&bar[XB_TOP], 1u);
            const unsigned tg = og / nx;
            if (og + 1u == (tg + 1u) * nx) xb_add(&bar[XB_TOPGEN], 1u);
            else XB_SPIN(xb_ld(&bar[XB_TOPGEN]) == tg, bar);
            __builtin_amdgcn_fence(__ATOMIC_ACQUIRE, "agent");
            xb_add(&bar[XB_XGEN(b.x)], 1u);
            asm volatile("s_waitcnt vmcnt(0)" ::: "memory");
        } else {
            XB_SPIN(xb_ld(&bar[XB_XGEN(b.x)]) == gen, bar);
            __builtin_amdgcn_fence(__ATOMIC_ACQUIRE, "agent");
            asm volatile("s_waitcnt vmcnt(0)" ::: "memory");
        }
    }
    __syncthreads();
}


typedef short mm_bf16x8 __attribute__((ext_vector_type(8)));
constexpr int MXS = 136;

__device__ __forceinline__ void gmlp_mfma(const bf16* proj, const float* vgain, const float* wsp, const float* bs, bf16* mix, unsigned char* lds_) {
    bf16* Wl = (bf16*)lds_;
    bf16* Vt = (bf16*)lds_ + 128 * MXS;
    const int half_ = gridDim.x >> 1;
    if ((int)blockIdx.x < half_) return;
    for (int item = blockIdx.x - half_; item < 256; item += gridDim.x - half_) {
        OPAQUE_TID();
        const int g = item & 3, n = (item >> 2) & 15, b = item >> 6;
        const size_t row0 = (size_t)b * SEQ + n * 128;
        { const float* wg = wsp + (size_t)g * 128 * 128;
#pragma unroll 4
          for (int i = 0; i < 8; ++i) { const int e = (i * 512 + tid) * 4, t = e >> 7, s = e & 127;
              const f32x4 w = *(const f32x4*)(wg + e);
              v2u o; o.x = pk2(s <= t ? w[0] : 0.f, s + 1 <= t ? w[1] : 0.f); o.y = pk2(s + 2 <= t ? w[2] : 0.f, s + 3 <= t ? w[3] : 0.f);
              *(v2u*)(Wl + t * MXS + s) = o; } }
        for (int i = 0; i < 16; ++i) { const int s = wave * 16 + i;
            const unsigned w = *(const unsigned*)(proj + (row0 + s) * NPROJ + 3584 + g * 128 + 2 * lane);
            const float v0 = gelu_tanh(bflo(w)), v1 = gelu_tanh(bfhi(w));
            const float ss = wave_sum(v0 * v0 + v1 * v1); const float rinv = 1.0f / sqrtf(ss * (1.0f / 128.0f) + EPS);
            Vt[(2 * lane) * MXS + s] = (bf16)f2bf(v0 * rinv * vgain[g * 128 + 2 * lane]); Vt[(2 * lane + 1) * MXS + s] = (bf16)f2bf(v1 * rinv * vgain[g * 128 + 2 * lane + 1]); }
        __syncthreads();
        { const int fr = lane & 15, fq = lane >> 4;
          f32x4 acc[8];
#pragma unroll
          for (int cb = 0; cb < 8; ++cb) acc[cb] = (f32x4){0.f, 0.f, 0.f, 0.f};
          const int nkc = (16 * (wave + 1) + 31) >> 5;
          for (int kc = 0; kc < nkc; ++kc) {
              const mm_bf16x8 af = *(const mm_bf16x8*)(Wl + (16 * wave + fr) * MXS + kc * 32 + fq * 8);
#pragma unroll
              for (int cb = 0; cb < 8; ++cb) { const mm_bf16x8 bf = *(const mm_bf16x8*)(Vt + (16 * cb + fr) * MXS + kc * 32 + fq * 8);
                  acc[cb] = __builtin_amdgcn_mfma_f32_16x16x32_bf16(bf, af, acc[cb], 0, 0, 0); } }
          const int t = 16 * wave + fr; const float bt = bs[g * 128 + t];
#pragma unroll
          for (int cb = 0; cb < 8; ++cb) { const int c = 16 * cb + 4 * fq;
              const v2u uw = *(const v2u*)(proj + (row0 + t) * NPROJ + 3072 + g * 128 + c);
              v2u o; o.x = pk2(gelu_tanh(bflo(uw.x)) * (acc[cb][0] + bt), gelu_tanh(bfhi(uw.x)) * (acc[cb][1] + bt));
              o.y = pk2(gelu_tanh(bflo(uw.y)) * (acc[cb][2] + bt), gelu_tanh(bfhi(uw.y)) * (acc[cb][3] + bt));
              *(v2u*)(mix + (row0 + t) * DM + 1024 + g * 128 + c) = o; } }
        __syncthreads();
    }
}

__device__ __forceinline__ void pool_mfma(const bf16* proj, const float* pw, const float* pscale, bf16* mix, unsigned char* lds_) {
    bf16* Wt = (bf16*)lds_;
    bf16* Dl = (bf16*)lds_ + 128 * MXS;
    const int half_ = gridDim.x >> 1;
    if ((int)blockIdx.x < half_) return;
    for (int item = blockIdx.x - half_; item < 256; item += gridDim.x - half_) {
        OPAQUE_TID();
        const int g = item & 3, tb = item >> 2; const size_t row0 = (size_t)tb * 128; const int sbase = (tb * 128) % SEQ;
        const int win = 2 << g;
        { const float* wg = pw + (size_t)g * 128 * 128;
#pragma unroll 4
          for (int i = 0; i < 8; ++i) { const int e = (i * 512 + tid) * 4, c = e >> 7, dd = e & 127;
              const f32x4 w = *(const f32x4*)(wg + e);
              Wt[(dd + 0) * MXS + c] = (bf16)f2bf(w[0]); Wt[(dd + 1) * MXS + c] = (bf16)f2bf(w[1]); Wt[(dd + 2) * MXS + c] = (bf16)f2bf(w[2]); Wt[(dd + 3) * MXS + c] = (bf16)f2bf(w[3]); } }
        { const int r0 = wave * 16; const bf16* xp = proj + 4096 + g * 128 + 2 * lane;
          float x0[31], x1[31];
#pragma unroll
          for (int k = 0; k < 31; ++k) { const int r = r0 - 15 + k; unsigned w = 0u;
              if (sbase + r >= 0) w = *(const unsigned*)(xp + (size_t)((long)row0 + r) * NPROJ);
              x0[k] = bflo(w); x1[k] = bfhi(w); }
#pragma unroll
          for (int i = 0; i < 16; ++i) { const int k = i + 15, s = sbase + r0 + i;
              float s0 = 0.f, s1 = 0.f;
#pragma unroll
              for (int j = 0; j < 16; ++j) { if (j < win) { s0 += x0[k - j]; s1 += x1[k - j]; } }
              const int cnt = (s + 1 < win) ? (s + 1) : win; const float ic = 1.0f / (float)cnt;
              *(unsigned*)(Dl + (r0 + i) * MXS + 2 * lane) = pk2(s0 * ic - x0[k], s1 * ic - x1[k]); } }
        __syncthreads();
        { const int fr = lane & 15, fq = lane >> 4;
          f32x4 acc[8];
#pragma unroll
          for (int db = 0; db < 8; ++db) acc[db] = (f32x4){0.f, 0.f, 0.f, 0.f};
#pragma unroll
          for (int kc = 0; kc < 4; ++kc) {
              const mm_bf16x8 af = *(const mm_bf16x8*)(Dl + (16 * wave + fr) * MXS + kc * 32 + fq * 8);
#pragma unroll
              for (int db = 0; db < 8; ++db) { const mm_bf16x8 bf = *(const mm_bf16x8*)(Wt + (16 * db + fr) * MXS + kc * 32 + fq * 8);
                  acc[db] = __builtin_amdgcn_mfma_f32_16x16x32_bf16(bf, af, acc[db], 0, 0, 0); } }
          const int s = 16 * wave + fr;
#pragma unroll
          for (int db = 0; db < 8; ++db) { const int dd = 16 * db + 4 * fq; const f32x4 sc = *(const f32x4*)(pscale + g * 128 + dd);
              v2u o; o.x = pk2(acc[db][0] * sc[0], acc[db][1] * sc[1]); o.y = pk2(acc[db][2] * sc[2], acc[db][3] * sc[3]);
              *(v2u*)(mix + (row0 + s) * DM + 1536 + g * 128 + dd) = o; } }
        __syncthreads();
    }
}

namespace fa {
constexpr int D = 128;
constexpr float THR = 8.f;
constexpr bool WSKIP = false;
constexpr int KVP = 4608, QP = 4608, OP = 2048;
constexpr float SCALE = 0.08838834764831845f;
constexpr int NW = 8, QBLK = 32, KVBLK = 64, QB = NW * QBLK;
constexpr int SHM_V = KVBLK * D * 2, SHM_K = KVBLK * D * 2;
constexpr int BIAS_OFF = 2 * SHM_V + 2 * SHM_K + NW * 64 * 4;
constexpr int Q_OFF = BIAS_OFF + 2048 * 4;
constexpr int FA_LDS_BYTES = Q_OFF + 8 * 8192;

typedef short bf16x8 __attribute__((ext_vector_type(8)));
typedef short s16x4 __attribute__((ext_vector_type(4)));
typedef float f32x16 __attribute__((ext_vector_type(16)));
typedef float f32x4 __attribute__((ext_vector_type(4)));
typedef unsigned u32x4 __attribute__((ext_vector_type(4)));
template <class A, class Bt> struct same_t { static constexpr bool v = false; };
template <class A> struct same_t<A, A> { static constexpr bool v = true; };

#define KSWZ(row, colB) ((row) * 256 + ((colB) ^ (((row) & 7) << 4)))
#define SBAR() __builtin_amdgcn_sched_barrier(0)
__device__ __forceinline__ int v_st(int k, int c) { const int kk = (k & ~0xC) | ((k & 4) << 1) | ((k & 8) >> 1); return ((kk >> 3) * 4 + (c >> 5)) * 512 + ((kk & 7) * 32 + (c & 31)) * 2; }
__device__ __forceinline__ int v_rd_base(int lane) { return ((lane & 3) << 3) | (((lane >> 2) & 3) << 6) | (((lane >> 4) & 1) << 5) | (((lane >> 5) & 1) << 8); }
constexpr int v_rd_off(int d0, int ks, int half) { return d0 * 512 + ks * 4096 + half * 2048; }
__device__ __forceinline__ int crow(int r, int hi) { return (r & 3) + 8 * (r >> 2) + 4 * hi; }
__device__ __forceinline__ unsigned cvtpk(float lo, float hi) {
    unsigned r; asm volatile("v_cvt_pk_bf16_f32 %0, %1, %2" : "=v"(r) : "v"(lo), "v"(hi)); return r;
}
__device__ __forceinline__ bf16x8 pack8(f32x4 a, f32x4 b) {
    u32x4 w = {cvtpk(a[0], a[1]), cvtpk(a[2], a[3]), cvtpk(b[0], b[1]), cvtpk(b[2], b[3])};
    return *reinterpret_cast<bf16x8*>(&w);
}
template <class T> __device__ __forceinline__ bf16x8 load8(const T* p) {
    if constexpr (same_t<T, float>::v) { return pack8(*(const f32x4*)p, *(const f32x4*)(p + 4)); }
    else { return *reinterpret_cast<const bf16x8*>(p); }
}
__device__ __forceinline__ void mask_tile(f32x16& p0, f32x16& p1, int dq, unsigned W) {
    const float NEG = -__builtin_inff();
#pragma unroll
    for (int r = 0; r < 16; ++r) {
        const int c = (r & 3) + 8 * (r >> 2);
        if ((unsigned)(dq - c) >= W) p0[r] = NEG;
        if ((unsigned)(dq - c - 32) >= W) p1[r] = NEG;
    }
}
__device__ __forceinline__ void partialSM(f32x16& p0, f32x16& p1, float& m_reg, float& mn, float& alpha) {
    float pmax = p0[0]; for (int r = 1; r < 16; ++r) pmax = fmaxf(pmax, p0[r]); for (int r = 0; r < 16; ++r) pmax = fmaxf(pmax, p1[r]);
    { auto rr = __builtin_amdgcn_permlane32_swap(__float_as_uint(pmax), __float_as_uint(pmax), false, false);
      pmax = fmaxf(__uint_as_float(rr[0]), __uint_as_float(rr[1])); }
    constexpr float C2 = 1.4426950408889634f * SCALE;
    if (__builtin_expect(__all((pmax - m_reg) * SCALE <= THR), 1)) { mn = m_reg; alpha = 1.f; }
    else { mn = fmaxf(m_reg, pmax); alpha = __builtin_amdgcn_exp2f((m_reg - mn) * C2); m_reg = mn; }
    const float mnL = -mn * C2;
    for (int r = 0; r < 16; ++r) p0[r] = fmaf(p0[r], C2, mnL); for (int r = 0; r < 16; ++r) p1[r] = fmaf(p1[r], C2, mnL);
    for (int r = 0; r < 16; ++r) p0[r] = __builtin_amdgcn_exp2f(p0[r]);
}
__device__ __forceinline__ void finishSM(f32x16& p0, f32x16& p1, float alpha, float& l_reg, bf16x8& pa0, bf16x8& pa1, bf16x8& pa2, bf16x8& pa3) {
    for (int r = 0; r < 16; ++r) p1[r] = __builtin_amdgcn_exp2f(p1[r]);
    float ps = 0; for (int r = 0; r < 16; ++r) ps += p0[r]; for (int r = 0; r < 16; ++r) ps += p1[r];
    { auto rr = __builtin_amdgcn_permlane32_swap(__float_as_uint(ps), __float_as_uint(ps), false, false);
      ps = __uint_as_float(rr[0]) + __uint_as_float(rr[1]); }
    l_reg = l_reg * alpha + ps;
#define PK4(P, B_, OUT) do { unsigned a0 = cvtpk(P[B_+0], P[B_+1]), a1 = cvtpk(P[B_+2], P[B_+3]);                          \
        unsigned b0 = cvtpk(P[B_+4], P[B_+5]), b1 = cvtpk(P[B_+6], P[B_+7]);                                             \
        auto r0 = __builtin_amdgcn_permlane32_swap(a0, b0, false, false); auto r1 = __builtin_amdgcn_permlane32_swap(a1, b1, false, false); \
        u32x4 w = {r0[0], r1[0], r0[1], r1[1]}; OUT = *reinterpret_cast<bf16x8*>(&w); } while (0)
    PK4(p0, 0, pa0); PK4(p0, 8, pa1); PK4(p1, 0, pa2); PK4(p1, 8, pa3);
#undef PK4
}
template <int KB, bool SK>
__device__ __forceinline__ void qkt(f32x16& p0, f32x16& p1, const char* K_lds, int r32, int hi, const char* Qw, bool act, const float* bt) {
    if (SK && !act) { const float NEG = -__builtin_inff();
#pragma unroll
        for (int r = 0; r < 16; ++r) { p0[r] = NEG; p1[r] = NEG; } return; }
#pragma unroll
    for (int g_ = 0; g_ < 4; ++g_) { const f32x4 b0_ = *(const f32x4*)(bt + 8 * g_), b1_ = *(const f32x4*)(bt + 32 + 8 * g_);
#pragma unroll
        for (int j_ = 0; j_ < 4; ++j_) { p0[4 * g_ + j_] = b0_[j_]; p1[4 * g_ + j_] = b1_[j_]; } }
    const char* kb[4];
#pragma unroll
    for (int dd = 0; dd < 4; ++dd) kb[dd] = K_lds + KB * SHM_K + KSWZ(r32, (dd * 16 + hi * 8) * 2);
#pragma unroll
    for (int d0 = 0; d0 < 8; ++d0) { const char* a = kb[d0 & 3] + (d0 >> 2) * 128;
        bf16x8 b0 = *reinterpret_cast<const bf16x8*>(a);
        bf16x8 b1 = *reinterpret_cast<const bf16x8*>(a + 32 * 256);
        const bf16x8 q_ = *reinterpret_cast<const bf16x8*>(Qw + KSWZ(r32, ((d0 & 3) * 16 + hi * 8) * 2) + (d0 >> 2) * 128);
        p0 = __builtin_amdgcn_mfma_f32_32x32x16_bf16(b0, q_, p0, 0, 0, 0);
        p1 = __builtin_amdgcn_mfma_f32_32x32x16_bf16(b1, q_, p1, 0, 0, 0); }
}
template <int VB, bool SK>
__device__ __forceinline__ void pv_tile(f32x16* o, int vb0, bf16x8 pa0, bf16x8 pa1, bf16x8 pa2, bf16x8 pa3, bool act) {
    if (SK && !act) return;
#define TRRD(dst, off) asm volatile("ds_read_b64_tr_b16 %0, %1 offset:%2" : "=&v"(dst) : "v"(vb0), "i"(off) : "memory")
#define PV_D0(d0) do { s16x4 l0, l1, l2, l3, h0, h1, h2, h3; constexpr int b_ = VB * SHM_V + v_rd_off(d0, 0, 0);     \
        TRRD(l0, b_); TRRD(h0, b_ + 2048); TRRD(l1, b_ + 4096); TRRD(h1, b_ + 6144); TRRD(l2, b_ + 8192); TRRD(h2, b_ + 10240); TRRD(l3, b_ + 12288); TRRD(h3, b_ + 14336); \
        asm volatile("s_waitcnt lgkmcnt(0)" ::: "memory"); SBAR();                 \
        o[d0] = __builtin_amdgcn_mfma_f32_32x32x16_bf16(pa0, (bf16x8){l0[0], l0[1], l0[2], l0[3], h0[0], h0[1], h0[2], h0[3]}, o[d0], 0, 0, 0);   \
        o[d0] = __builtin_amdgcn_mfma_f32_32x32x16_bf16(pa1, (bf16x8){l1[0], l1[1], l1[2], l1[3], h1[0], h1[1], h1[2], h1[3]}, o[d0], 0, 0, 0);   \
        o[d0] = __builtin_amdgcn_mfma_f32_32x32x16_bf16(pa2, (bf16x8){l2[0], l2[1], l2[2], l2[3], h2[0], h2[1], h2[2], h2[3]}, o[d0], 0, 0, 0);   \
        o[d0] = __builtin_amdgcn_mfma_f32_32x32x16_bf16(pa3, (bf16x8){l3[0], l3[1], l3[2], l3[3], h3[0], h3[1], h3[2], h3[3]}, o[d0], 0, 0, 0); } while (0)
    PV_D0(0); PV_D0(1); PV_D0(2); PV_D0(3);
#undef PV_D0
#undef TRRD
}

template <class TIn, class TOut> struct BlockRef { const TIn* Q; const TIn* K; const TIn* V; TOut* O; int P0; };
template <class TIn> struct Seam {
    bf16x8 st_v0, st_v1, st_k0, st_k1; f32x4 sf0, sf1, sf2, sf3;
    f32x4 tq[16];
};
__device__ __forceinline__ int swa_jlo(int P0, int W) { const int lowk = P0 - W + 1; return lowk > 0 ? lowk / KVBLK : 0; }
#define ROW(p, k0, rr) ((p) + (size_t)((k0) + (rr)) * KVP + sc)
#define VMW() asm volatile("s_waitcnt vmcnt(0)" ::: "memory")
#define VMWN(n) asm volatile("s_waitcnt vmcnt(%0)" :: "i"(n) : "memory")
#define SLOAD_H(Kp, Vp, k0) do { S.st_v0 = load8<TIn>(ROW(Vp, k0, sr)); S.st_v1 = load8<TIn>(ROW(Vp, k0, 32 + sr));              \
                         S.st_k0 = load8<TIn>(ROW(Kp, k0, sr)); S.st_k1 = load8<TIn>(ROW(Kp, k0, 32 + sr)); } while (0)
#define SWRITE_HK(bf) do { *(bf16x8*)(K_lds + (bf) * SHM_K + kws) = S.st_k0; *(bf16x8*)(K_lds + (bf) * SHM_K + kws + 32 * 256) = S.st_k1; } while (0)
#define SWRITE_HV(bf) do { *(bf16x8*)(V_lds + (bf) * SHM_V + vst0) = S.st_v0; *(bf16x8*)(V_lds + (bf) * SHM_V + vst1) = S.st_v1; } while (0)
#define SWRITE_H(bf) do { SWRITE_HV(bf); SWRITE_HK(bf); } while (0)
#define SLOAD_F(p, k0) do { S.sf0 = *(const f32x4*)ROW(p, k0, sr); S.sf1 = *(const f32x4*)(ROW(p, k0, sr) + 4);                \
                            S.sf2 = *(const f32x4*)ROW(p, k0, 32 + sr); S.sf3 = *(const f32x4*)(ROW(p, k0, 32 + sr) + 4); } while (0)
#define SWRITE_KF(bf) do { *(bf16x8*)(K_lds + (bf) * SHM_K + kws) = pack8(S.sf0, S.sf1); *(bf16x8*)(K_lds + (bf) * SHM_K + kws + 32 * 256) = pack8(S.sf2, S.sf3); } while (0)
#define SWRITE_VF(bf) do { *(bf16x8*)(V_lds + (bf) * SHM_V + vst0) = pack8(S.sf0, S.sf1); *(bf16x8*)(V_lds + (bf) * SHM_V + vst1) = pack8(S.sf2, S.sf3); } while (0)
template <class TIn, class TOut>
__device__ __forceinline__ void causal_swa_prime(const BlockRef<TIn, TOut>& cur, int W, char* lds, Seam<TIn>& S, int tid_in) {
    constexpr bool F32 = same_t<TIn, float>::v;
    const int tid = tid_in, wid = __builtin_amdgcn_readfirstlane(tid >> 6), lane = tid & 63, r32 = lane & 31, hi = lane >> 5;
    const int sr = tid >> 4, sc = (tid & 15) * 8, kws = KSWZ(sr, sc * 2); char* K_lds = lds + 2 * SHM_V;
    const int kb0 = swa_jlo(cur.P0, W) * KVBLK;
    { char* Qw_ = lds + Q_OFF + wid * 8192;
#pragma unroll
      for (int d0 = 0; d0 < 8; ++d0) *(bf16x8*)(Qw_ + KSWZ(r32, ((d0 & 3) * 16 + hi * 8) * 2) + (d0 >> 2) * 128) = load8<TIn>(cur.Q + (size_t)(wid * QBLK + r32) * QP + d0 * 16 + hi * 8); }
    if constexpr (F32) { SLOAD_F((const float*)cur.K, kb0); VMW(); SWRITE_KF(0); SBAR(); SLOAD_F((const float*)cur.V, kb0); }
    else { SLOAD_H(cur.K, cur.V, kb0); VMW(); SWRITE_HK(0); }
    __syncthreads();
}
template <class TIn, class TOut>
__device__ __forceinline__ void causal_swa_block(const BlockRef<TIn, TOut>& cur, const BlockRef<TIn, TOut>& nxt, int skv, int W, char* lds, Seam<TIn>& S, int tid_in) {
    constexpr bool F32 = same_t<TIn, float>::v;
    const int tid = tid_in, wid = __builtin_amdgcn_readfirstlane(tid >> 6), lane = tid & 63, r32 = lane & 31, hi = lane >> 5;
    const int j_lo = swa_jlo(cur.P0, W);
    int j_hi = (cur.P0 + QB - 1) / KVBLK + 1; if (j_hi > skv / KVBLK) j_hi = skv / KVBLK;
    const int NT = j_hi - j_lo;
    const int kbn = swa_jlo(nxt.P0, W) * KVBLK;
    const int qlo = cur.P0 + wid * QBLK, qm = qlo + r32 - 4 * hi;
    char* V_lds = lds; char* K_lds = lds + 2 * SHM_V;
    float* ws = (float*)(lds + 2 * SHM_V + 2 * SHM_K) + wid * 64; float* li_l = ws, * al_l = ws + 32;
    const float* bias_l = (const float*)(lds + BIAS_OFF) + 4 * hi;
    const char* Qw_lds = lds + Q_OFF + wid * 8192;
    float m_reg = -1e30f, l_reg = 0; f32x16 o[4] = {};
    const int sr = tid >> 4, sc = (tid & 15) * 8, vst0 = v_st(sr, sc), vst1 = v_st(32 + sr, sc), kws = KSWZ(sr, sc * 2);
    const int vb0 = (int)(uintptr_t)V_lds + v_rd_base(lane);
    const TIn* Kh = cur.K; const TIn* Vh = cur.V;
#define RESC(a) do { if (__any((a) < 1.f)) { if (hi == 0) al_l[r32] = (a); asm volatile("s_waitcnt lgkmcnt(0)" ::: "memory");              \
                     for (int d_ = 0; d_ < 4; ++d_) for (int r = 0; r < 16; ++r) o[d_][r] *= al_l[crow(r, hi)]; } } while (0)
#define KBASE(t) ((j_lo + (t)) * KVBLK)
#define ACT(t) (KBASE(t) <= qlo + QBLK - 1 && KBASE(t) + KVBLK - 1 >= qlo - W + 1)
#define MASKT(P0_, P1_, t) do { const int kb_ = KBASE(t); if ((!SK || ACT(t)) && (kb_ + KVBLK - 1 > qlo || kb_ <= qlo + QBLK - 1 - W)) mask_tile(P0_, P1_, qm - kb_, (unsigned)W); } while (0)
    constexpr int NQL = F32 ? 16 : 0;
    constexpr bool SK = WSKIP && !F32;
#define SEAM_K0() do { VMWN(NQL); if constexpr (F32) { SWRITE_KF(0); SBAR(); SLOAD_F((const float*)nxt.V, kbn); } else { SWRITE_HK(0); } SBAR(); } while (0)
    f32x16 pA0, pA1, pB0, pB1; float mnA, mnB, alA, alB; bf16x8 pa0, pa1, pa2, pa3;
    if constexpr (F32) { VMW(); SWRITE_VF(0); SBAR(); } else { SWRITE_HV(0); SBAR(); }
    if (NT > 1) { if constexpr (F32) SLOAD_F((const float*)Kh, KBASE(1)); else SLOAD_H(Kh, Vh, KBASE(1)); }
    SBAR(); qkt<0, SK>(pA0, pA1, K_lds, r32, hi, Qw_lds, ACT(0), bias_l + KBASE(0));
    if constexpr (F32) { if (NT > 1) { VMW(); SWRITE_KF(1); SBAR(); SLOAD_F((const float*)Vh, KBASE(1)); } }
    MASKT(pA0, pA1, 0); partialSM(pA0, pA1, m_reg, mnA, alA);
    if (NT > 1) { VMW(); if constexpr (F32) { SWRITE_VF(1); SBAR(); if (NT > 2) SLOAD_F((const float*)Kh, KBASE(2)); } else SWRITE_H(1); }
    __syncthreads();
#define HALF_STEP(PX0, PX1, mnX, alX, PY0, PY1, alY, t, KB, VB, SB) do {                                                      \
        SBAR(); qkt<KB, SK>(PX0, PX1, K_lds, r32, hi, Qw_lds, ACT(t), bias_l + KBASE(t));                                             \
        finishSM(PY0, PY1, alY, l_reg, pa0, pa1, pa2, pa3); SBAR();                                                           \
        if ((t) + 1 < NT) { if constexpr (F32) { VMW(); SWRITE_KF(SB); SBAR(); SLOAD_F((const float*)Vh, KBASE((t) + 1)); }  \
                            else { SLOAD_H(Kh, Vh, KBASE((t) + 1)); } SBAR(); }                                               \
        pv_tile<VB, SK>(o, vb0, pa0, pa1, pa2, pa3, ACT((t) - 1)); MASKT(PX0, PX1, (t)); partialSM(PX0, PX1, m_reg, mnX, alX);                                        \
        __syncthreads();                                                                                                      \
        if ((t) + 1 < NT) { VMW(); if constexpr (F32) { SWRITE_VF(SB); SBAR(); if ((t) + 2 < NT) SLOAD_F((const float*)Kh, KBASE((t) + 2)); } \
                            else { SWRITE_H(SB); } }                                                                          \
        RESC(alX); __syncthreads(); } while (0)
    for (int t = 1; t + 1 < NT; t += 2) {
        HALF_STEP(pB0, pB1, mnB, alB, pA0, pA1, alA, t, 1, 0, 0);
        HALF_STEP(pA0, pA1, mnA, alA, pB0, pB1, alB, t + 1, 0, 1, 1);
    }
    const bool even = (NT & 1) == 0;
    if (even) { SBAR(); qkt<1, SK>(pB0, pB1, K_lds, r32, hi, Qw_lds, ACT(NT - 1), bias_l + KBASE(NT - 1)); SBAR(); }
#define QROW(e) (nxt.Q + (size_t)(wid * QBLK + r32) * QP + ((e) >> 1) * 16 + hi * 8 + ((e) & 1) * 4)
    if constexpr (F32) { SLOAD_F((const float*)nxt.K, kbn); SBAR();
#pragma unroll
        for (int e = 0; e < 8; ++e) S.tq[e] = *(const f32x4*)QROW(e); }
    else { SLOAD_H(nxt.K, nxt.V, kbn); SBAR(); }
    SBAR();
    finishSM(pA0, pA1, alA, l_reg, pa0, pa1, pa2, pa3); SBAR();
    if constexpr (F32) {
#pragma unroll
        for (int e = 8; e < 16; ++e) S.tq[e] = *(const f32x4*)QROW(e); SBAR(); }
#undef QROW
    pv_tile<0, SK>(o, vb0, pa0, pa1, pa2, pa3, ACT(even ? NT - 2 : NT - 1));
    if (even) { MASKT(pB0, pB1, NT - 1); partialSM(pB0, pB1, m_reg, mnB, alB); __syncthreads(); RESC(alB);
        finishSM(pB0, pB1, alB, l_reg, pa0, pa1, pa2, pa3); SBAR(); pv_tile<1, SK>(o, vb0, pa0, pa1, pa2, pa3, ACT(NT - 1)); }
    SBAR(); SEAM_K0();
    if (hi == 0) li_l[r32] = l_reg; asm volatile("s_waitcnt lgkmcnt(0)" ::: "memory");
    float rli[16];
#pragma unroll
    for (int r = 0; r < 16; ++r) rli[r] = __builtin_amdgcn_rcpf(li_l[crow(r, hi)]);
    TOut* Ow = cur.O + (size_t)(wid * QBLK) * OP;
#pragma unroll
    for (int r = 0; r < 16; ++r) { const int orow = crow(r, hi);
#pragma unroll
        for (int d0 = 0; d0 < 4; ++d0) { const float v = o[d0][r] * rli[r];
            if constexpr (same_t<TOut, float>::v) { Ow[(size_t)orow * OP + d0 * 32 + r32] = v; }
            else { const float vn = __shfl_xor(v, 1);
                   if ((r32 & 1) == 0) *(unsigned*)(Ow + (size_t)orow * OP + d0 * 32 + r32) = cvtpk(v, vn); } } }
    if constexpr (F32) {
#pragma unroll
        for (int d0 = 0; d0 < 8; ++d0) (void)S.tq[2 * d0]; }
    __syncthreads();
#undef RESC
#undef KBASE
#undef ACT
#undef MASKT
#undef SEAM_K0
#undef HALF_STEP
}
#undef ROW
#undef VMW
#undef VMWN
#undef SLOAD_H
#undef SWRITE_HK
#undef SWRITE_HV
#undef SWRITE_H
#undef SLOAD_F
#undef SWRITE_KF
#undef SWRITE_VF

#undef KSWZ
#undef SBAR
}

__device__ __forceinline__ void attn_phase(const bf16* proj, const float* logf, bf16* mix, unsigned char* lds_) {
    char* lds = (char*)lds_;
    for (int item = blockIdx.x; item < 256; item += gridDim.x) {
        OPAQUE_TID();
        const int bh = (item & 7) * 4 + ((item >> 3) & 3), qb = 7 - (item >> 5);
        const int b = bh >> 3, hh = bh & 7;
        float* bias = (float*)(lds + fa::BIAS_OFF);
        const int nk = (qb + 1) * 256;
        { float* scanw = (float*)(lds + 2 * fa::SHM_V + 2 * fa::SHM_K);
          const int s0 = 4 * tid; float l0 = 0.f, l1 = 0.f, l2 = 0.f, l3 = 0.f;
          if (s0 < nk) { const float* lf = logf + ((size_t)(b * SEQ + s0)) * 8 + hh; l0 = lf[0]; l1 = lf[8]; l2 = lf[16]; l3 = lf[24]; }
          l1 += l0; l2 += l1; l3 += l2;
          float inc = l3;
#pragma unroll
          for (int o = 1; o < 64; o <<= 1) { const float t = __shfl_up(inc, o); if (lane >= o) inc += t; }
          if (lane == 63) scanw[wave] = inc;
          __syncthreads();
          float off = inc - l3;
#pragma unroll
          for (int w = 0; w < 8; ++w) off += (w < wave) ? scanw[w] : 0.f;
          const float k = -1.0f / fa::SCALE;
          if (s0 < nk) { bias[s0] = (off + l0) * k; bias[s0 + 1] = (off + l1) * k; bias[s0 + 2] = (off + l2) * k; bias[s0 + 3] = (off + l3) * k; } }
        fa::BlockRef<bf16, bf16> cur;
        cur.Q = proj + (size_t)(b * SEQ + qb * 256) * NPROJ + hh * 128; cur.K = proj + (size_t)(b * SEQ) * NPROJ + 1024 + hh * 128; cur.V = cur.K + 1024;
        cur.O = mix + (size_t)(b * SEQ + qb * 256) * DM + hh * 128; cur.P0 = qb * 256;
        fa::Seam<bf16> S;
        fa::causal_swa_prime<bf16, bf16>(cur, SEQ, lds, S, tid);
        fa::causal_swa_block<bf16, bf16>(cur, cur, SEQ, SEQ, lds, S, tid);
    }
}

__global__ void __launch_bounds__(512, 2) fwd(Args a) {
    extern __shared__ __attribute__((aligned(16))) unsigned char lds[];
    cg::grid_group grid = cg::this_grid();
#define OPQ_WS() opq_ptr(a.ws)
#define XN ((bf16*)(OPQ_WS() + WS_XN))
#define PROJ ((bf16*)(OPQ_WS() + WS_PROJ))
#define MIX ((bf16*)(OPQ_WS() + WS_MIX))
#define ACT ((bf16*)(OPQ_WS() + WS_ACT))
#define PP ((bf16*)(OPQ_WS() + WS_PP))
#define PBF ((bf16*)(OPQ_WS() + WS_PBF))
#define LOGF ((float*)(OPQ_WS() + WS_LOGF))
#define CUM ((float*)(OPQ_WS() + WS_CUM))
#define H ((float*)opq_ptr((unsigned char*)a.out))
    PG8_LAS unsigned char* ring = (PG8_LAS unsigned char*)lds;
    const int G = gridDim.x, bx = blockIdx.x;
    { volatile LAS unsigned* st0 = (volatile LAS unsigned*)((LAS unsigned char*)lds + XB_LDS_OFF); if (threadIdx.x < 2) st0[threadIdx.x] = 0u; }
    __syncthreads();
    const XcdBarrier xbar = xcd_barrier_post((unsigned*)(a.ws + WS_BAR), (volatile LAS unsigned*)((LAS unsigned char*)lds + XB_LDS_OFF));
#define GRID_SYNC() xcd_barrier(xbar)
    constexpr int CONV_SPLIT = 1940;

    convert_weights(a, (LAS unsigned char*)lds, 0, I_LAYER, bx, G);
    convert_p(a);
    norm_phase(a.in[I_X], a.in[I_NORM_MIX], XN, true, a.in[I_W_IN], a.in[I_FBIAS], LOGF, lds);
    grid.sync();

#pragma unroll 1
    for (int L = 0; L < DEPTH; ++L) {
#define WL(off) ((const bf16*)(OPQ_WS() + WS_W + (size_t)L * SZ_LAYER + (off)))
#define Win WL(OFF_WIN)
#define Wout WL(OFF_WOUT)
#define Wgu WL(OFF_WGU)
#define Wdn WL(OFF_WDN)
#define Wpg WL(OFF_WPG)
#define Wpp WL(OFF_WPP)
        for (int rep_ = 0; rep_ < REP_A; ++rep_) {
        { pg8::Gemm g{XN, Win, M, NPROJ, DM}; pg8::StaticOrder S; S.init(M, NPROJ, G, bx);
          pg8::EpiProjQK E{PROJ, NPROJ, a.in[I_Q_NORM] + L * 128, a.in[I_K_NORM] + L * 128, (PG8_LAS float*)(ring + 131072)};
          pg8::gemm_phase<pg8::EpiProjQK, pg8::StaticOrder, true, true>(ring, g, S, E); }
        { pg8::Gemm g{PBF + (size_t)L * M * DPLE, Wpp, M, DM, DPLE}; pg8::StaticOrder S; S.init(M, DM, G, bx);
          pg8::EpiBf16<0> E{PP, DM, nullptr, 0, 0, 1.f};
          pg8::gemm_phase<pg8::EpiBf16<0>, pg8::StaticOrder, true, true>(ring, g, S, E); }
        }
        if (L + 1 < DEPTH) {
            const int ntile = (M / 256) * (NPROJ / 256), maxu = (ntile + G - 1) / G, rem = ntile - (maxu - 1) * G, first_idle = (rem >= G) ? 0 : rem;
            if (bx >= first_idle) convert_weights(a, (LAS unsigned char*)lds, (L + 1) * I_LAYER, (L + 1) * I_LAYER + CONV_SPLIT, bx - first_idle, G - first_idle);
        }
        GRID_SYNC();
        for (int rep_ = 0; rep_ < REP_C; ++rep_) {
        gmlp_mfma(PROJ, a.in[I_GV_NORM] + L * 512, a.in[I_G_WS] + (size_t)L * 4 * 128 * 128, a.in[I_G_BS] + L * 512, MIX, lds);
        pool_mfma(PROJ, a.in[I_POOL_W] + (size_t)L * 4 * 128 * 128, a.in[I_POOL_SCALE] + L * 512, MIX, lds);
        for (int rep2_ = 0; rep2_ < REP_ATT; ++rep2_) attn_phase(PROJ, LOGF, MIX, lds);
        }
        for (int rep_ = 0; rep_ < REP_SYNC; ++rep_) GRID_SYNC();
        { pg8::Gemm g{MIX, Wout, M, DM, DM}; pg8::StaticOrder S; S.init(M, DM, G, bx);
          pg8::EpiRes E{L == 0 ? a.in[I_X] : H, H, DM};
          pg8::gemm_phase<pg8::EpiRes, pg8::StaticOrder, true, true>(ring, g, S, E); }
        GRID_SYNC();
        for (int rep_ = 0; rep_ < REP_N; ++rep_) norm_phase(H, a.in[I_NORM_FFN] + L * DM, XN, false, nullptr, nullptr, nullptr, lds);
        GRID_SYNC();
        for (int rep_ = 0; rep_ < REP_F; ++rep_) { pg8::Gemm g{XN, Wgu, M, NGU, DM}; pg8::StaticOrder S; S.init(M, NGU, G, bx);
          pg8::EpiSwiglu E{ACT, DFF};
          pg8::gemm_phase<pg8::EpiSwiglu, pg8::StaticOrder, true, true>(ring, g, S, E); }
        if (L + 1 < DEPTH) {
            const int ntile = (M / 256) * (NGU / 256), maxu = (ntile + G - 1) / G, rem = ntile - (maxu - 1) * G, first_idle = (rem >= G) ? 0 : rem;
            if (bx >= first_idle) convert_weights(a, (LAS unsigned char*)lds, (L + 1) * I_LAYER + CONV_SPLIT, (L + 2) * I_LAYER, bx - first_idle, G - first_idle);
        }
        GRID_SYNC();
        { pg8::Gemm g{ACT, Wdn, M, DM, DFF}; pg8::StaticOrder S; S.init(M, DM, G, bx);
          pg8::EpiRes E{H, H, DM};
          pg8::gemm_phase<pg8::EpiRes, pg8::StaticOrder, true, true>(ring, g, S, E); }
        GRID_SYNC();
        for (int rep_ = 0; rep_ < REP_N; ++rep_) norm_phase(H, a.in[I_NORM_PLE] + L * DM, XN, false, nullptr, nullptr, nullptr, lds);
        GRID_SYNC();
        { pg8::Gemm g{XN, Wpg, M, DM, DM}; pg8::StaticOrder S; S.init(M, DM, G, bx);
          pg8::EpiPle E{H, H, PP, DM};
          pg8::gemm_phase<pg8::EpiPle, pg8::StaticOrder, true, true>(ring, g, S, E); }
        if (L + 1 < DEPTH) {
            GRID_SYNC();
            norm_phase(H, a.in[I_NORM_MIX] + (L + 1) * DM, XN, true, a.in[I_W_IN] + (size_t)(L + 1) * DM * DPROJ_SRC, a.in[I_FBIAS] + (L + 1) * 8, LOGF, lds);
            GRID_SYNC();
        }
    }
}

extern "C" void kernel_launch(void* const* d_in, const int* in_sizes, int n_in, void* d_out, int out_size, void* d_ws, size_t ws_size, hipStream_t stream) {
    static int grid = 0;
    if (grid == 0) {
        if (n_in != 20 || out_size != M * DM || ws_size < WS_END) { fprintf(stderr, "kernel_launch: unexpected shapes (n_in %d out %d ws %zu, need %zu)\n", n_in, out_size, ws_size, (size_t)WS_END); grid = -1; return; }
        int dev = 0, cus = 0, per_cu = 0;
        (void)hipGetDevice(&dev); (void)hipDeviceGetAttribute(&cus, hipDeviceAttributeMultiprocessorCount, dev);
        if (hipFuncSetAttribute((const void*)fwd, hipFuncAttributeMaxDynamicSharedMemorySize, LDS_BYTES) != hipSuccess) fprintf(stderr, "kernel_launch: hipFuncSetAttribute failed\n");
        if (hipOccupancyMaxActiveBlocksPerMultiprocessor(&per_cu, (const void*)fwd, 512, LDS_BYTES) != hipSuccess || per_cu < 1) { fprintf(stderr, "kernel_launch: occupancy query gave %d\n", per_cu); per_cu = 1; }
        (void)hipGetLastError();
        if (cus <= 0) cus = 256;
        grid = cus * per_cu;
    }
    if (grid < 0) return;
    Args a{};
    for (int i = 0; i < 20; ++i) a.in[i] = (const float*)d_in[i];
    a.out = (float*)d_out; a.ws = (unsigned char*)d_ws;
    if (hipMemsetAsync((char*)d_ws + WS_BAR, 0, XCD_BAR_WORDS * 4, stream) != hipSuccess) fprintf(stderr, "kernel_launch: memset of barrier words failed\n");
    void* args[] = {&a};
    hipError_t e = hipLaunchCooperativeKernel((void*)fwd, dim3(grid), dim3(512), args, LDS_BYTES, stream);
    if (e != hipSuccess) fprintf(stderr, "cooperative launch failed: %s (grid %d)\n", hipGetErrorString(e), grid);
}
```

```cpp
#include <hip/hip_runtime.h>
#include <hip/hip_cooperative_groups.h>
#include <cstdio>
#include <cstdint>
namespace cg = cooperative_groups;
#ifndef REP_PRO
#define REP_PRO 1
#define REP_A 1
#define REP_C 1
#define REP_ATT 1
#define REP_F 1
#define REP_N 1
#define REP_SYNC 1
#endif
namespace pg8 {
#define PG8_LAS __attribute__((address_space(3)))
typedef unsigned short bf16_t;
typedef short bf16x8 __attribute__((ext_vector_type(8)));
typedef float f32x4 __attribute__((ext_vector_type(4)));
typedef unsigned u32x4 __attribute__((ext_vector_type(4)));
constexpr int BM = 256, BK = 64, HALF = 128, HTB = HALF * BK * 2  , STAGE_BYTES = 8 * HTB, NXCD = 8, WGM = 8;

__host__ __device__ __forceinline__ int lds_byte(int r, int c) { const int st = (r >> 4) * 2 + (c >> 5), rr = r & 15, cc = c & 31, ob = rr * 64 + cc * 2; return st * 1024 + (ob ^ (((ob >> 9) & 1) << 5)); }
__host__ __device__ __forceinline__ void stage_rc(int b, int& R, int& C) { const int st = b / 1024, sb = b % 1024, swz = sb ^ (((sb >> 9) & 1) << 5); R = (st >> 1) * 16 + swz / 64; C = (st & 1) * 32 + (swz % 64) / 2; }
__host__ __device__ __forceinline__ int perm32(int rho) { const int n = rho >> 4, i = rho & 15; return 8 * (i >> 2) + 4 * n + (i & 3); }

struct Unit { int pm, pn; };
struct Gemm { const bf16_t* A; const bf16_t* Bt; int M, N, K; };

struct StaticOrder {
    int nM, nN, nwg, G, c;
    __host__ __device__ void init(int M, int N, int G_, int c_) { nM = M / BM; nN = N / BM; nwg = nM * nN; G = G_; c = c_; }
    __host__ __device__ bool next(int i, Unit& u) const {
        const long L = (long)i * G + c; if (L >= nwg) return false;
        int wgid = (int)L; { const int q = nwg / NXCD, r = nwg % NXCD, xcd = wgid % NXCD, off = wgid / NXCD; wgid = (xcd < r ? xcd * (q + 1) : r * (q + 1) + (xcd - r) * q) + off; }
        const int nig = WGM * nN, gid = wgid / nig, fm = gid * WGM, gsz = (nM - fm) < WGM ? (nM - fm) : WGM;
        u.pm = fm + ((wgid % nig) % gsz); u.pn = (wgid % nig) / gsz; return true;
    }
    __device__ __forceinline__ void a_ready(const Unit&) const {}
    __device__ __forceinline__ void done(const Unit&) const {}
};

__device__ __forceinline__ unsigned cvt_pk_bf16(float lo, float hi) { unsigned r; asm volatile("v_cvt_pk_bf16_f32 %0, %1, %2" : "=v"(r) : "v"(lo), "v"(hi)); return r; }
typedef float f32x2 __attribute__((ext_vector_type(2)));
__device__ __forceinline__ f32x2 gelu_pk(f32x2 v) {
    const f32x2 av = __builtin_elementwise_abs(v), d = av * 0.2316418882f + 1.0f;
    f32x2 t; t.x = __builtin_amdgcn_rcpf(d.x); t.y = __builtin_amdgcn_rcpf(d.y);
    f32x2 q = t * 0.5307027145f + (-0.7265760135f); q = q * t + 0.7107068705f; q = q * t + (-0.142248368f); q = q * t + 0.127414796f; q = q * t;
    const f32x2 s = (v * v) * (-0.72134752044f);
    f32x2 e; e.x = __builtin_amdgcn_exp2f(s.x); e.y = __builtin_amdgcn_exp2f(s.y);
    const f32x2 m = v * (q * e), r = v - m;
    f32x2 o; o.x = v.x < 0.f ? m.x : r.x; o.y = v.y < 0.f ? m.y : r.y; return o;
}

template <int ACT  > struct EpiBf16 {
    static constexpr bool PERM = true, AFTER_DRAIN = false; static_assert(ACT == 0 || ACT == 1, "EpiBf16: ACT is 0 (none) or 1 (gelu_pk)");
    bf16_t* O; int ldc; const float* bias; int split_cols; size_t split_stride; float scale0;
    __device__ __forceinline__ void operator()(const f32x4 (&acc)[2][2][4][2], const Unit& u, int wr, int wc, int fr, int fq) const {
        const int row0 = u.pm * BM + wr * 64 + fr; int colt = u.pn * BM; bf16_t* base = O;
        float sc = 1.f; if (split_cols) { const int t = colt / split_cols; base += (size_t)t * split_stride; colt -= t * split_cols; if (t == 0) sc = scale0; }
        const int col0 = colt + wc * 32 + 8 * fq, bcol0 = u.pn * BM + wc * 32 + 8 * fq;
        f32x4 bv[2][2];
#pragma unroll
        for (int bj = 0; bj < 2; ++bj)
#pragma unroll
            for (int n = 0; n < 2; ++n) bv[bj][n] = bias ? *(const f32x4*)(bias + bcol0 + bj * HALF + 4 * n) : (f32x4){0.f, 0.f, 0.f, 0.f};
#pragma unroll
        for (int ai = 0; ai < 2; ++ai)
#pragma unroll
            for (int m = 0; m < 4; ++m) { bf16_t* rowp = base + (size_t)(row0 + ai * HALF + m * 16) * ldc + col0;
#pragma unroll
                for (int bj = 0; bj < 2; ++bj) { f32x4 v0 = acc[ai][bj][m][0] + bv[bj][0], v1 = acc[ai][bj][m][1] + bv[bj][1];
                    if (ACT == 1) { f32x2 a = gelu_pk((f32x2){v0[0], v0[1]}), b = gelu_pk((f32x2){v0[2], v0[3]}), c = gelu_pk((f32x2){v1[0], v1[1]}), d = gelu_pk((f32x2){v1[2], v1[3]});
                        v0 = (f32x4){a.x, a.y, b.x, b.y}; v1 = (f32x4){c.x, c.y, d.x, d.y}; }
                    v0 = v0 * sc; v1 = v1 * sc; u32x4 w; w.x = cvt_pk_bf16(v0[0], v0[1]); w.y = cvt_pk_bf16(v0[2], v0[3]); w.z = cvt_pk_bf16(v1[0], v1[1]); w.w = cvt_pk_bf16(v1[2], v1[3]);
                    *(u32x4*)(rowp + bj * HALF) = w; } }
    }
};
typedef unsigned u32x2 __attribute__((ext_vector_type(2)));
__device__ __forceinline__ float bf_lo(unsigned w) { return __uint_as_float(w << 16); }
__device__ __forceinline__ float bf_hi(unsigned w) { return __uint_as_float(w & 0xffff0000u); }
__device__ __forceinline__ float sigmoidf_(float x) { return 1.0f / (1.0f + __expf(-x)); }
struct EpiRes {
    static constexpr bool PERM = false, AFTER_DRAIN = false;
    const float* base; float* out; int ldc;
    __device__ __forceinline__ void operator()(const f32x4 (&acc)[2][2][4][2], const Unit& u, int wr, int wc, int fr, int fq) const {
        const int col0 = u.pn * BM + wc * 32 + 4 * fq;
        const size_t off0 = (size_t)(u.pm * BM + wr * 64 + fr) * ldc + col0;
        f32x4 nb[2][2];
#pragma unroll
        for (int bj = 0; bj < 2; ++bj)
#pragma unroll
            for (int n = 0; n < 2; ++n) nb[bj][n] = *(const f32x4*)(base + off0 + bj * HALF + n * 16);
#pragma unroll
        for (int g = 0; g < 8; ++g) { const int ai = g >> 2, m = g & 3; const size_t off = off0 + (size_t)(ai * HALF + m * 16) * ldc;
            f32x4 cb[2][2];
#pragma unroll
            for (int bj = 0; bj < 2; ++bj)
#pragma unroll
                for (int n = 0; n < 2; ++n) cb[bj][n] = nb[bj][n];
            if (g < 7) { const size_t offn = off0 + (size_t)(((g + 1) >> 2) * HALF + ((g + 1) & 3) * 16) * ldc;
#pragma unroll
                for (int bj = 0; bj < 2; ++bj)
#pragma unroll
                    for (int n = 0; n < 2; ++n) nb[bj][n] = *(const f32x4*)(base + offn + bj * HALF + n * 16); }
#pragma unroll
            for (int bj = 0; bj < 2; ++bj)
#pragma unroll
                for (int n = 0; n < 2; ++n) *(f32x4*)(out + off + bj * HALF + n * 16) = cb[bj][n] + acc[ai][bj][m][n];
            asm volatile("" ::: "memory"); }
    }
};
struct EpiPle {
    static constexpr bool PERM = false, AFTER_DRAIN = false;
    const float* base; float* out; const bf16_t* pp; int ldc;
    __device__ __forceinline__ void operator()(const f32x4 (&acc)[2][2][4][2], const Unit& u, int wr, int wc, int fr, int fq) const {
        const int col0 = u.pn * BM + wc * 32 + 4 * fq;
        const size_t off0 = (size_t)(u.pm * BM + wr * 64 + fr) * ldc + col0;
        f32x4 nb[2][2]; u32x2 np[2][2];
#pragma unroll
        for (int bj = 0; bj < 2; ++bj)
#pragma unroll
            for (int n = 0; n < 2; ++n) { nb[bj][n] = *(const f32x4*)(base + off0 + bj * HALF + n * 16); np[bj][n] = *(const u32x2*)(pp + off0 + bj * HALF + n * 16); }
#pragma unroll
        for (int g = 0; g < 8; ++g) { const int ai = g >> 2, m = g & 3; const size_t off = off0 + (size_t)(ai * HALF + m * 16) * ldc;
            f32x4 cb[2][2]; u32x2 cp[2][2];
#pragma unroll
            for (int bj = 0; bj < 2; ++bj)
#pragma unroll
                for (int n = 0; n < 2; ++n) { cb[bj][n] = nb[bj][n]; cp[bj][n] = np[bj][n]; }
            if (g < 7) { const size_t offn = off0 + (size_t)(((g + 1) >> 2) * HALF + ((g + 1) & 3) * 16) * ldc;
#pragma unroll
                for (int bj = 0; bj < 2; ++bj)
#pragma unroll
                    for (int n = 0; n < 2; ++n) { nb[bj][n] = *(const f32x4*)(base + offn + bj * HALF + n * 16); np[bj][n] = *(const u32x2*)(pp + offn + bj * HALF + n * 16); } }
#pragma unroll
            for (int bj = 0; bj < 2; ++bj)
#pragma unroll
                for (int n = 0; n < 2; ++n) { const f32x4 bs = cb[bj][n]; const u32x2 pw = cp[bj][n]; const f32x4 a = acc[ai][bj][m][n]; f32x4 o;
                    o[0] = bs[0] + bf_lo(pw.x) * sigmoidf_(a[0]); o[1] = bs[1] + bf_hi(pw.x) * sigmoidf_(a[1]);
                    o[2] = bs[2] + bf_lo(pw.y) * sigmoidf_(a[2]); o[3] = bs[3] + bf_hi(pw.y) * sigmoidf_(a[3]);
                    *(f32x4*)(out + off + bj * HALF + n * 16) = o; }
            asm volatile("" ::: "memory"); }
    }
};
struct EpiSwiglu {
    static constexpr bool PERM = true, AFTER_DRAIN = false;
    bf16_t* O; int ldc;
    __device__ __forceinline__ void operator()(const f32x4 (&acc)[2][2][4][2], const Unit& u, int wr, int wc, int fr, int fq) const {
        const int col0 = u.pn * HALF + wc * 32 + 8 * fq;
#pragma unroll
        for (int ai = 0; ai < 2; ++ai)
#pragma unroll
            for (int m = 0; m < 4; ++m) { bf16_t* rowp = O + (size_t)(u.pm * BM + ai * HALF + wr * 64 + m * 16 + fr) * ldc + col0;
                float r[8];
#pragma unroll
                for (int n = 0; n < 2; ++n)
#pragma unroll
                    for (int j = 0; j < 4; ++j) { const float g = acc[ai][0][m][n][j], up = acc[ai][1][m][n][j]; r[n * 4 + j] = g * sigmoidf_(g) * up; }
                u32x4 w; w.x = cvt_pk_bf16(r[0], r[1]); w.y = cvt_pk_bf16(r[2], r[3]); w.z = cvt_pk_bf16(r[4], r[5]); w.w = cvt_pk_bf16(r[6], r[7]);
                *(u32x4*)rowp = w; asm volatile("" ::: "memory"); }
    }
};
struct EpiProjQK {
    static constexpr bool PERM = true, AFTER_DRAIN = false;
    bf16_t* O; int ldc; const float* qg; const float* kg; PG8_LAS float* P;
    __device__ __forceinline__ void operator()(const f32x4 (&acc)[2][2][4][2], const Unit& u, int wr, int wc, int fr_in, int fq_in) const {
        int fr = fr_in, fq = fq_in; asm volatile("" : "+v"(fr), "+v"(fq));
        const int row0 = u.pm * BM + wr * 64 + fr, col0 = u.pn * BM + wc * 32 + 8 * fq;
        if (u.pn < 8) {
#pragma unroll
            for (int ai = 0; ai < 2; ++ai)
#pragma unroll
                for (int m = 0; m < 4; ++m)
#pragma unroll
                    for (int bj = 0; bj < 2; ++bj) { const f32x4 a0 = acc[ai][bj][m][0], a1 = acc[ai][bj][m][1];
                        float s = ((a0[0] * a0[0] + a0[1] * a0[1]) + (a0[2] * a0[2] + a0[3] * a0[3])) + ((a1[0] * a1[0] + a1[1] * a1[1]) + (a1[2] * a1[2] + a1[3] * a1[3]));
                        s += __shfl_xor(s, 16); s += __shfl_xor(s, 32);
                        if (fq == 0) P[((ai * HALF + wr * 64 + m * 16 + fr) * 2 + bj) * 4 + wc] = s; }
            asm volatile("s_waitcnt lgkmcnt(0)" ::: "memory"); __builtin_amdgcn_s_barrier(); asm volatile("" ::: "memory");
            const float* gp = (u.pn < 4 ? qg : kg) + wc * 32 + 8 * fq;
            const f32x4 g0 = *(const f32x4*)gp, g1 = *(const f32x4*)(gp + 4);
#pragma unroll
            for (int ai = 0; ai < 2; ++ai)
#pragma unroll
                for (int m = 0; m < 4; ++m) { bf16_t* rowp = O + (size_t)(row0 + ai * HALF + m * 16) * ldc + col0;
#pragma unroll
                    for (int bj = 0; bj < 2; ++bj) { const f32x4 pp = *(const PG8_LAS f32x4*)(P + ((ai * HALF + wr * 64 + m * 16 + fr) * 2 + bj) * 4);
                        const float rinv = rsqrtf(((pp[0] + pp[1]) + (pp[2] + pp[3])) * (1.0f / 128.0f) + 1e-6f);
                        const f32x4 v0 = acc[ai][bj][m][0] * rinv * g0, v1 = acc[ai][bj][m][1] * rinv * g1;
                        u32x4 w; w.x = cvt_pk_bf16(v0[0], v0[1]); w.y = cvt_pk_bf16(v0[2], v0[3]); w.z = cvt_pk_bf16(v1[0], v1[1]); w.w = cvt_pk_bf16(v1[2], v1[3]);
                        *(u32x4*)(rowp + bj * HALF) = w; } }
            asm volatile("s_waitcnt lgkmcnt(0)" ::: "memory"); __builtin_amdgcn_s_barrier(); asm volatile("" ::: "memory");
        } else {
#pragma unroll
            for (int ai = 0; ai < 2; ++ai)
#pragma unroll
                for (int m = 0; m < 4; ++m) { bf16_t* rowp = O + (size_t)(row0 + ai * HALF + m * 16) * ldc + col0;
#pragma unroll
                    for (int bj = 0; bj < 2; ++bj) { const f32x4 v0 = acc[ai][bj][m][0], v1 = acc[ai][bj][m][1];
                        u32x4 w; w.x = cvt_pk_bf16(v0[0], v0[1]); w.y = cvt_pk_bf16(v0[2], v0[3]); w.z = cvt_pk_bf16(v1[0], v1[1]); w.w = cvt_pk_bf16(v1[2], v1[3]);
                        *(u32x4*)(rowp + bj * HALF) = w; } }
        }
    }
};
template <class Epi, class Sched, bool ALIGN_EPI = false, bool SP2 = false>
__device__ __forceinline__ void gemm_phase(PG8_LAS unsigned char* lds, const Gemm g, const Sched& S, const Epi& E) {
    int tid_ = threadIdx.x; asm volatile("" : "+v"(tid_));
    const int tid = tid_, wid = __builtin_amdgcn_readfirstlane(tid >> 6), lane = tid & 63, wr = wid >> 2, wc = wid & 3, fr = lane & 15, fq = lane >> 4;
    const int K = g.K, nt = K / BK;
    unsigned voffA[2], voffB[2];
#pragma unroll
    for (int i = 0; i < 2; ++i) { int R, C; stage_rc(tid * 16 + i * 8192, R, C); const int Rb = Epi::PERM ? ((R & ~31) + perm32(R & 31)) : R;
        voffA[i] = (unsigned)(R * K + C) * 2u; voffB[i] = (unsigned)(Rb * K + C) * 2u; }
    const size_t kstep = (size_t)(BK * 2);
    const size_t hstep = (size_t)HALF * K * 2;
    const size_t tstep = 2 * hstep;
    const unsigned ldsw = (unsigned)wid * 1024u;
    const int aoff = lds_byte(wr * 64 + fr, fq * 8), boff = lds_byte(wc * 32 + fr, fq * 8);
#define PG8_SA(b, h) (((b) * 2 + (h)) * HTB)
#define PG8_SB(b, h) ((4 + (b) * 2 + (h)) * HTB)
#define PG8_STAGE(bufoff, gbase, voff) do { _Pragma("unroll") for (int _i = 0; _i < 2; ++_i) \
        __builtin_amdgcn_global_load_lds((const unsigned*)((const char*)(gbase) + (voff)[_i]), (PG8_LAS unsigned*)(lds + (bufoff) + ldsw + _i * 8192), 16, 0, 0); } while (0)
#define PG8_LDA(dst, b, h) do { _Pragma("unroll") for (int m = 0; m < 4; ++m) _Pragma("unroll") for (int k = 0; k < 2; ++k) dst[m][k] = *(const PG8_LAS bf16x8*)(lds + PG8_SA(b, h) + aoff + m * 2048 + k * 1024); } while (0)
#define PG8_LDB(dst, b, h) do { _Pragma("unroll") for (int n = 0; n < 2; ++n) _Pragma("unroll") for (int k = 0; k < 2; ++k) dst[n][k] = *(const PG8_LAS bf16x8*)(lds + PG8_SB(b, h) + boff + n * 2048 + k * 1024); } while (0)
#define PG8_MMA(ai, bj, At, Bt) do { __builtin_amdgcn_s_setprio(1); _Pragma("unroll") for (int m = 0; m < 4; ++m) _Pragma("unroll") for (int n = 0; n < 2; ++n) _Pragma("unroll") for (int k = 0; k < 2; ++k) \
        acc[ai][bj][m][n] = __builtin_amdgcn_mfma_f32_16x16x32_bf16(Bt[n][k], At[m][k], acc[ai][bj][m][n], 0, 0, 0); __builtin_amdgcn_s_setprio(0); } while (0)
#define PG8_WAIT_V(n) asm volatile("s_waitcnt vmcnt(" #n ")" ::: "memory")
#define PG8_WAIT_L(n) asm volatile("s_waitcnt lgkmcnt(" #n ")" ::: "memory")
#define PG8_BAR __builtin_amdgcn_s_barrier()
#define PG8_SCHED __builtin_amdgcn_sched_barrier(0)
    Unit cur, nxt; int ui = 0;
    if (!S.next(0, cur)) return;
    f32x4 acc[2][2][4][2];
#pragma unroll
    for (int a = 0; a < 2; ++a)
#pragma unroll
        for (int b = 0; b < 2; ++b)
#pragma unroll
            for (int m = 0; m < 4; ++m)
#pragma unroll
                for (int n = 0; n < 2; ++n) acc[a][b][m][n] = (f32x4){0.f, 0.f, 0.f, 0.f};
    bf16x8 At[4][2], B0[2][2], B1[2][2];
    const char* cA = (const char*)g.A + (size_t)cur.pm * tstep; const char* cB = (const char*)g.Bt + (size_t)cur.pn * tstep;
    S.a_ready(cur);
    if constexpr (SP2) {
        PG8_STAGE(PG8_SB(0, 0), cB, voffB); PG8_STAGE(PG8_SB(0, 1), cB + hstep, voffB); PG8_STAGE(PG8_SA(0, 0), cA, voffA); PG8_STAGE(PG8_SA(0, 1), cA + hstep, voffA);
        if (wr == 1) PG8_BAR;
        PG8_WAIT_V(2); PG8_BAR;
        PG8_STAGE(PG8_SB(1, 0), cB + kstep, voffB); PG8_STAGE(PG8_SA(1, 0), cA + kstep, voffA); PG8_STAGE(PG8_SB(1, 1), cB + hstep + kstep, voffB);
        PG8_WAIT_V(6); PG8_BAR;
    } else {
        PG8_STAGE(PG8_SB(0, 0), cB, voffB); PG8_STAGE(PG8_SA(0, 0), cA, voffA); PG8_STAGE(PG8_SB(0, 1), cB + hstep, voffB); PG8_STAGE(PG8_SA(0, 1), cA + hstep, voffA);
        if (wr == 1) PG8_BAR;
        PG8_WAIT_V(4); PG8_BAR;
        PG8_STAGE(PG8_SB(1, 0), cB + kstep, voffB); PG8_STAGE(PG8_SA(1, 0), cA + kstep, voffA); PG8_STAGE(PG8_SB(1, 1), cB + hstep + kstep, voffB);
        PG8_WAIT_V(6); PG8_BAR;
    }
    for (;;) {
        const bool has_next = S.next(ui + 1, nxt);
        const char* nA = has_next ? (const char*)g.A + (size_t)nxt.pm * tstep : cA; const char* nB = has_next ? (const char*)g.Bt + (size_t)nxt.pn * tstep : cB;
        for (int t = 0; t < nt; t += 2) {
            const bool last = (t == nt - 2);
            const char* a1 = cA + (size_t)(t + 1) * kstep;
            const char* a2 = last ? nA : cA + (size_t)(t + 2) * kstep; const char* b2 = last ? nB : cB + (size_t)(t + 2) * kstep;
            const char* a3 = a2 + kstep; const char* b3 = b2 + kstep;
            if (last && has_next) S.a_ready(nxt);
            if constexpr (SP2) {
            PG8_LDB(B0, 0, 0); PG8_LDB(B1, 0, 1); PG8_SCHED; PG8_LDA(At, 0, 0); PG8_STAGE(PG8_SA(1, 1), a1 + hstep, voffA);
            PG8_WAIT_V(8); PG8_WAIT_L(0); PG8_BAR; PG8_MMA(0, 0, At, B0); PG8_MMA(0, 1, At, B1); PG8_BAR; PG8_SCHED;
            PG8_LDA(At, 0, 1); PG8_STAGE(PG8_SB(0, 0), b2, voffB); PG8_STAGE(PG8_SB(0, 1), b2 + hstep, voffB); PG8_STAGE(PG8_SA(0, 0), a2, voffA);
            PG8_WAIT_V(8); PG8_WAIT_L(0); PG8_BAR; PG8_MMA(1, 0, At, B0); PG8_MMA(1, 1, At, B1); PG8_BAR; PG8_SCHED;
            PG8_LDB(B0, 1, 0); PG8_LDB(B1, 1, 1); PG8_SCHED; PG8_LDA(At, 1, 0); PG8_STAGE(PG8_SA(0, 1), a2 + hstep, voffA);
            PG8_WAIT_V(8); PG8_WAIT_L(0); PG8_BAR; PG8_MMA(0, 0, At, B0); PG8_MMA(0, 1, At, B1); PG8_BAR; PG8_SCHED;
            PG8_LDA(At, 1, 1); PG8_STAGE(PG8_SB(1, 0), b3, voffB); PG8_STAGE(PG8_SB(1, 1), b3 + hstep, voffB); PG8_STAGE(PG8_SA(1, 0), a3, voffA);
            PG8_WAIT_V(8); PG8_WAIT_L(0); PG8_BAR; PG8_MMA(1, 0, At, B0); PG8_MMA(1, 1, At, B1); PG8_BAR; PG8_SCHED;
            } else {
            PG8_LDB(B0, 0, 0); PG8_SCHED; PG8_LDA(At, 0, 0); PG8_STAGE(PG8_SA(1, 1), a1 + hstep, voffA);
            PG8_WAIT_L(8); PG8_BAR; PG8_WAIT_L(0); PG8_MMA(0, 0, At, B0); PG8_BAR; PG8_SCHED;
            PG8_LDB(B1, 0, 1); PG8_STAGE(PG8_SB(0, 0), b2, voffB);
            PG8_BAR; PG8_WAIT_L(0); PG8_MMA(0, 1, At, B1); PG8_BAR;
            PG8_LDA(At, 0, 1); PG8_STAGE(PG8_SA(0, 0), a2, voffA);
            PG8_BAR; PG8_WAIT_L(0); PG8_MMA(1, 0, At, B0); PG8_BAR; PG8_SCHED;
            PG8_STAGE(PG8_SB(0, 1), b2 + hstep, voffB);
            PG8_WAIT_V(6); PG8_BAR; PG8_MMA(1, 1, At, B1); PG8_BAR;
            PG8_LDB(B0, 1, 0); PG8_SCHED; PG8_LDA(At, 1, 0); PG8_STAGE(PG8_SA(0, 1), a2 + hstep, voffA);
            PG8_WAIT_L(8); PG8_BAR; PG8_WAIT_L(0); PG8_MMA(0, 0, At, B0); PG8_BAR; PG8_SCHED;
            PG8_LDB(B1, 1, 1); PG8_STAGE(PG8_SB(1, 0), b3, voffB);
            PG8_BAR; PG8_WAIT_L(0); PG8_MMA(0, 1, At, B1); PG8_BAR;
            PG8_LDA(At, 1, 1); PG8_STAGE(PG8_SA(1, 0), a3, voffA);
            PG8_BAR; PG8_WAIT_L(0); PG8_MMA(1, 0, At, B0); PG8_BAR; PG8_SCHED;
            PG8_STAGE(PG8_SB(1, 1), b3 + hstep, voffB);
            PG8_WAIT_V(6); PG8_BAR; PG8_MMA(1, 1, At, B1); PG8_BAR;
            }
        }
        if constexpr (ALIGN_EPI) { if (wr == 0) PG8_BAR; }
        if constexpr (!Epi::AFTER_DRAIN) { int te_ = threadIdx.x; asm volatile("" : "+v"(te_)); const int fr_e = te_ & 15, fq_e = (te_ >> 4) & 3;
            E(acc, cur, wr, wc, fr_e, fq_e); S.done(cur); }
        if (!has_next) break;
#pragma unroll
        for (int a = 0; a < 2; ++a)
#pragma unroll
            for (int b = 0; b < 2; ++b)
#pragma unroll
                for (int m = 0; m < 4; ++m)
#pragma unroll
                    for (int n = 0; n < 2; ++n) acc[a][b][m][n] = (f32x4){0.f, 0.f, 0.f, 0.f};
        cur = nxt; cA = nA; cB = nB; ++ui;
        if constexpr (ALIGN_EPI) { if (wr == 1) PG8_BAR; }
    }
    PG8_WAIT_V(0);
    if constexpr (!ALIGN_EPI) { if (wr == 0) PG8_BAR; }
    PG8_BAR;
    if constexpr (Epi::AFTER_DRAIN) { E.fused(acc, cur, wr, wc, fr, fq, lds, wid, lane); S.done(cur); }
#undef PG8_SA
#undef PG8_SB
#undef PG8_STAGE
#undef PG8_LDA
#undef PG8_LDB
#undef PG8_MMA
#undef PG8_WAIT_V
#undef PG8_WAIT_L
#undef PG8_BAR
#undef PG8_SCHED
}
}

constexpr int M = 8192, DM = 2048, SEQ = 2048, NPROJ = 4608, DPROJ_SRC = 4616, DFF = 5632, NGU = 11264, DPLE = 256, DEPTH = 4;
constexpr size_t SZ_WIN = (size_t)NPROJ * DM * 2, SZ_WOUT = (size_t)DM * DM * 2, SZ_WGU = (size_t)NGU * DM * 2, SZ_WDN = (size_t)DM * DFF * 2, SZ_WPG = SZ_WOUT, SZ_WPP = (size_t)DM * DPLE * 2;
constexpr size_t OFF_WIN = 0, OFF_WOUT = OFF_WIN + SZ_WIN, OFF_WGU = OFF_WOUT + SZ_WOUT, OFF_WDN = OFF_WGU + SZ_WGU, OFF_WPG = OFF_WDN + SZ_WDN, OFF_WPP = OFF_WPG + SZ_WPG, SZ_LAYER = OFF_WPP + SZ_WPP;
constexpr size_t WS_W = 1u << 20, WS_XN = WS_W + DEPTH * SZ_LAYER, WS_PROJ = WS_XN + (size_t)M * DM * 2, WS_MIX = WS_PROJ + (size_t)M * NPROJ * 2, WS_ACT = WS_MIX + (size_t)M * DM * 2,
                 WS_PP = WS_ACT + (size_t)M * DFF * 2, WS_PBF = WS_PP + (size_t)M * DM * 2, WS_LOGF = WS_PBF + (size_t)DEPTH * M * DPLE * 2, WS_CUM = WS_LOGF + (size_t)M * 8 * 4, WS_END = WS_CUM + (size_t)M * 8 * 4;
constexpr int LDS_BYTES = 147456;
constexpr int XB_LDS_OFF = LDS_BYTES - 64;
constexpr size_t WS_BAR = 4096;
constexpr float EPS = 1e-6f;

typedef unsigned short bf16;
typedef unsigned v4u __attribute__((ext_vector_type(4)));
typedef unsigned v2u __attribute__((ext_vector_type(2)));
typedef float f32x4 __attribute__((ext_vector_type(4)));
#define LAS __attribute__((address_space(3)))
#define LDS_WAIT() asm volatile("s_waitcnt lgkmcnt(0)" ::: "memory")
#define OPAQUE_TID() int tid; { int t_ = threadIdx.x; asm volatile("" : "+v"(t_)); tid = t_; } const int lane = tid & 63, wave = __builtin_amdgcn_readfirstlane(tid >> 6); (void)lane; (void)wave

__device__ __forceinline__ unsigned f2bf(float f) { unsigned u = __builtin_bit_cast(unsigned, f); return (u + 0x7fffu + ((u >> 16) & 1u)) >> 16; }
__device__ __forceinline__ unsigned pk2(float lo, float hi) { return f2bf(lo) | (f2bf(hi) << 16); }
__device__ __forceinline__ float bflo(unsigned w) { return __uint_as_float(w << 16); }
__device__ __forceinline__ float bfhi(unsigned w) { return __uint_as_float(w & 0xffff0000u); }
__device__ __forceinline__ float bf2f(bf16 v) { return __uint_as_float((unsigned)v << 16); }
__device__ __forceinline__ float wave_sum(float v) {
#pragma unroll
    for (int o = 1; o < 64; o <<= 1) v += __shfl_xor(v, o);
    return v;
}
__device__ __forceinline__ float gelu_tanh(float x) { const float y2 = 1.5957691216057308f * (x + 0.044715f * x * x * x); return x / (1.0f + __expf(-y2)); }
__device__ __forceinline__ float log_sigmoid(float x) { return fminf(x, 0.f) - __logf(1.0f + __expf(-fabsf(x))); }

__device__ __forceinline__ unsigned char* opq_ptr(unsigned char* p) { asm volatile("" : "+s"(p)); return p; }
struct Args { const float* in[20]; float* out; unsigned char* ws; };
enum { I_X = 0, I_P, I_NORM_MIX, I_W_IN, I_Q_NORM, I_K_NORM, I_FBIAS, I_GV_NORM, I_G_WS, I_G_BS, I_POOL_W, I_POOL_SCALE, I_W_OUT, I_NORM_FFN, I_W_GATE, I_W_UP, I_W_DOWN, I_NORM_PLE, I_W_PG, I_W_PP };

struct TrItem { const float* src; bf16* dst; int ldw, K; };
__device__ __forceinline__ TrItem tr_decode(const Args& a, int it) {
    constexpr int I_IN = 16 * 36, I_OUT = 16 * 16, I_GU = 16 * 88, I_DN = 44 * 16, I_PG = 16 * 16, I_PPN = 2 * 16, I_L = I_IN + I_OUT + I_GU + I_DN + I_PG + I_PPN;
    const int L = it / I_L; int r = it - L * I_L;
    unsigned char* wl = a.ws + WS_W + (size_t)L * SZ_LAYER;
    TrItem t;
    if (r < I_IN) { const int kb = r / 36, nb = r - kb * 36, n0 = nb * 128, c0 = n0 < 3072 ? n0 : n0 + 8;
        t.ldw = DPROJ_SRC; t.K = DM; t.src = a.in[I_W_IN] + (size_t)L * DM * DPROJ_SRC + (size_t)kb * 128 * DPROJ_SRC + c0; t.dst = (bf16*)(wl + OFF_WIN) + (size_t)n0 * DM + kb * 128; }
    else if ((r -= I_IN) < I_OUT) { const int kb = r / 16, nb = r - kb * 16, n0 = nb * 128;
        t.ldw = DM; t.K = DM; t.src = a.in[I_W_OUT] + (size_t)L * DM * DM + (size_t)kb * 128 * DM + n0; t.dst = (bf16*)(wl + OFF_WOUT) + (size_t)n0 * DM + kb * 128; }
    else if ((r -= I_OUT) < I_GU) { const int kb = r / 88, nb = r - kb * 88, n0 = nb * 128, tt = nb >> 1, half = nb & 1;
        t.ldw = DFF; t.K = DM; t.src = (half ? a.in[I_W_UP] : a.in[I_W_GATE]) + (size_t)L * DM * DFF + (size_t)kb * 128 * DFF + tt * 128; t.dst = (bf16*)(wl + OFF_WGU) + (size_t)n0 * DM + kb * 128; }
    else if ((r -= I_GU) < I_DN) { const int kb = r / 16, nb = r - kb * 16, n0 = nb * 128;
        t.ldw = DM; t.K = DFF; t.src = a.in[I_W_DOWN] + (size_t)L * DFF * DM + (size_t)kb * 128 * DM + n0; t.dst = (bf16*)(wl + OFF_WDN) + (size_t)n0 * DFF + kb * 128; }
    else if ((r -= I_DN) < I_PG) { const int kb = r / 16, nb = r - kb * 16, n0 = nb * 128;
        t.ldw = DM; t.K = DM; t.src = a.in[I_W_PG] + (size_t)L * DM * DM + (size_t)kb * 128 * DM + n0; t.dst = (bf16*)(wl + OFF_WPG) + (size_t)n0 * DM + kb * 128; }
    else { r -= I_PG; const int kb = r / 16, nb = r - kb * 16, n0 = nb * 128;
        t.ldw = DM; t.K = DPLE; t.src = a.in[I_W_PP] + (size_t)L * DPLE * DM + (size_t)kb * 128 * DM + n0; t.dst = (bf16*)(wl + OFF_WPP) + (size_t)n0 * DPLE + kb * 128; }
    return t;
}
constexpr int I_LAYER = 16 * 36 + 16 * 16 + 16 * 88 + 44 * 16 + 16 * 16 + 2 * 16;
__device__ __forceinline__ void convert_weights(const Args& a, LAS unsigned char* lds, int it_lo, int it_hi, int wg_i, int wg_n) {
    OPAQUE_TID();
    const int NITEMS = it_hi;
    constexpr int RSB = 272;
    const int ng = tid & 31, kg = tid >> 5;
    const int orow = tid >> 4, och = tid & 15;
    f32x4 v[8];
    int it = it_lo + wg_i;
    TrItem cur;
    if (it < NITEMS) { cur = tr_decode(a, it);
#pragma unroll
        for (int r = 0; r < 8; ++r) v[r] = *(const f32x4*)(cur.src + (size_t)(8 * kg + r) * cur.ldw + 4 * ng); }
    while (it < NITEMS) {
#pragma unroll
        for (int j = 0; j < 4; ++j) { v4u o; o.x = pk2(v[0][j], v[1][j]); o.y = pk2(v[2][j], v[3][j]); o.z = pk2(v[4][j], v[5][j]); o.w = pk2(v[6][j], v[7][j]);
            *(LAS v4u*)(lds + (4 * ng + j) * RSB + 16 * kg) = o; }
        __syncthreads();
        const int nit = it + wg_n; const TrItem out = cur;
        if (nit < NITEMS) { cur = tr_decode(a, nit);
#pragma unroll
            for (int r = 0; r < 8; ++r) v[r] = *(const f32x4*)(cur.src + (size_t)(8 * kg + r) * cur.ldw + 4 * ng); }
#pragma unroll
        for (int j = 0; j < 4; ++j) { const int n = orow + 32 * j; const v4u o = *(const LAS v4u*)(lds + n * RSB + 16 * och);
            *(v4u*)(out.dst + (size_t)n * out.K + 8 * och) = o; }
        __syncthreads();
        it = nit;
    }
}

__device__ __forceinline__ void convert_p(const Args& a) {
    OPAQUE_TID();
    { const size_t n8 = (size_t)DEPTH * M * DPLE / 8; const float* p = a.in[I_P]; bf16* pb = (bf16*)(a.ws + WS_PBF);
      for (size_t i = (size_t)blockIdx.x * 512 + tid; i < n8; i += (size_t)gridDim.x * 512) {
          const f32x4 x0 = *(const f32x4*)(p + i * 8), x1 = *(const f32x4*)(p + i * 8 + 4);
          v4u o; o.x = pk2(x0[0], x0[1]); o.y = pk2(x0[2], x0[3]); o.z = pk2(x1[0], x1[1]); o.w = pk2(x1[2], x1[3]);
          *(v4u*)(pb + i * 8) = o; } }
}

__device__ __forceinline__ void norm_phase(const float* h, const float* gain, bf16* xn, bool with_f, const float* win_l, const float* fbias, float* logf,
                                           unsigned char* lds) {
    OPAQUE_TID();
    float* wf = (float*)lds;
    if (with_f) {
        for (int c = tid; c < DM; c += 512) {
            const f32x4 x0 = *(const f32x4*)(win_l + (size_t)c * DPROJ_SRC + 3072), x1 = *(const f32x4*)(win_l + (size_t)c * DPROJ_SRC + 3076);
            wf[0 * DM + c] = x0[0]; wf[1 * DM + c] = x0[1]; wf[2 * DM + c] = x0[2]; wf[3 * DM + c] = x0[3];
            wf[4 * DM + c] = x1[0]; wf[5 * DM + c] = x1[1]; wf[6 * DM + c] = x1[2]; wf[7 * DM + c] = x1[3]; }
        __syncthreads();
    }
    const int gw = blockIdx.x * 8 + wave, NGW = gridDim.x * 8;
    f32x4 g[8];
#pragma unroll
    for (int j = 0; j < 8; ++j) g[j] = *(const f32x4*)(gain + 4 * lane + 256 * j);
    for (int row = gw; row < M; row += NGW) {
        const f32x4* xr = (const f32x4*)(h + (size_t)row * DM) + lane;
        f32x4 v[8]; float ss = 0.f;
#pragma unroll
        for (int j = 0; j < 8; ++j) { v[j] = xr[64 * j]; ss += (v[j][0] * v[j][0] + v[j][1] * v[j][1]) + (v[j][2] * v[j][2] + v[j][3] * v[j][3]); }
        ss = wave_sum(ss);
        const float rinv = 1.0f / sqrtf(ss * (1.0f / DM) + EPS);
        v2u* o8 = (v2u*)(xn + (size_t)row * DM) + lane;
#pragma unroll
        for (int j = 0; j < 8; ++j) { v[j] = v[j] * rinv * g[j]; v2u w; w.x = pk2(v[j][0], v[j][1]); w.y = pk2(v[j][2], v[j][3]); o8[64 * j] = w; }
        if (with_f) {
            float f[8];
#pragma unroll
            for (int hh = 0; hh < 8; ++hh) { float s = 0.f;
#pragma unroll
                for (int j = 0; j < 8; ++j) { const f32x4 w = *(const f32x4*)(wf + hh * DM + 4 * lane + 256 * j); s += (v[j][0] * w[0] + v[j][1] * w[1]) + (v[j][2] * w[2] + v[j][3] * w[3]); }
                f[hh] = wave_sum(s); asm volatile("" ::: "memory"); }
            float mine = f[0];
#pragma unroll
            for (int hh = 1; hh < 8; ++hh) mine = (lane == hh) ? f[hh] : mine;
            if (lane < 8) logf[(size_t)row * 8 + lane] = log_sigmoid(mine + fbias[lane]);
        }
    }
    if (with_f) __syncthreads();
}

__device__ __forceinline__ void post_phase(bf16* proj, const float* qg, const float* kg, const float* logf, float* cum) {
    OPAQUE_TID();
    const int gw = blockIdx.x * 8 + wave, NGW = gridDim.x * 8;
    const int d0 = 8 * (lane & 15);
    float gq[8], gk[8];
#pragma unroll
    for (int e = 0; e < 8; ++e) { gq[e] = qg[d0 + e]; gk[e] = kg[d0 + e]; }
    for (int row = gw; row < M; row += NGW) {
        v4u* pr = (v4u*)(proj + (size_t)row * NPROJ);
#pragma unroll
        for (int j = 0; j < 4; ++j) {
            const v4u w = pr[lane + 64 * j];
            float x[8] = {bflo(w.x), bfhi(w.x), bflo(w.y), bfhi(w.y), bflo(w.z), bfhi(w.z), bflo(w.w), bfhi(w.w)};
            float ss = 0.f;
#pragma unroll
            for (int e = 0; e < 8; ++e) ss += x[e] * x[e];
            ss += __shfl_xor(ss, 1); ss += __shfl_xor(ss, 2); ss += __shfl_xor(ss, 4); ss += __shfl_xor(ss, 8);
            const float rinv = 1.0f / sqrtf(ss * (1.0f / 128.0f) + EPS);
#pragma unroll
            for (int e = 0; e < 8; ++e) x[e] = x[e] * rinv * (j < 2 ? gq[e] : gk[e]);
            v4u o; o.x = pk2(x[0], x[1]); o.y = pk2(x[2], x[3]); o.z = pk2(x[4], x[5]); o.w = pk2(x[6], x[7]);
            pr[lane + 64 * j] = o;
        }
    }
    for (int bh = blockIdx.x; bh < 32; bh += gridDim.x) if (wave == 0) {
        const int b = bh >> 3, hh = bh & 7;
        float loc[32]; float run = 0.f;
#pragma unroll
        for (int i = 0; i < 32; ++i) { run += logf[((size_t)(b * SEQ + lane * 32 + i)) * 8 + hh]; loc[i] = run; }
        float inc = run;
#pragma unroll
        for (int o = 1; o < 64; o <<= 1) { const float t = __shfl_up(inc, o); if (lane >= o) inc += t; }
        const float excl = inc - run;
#pragma unroll
        for (int i = 0; i < 32; ++i) cum[(size_t)bh * SEQ + lane * 32 + i] = excl + loc[i];
    }
}

#define XB_TMO      128
#define XB_XCNT(j)  (256  + 64 * (j))
#define XB_XSUB(j)  (1280 + 64 * (j))
#define XB_XGEN(j)  (2304 + 64 * (j))
#define XB_TOP      3328
#define XB_TOPGEN   3392
#define XCD_BAR_WORDS 3456
#define XB_SPIN_CAP (1u << 18)

__device__ __forceinline__ unsigned xb_ld(unsigned* p)              { return __hip_atomic_load(p, __ATOMIC_RELAXED, __HIP_MEMORY_SCOPE_AGENT); }
__device__ __forceinline__ unsigned xb_add(unsigned* p, unsigned v) { return __hip_atomic_fetch_add(p, v, __ATOMIC_RELAXED, __HIP_MEMORY_SCOPE_AGENT); }
__device__ __forceinline__ unsigned xb_xcc_id() { return (unsigned)__builtin_amdgcn_s_getreg((3 << 11) | 20) & 0xFu; }
#define XB_SPIN(cond, bar) do { unsigned _sp = 0; while (cond) { __builtin_amdgcn_s_sleep(1); \
    if ((++_sp & 255u) == 0u) { if (xb_ld(&(bar)[XB_TMO])) break; if (_sp > XB_SPIN_CAP) { atomicAdd(&(bar)[XB_TMO], 1u); break; } } } } while (0)

struct XcdBarrier {
    unsigned* bar; unsigned x;
    volatile LAS unsigned* st;
};

__device__ __forceinline__ XcdBarrier xcd_barrier_post(unsigned* bar, volatile LAS unsigned* st) {
    XcdBarrier b; b.bar = bar; b.x = xb_xcc_id(); b.st = st;
    if (threadIdx.x == 0) (void)xb_add(&bar[XB_XCNT(b.x)], 1u);
    return b;
}
__device__ __forceinline__ void xcd_barrier_complete(unsigned* bar, unsigned x, unsigned& nloc, unsigned& nx) {
    const unsigned G = gridDim.x * gridDim.y * gridDim.z;
    unsigned sum, cnt, mine, sp = 0u;
    for (;;) {
        sum = 0u; cnt = 0u; mine = 0u;
#pragma unroll
        for (unsigned j = 0; j < 16; ++j) { const unsigned c = xb_ld(&bar[XB_XCNT(j)]); sum += c; cnt += (c > 0u) ? 1u : 0u; mine = (j == x) ? c : mine; }
        if (sum == G) break;
        __builtin_amdgcn_s_sleep(1);
        if ((++sp & 255u) == 0u) { if (xb_ld(&bar[XB_TMO])) break; if (sp > XB_SPIN_CAP) { atomicAdd(&bar[XB_TMO], 1u); break; } }
    }
    nloc = mine > 0u ? mine : 1u; nx = cnt > 0u ? cnt : 1u;
}

__device__ __forceinline__ void xcd_barrier(const XcdBarrier& b) {
    asm volatile("s_waitcnt vmcnt(0)" ::: "memory");
    __syncthreads();
    if (threadIdx.x == 0) {
        unsigned* bar = b.bar;
        __builtin_amdgcn_s_waitcnt(0);
        unsigned nloc = b.st[0], nx = b.st[1];
        if (nloc == 0u) { xcd_barrier_complete(bar, b.x, nloc, nx); b.st[0] = nloc; b.st[1] = nx; }
        const unsigned old = xb_add(&bar[XB_XSUB(b.x)], 1u);
        const unsigned gen = old / nloc;
        if (old + 1u == (gen + 1u) * nloc) {
            __builtin_amdgcn_fence(__ATOMIC_RELEASE, "agent");
            asm volatile("s_waitcnt vmcnt(0)" ::: "memory");
            const unsigned og = xb_add(&bar[XB_TOP], 1u);
            const unsigned tg = og / nx;
            if (og + 1u == (tg + 1u) * nx) xb_add(&bar[XB_TOPGEN], 1u);
            else XB_SPIN(xb_ld(&bar[XB_TOPGEN]) == tg, bar);
            __builtin_amdgcn_fence(__ATOMIC_ACQUIRE, "agent");
            xb_add(&bar[XB_XGEN(b.x)], 1u);
            asm volatile("s_waitcnt vmcnt(0)" ::: "memory");
        } else {
            XB_SPIN(xb_ld(&bar[XB_XGEN(b.x)]) == gen, bar);
            __builtin_amdgcn_fence(__ATOMIC_ACQUIRE, "agent");
            asm volatile("s_waitcnt vmcnt(0)" ::: "memory");
        }
    }
    __syncthreads();
}


typedef short mm_bf16x8 __attribute__((ext_vector_type(8)));
constexpr int MXS = 136;

__device__ __forceinline__ void gmlp_mfma(const bf16* proj, const float* vgain, const float* wsp, const float* bs, bf16* mix, unsigned char* lds_) {
    bf16* Wl = (bf16*)lds_;
    bf16* Vt = (bf16*)lds_ + 128 * MXS;
    const int half_ = gridDim.x >> 1;
    if ((int)blockIdx.x < half_) return;
    for (int item = blockIdx.x - half_; item < 256; item += gridDim.x - half_) {
        OPAQUE_TID();
        const int g = item & 3, n = (item >> 2) & 15, b = item >> 6;
        const size_t row0 = (size_t)b * SEQ + n * 128;
        { const float* wg = wsp + (size_t)g * 128 * 128;
#pragma unroll 4
          for (int i = 0; i < 8; ++i) { const int e = (i * 512 + tid) * 4, t = e >> 7, s = e & 127;
              const f32x4 w = *(const f32x4*)(wg + e);
              v2u o; o.x = pk2(s <= t ? w[0] : 0.f, s + 1 <= t ? w[1] : 0.f); o.y = pk2(s + 2 <= t ? w[2] : 0.f, s + 3 <= t ? w[3] : 0.f);
              *(v2u*)(Wl + t * MXS + s) = o; } }
        for (int i = 0; i < 16; ++i) { const int s = wave * 16 + i;
            const unsigned w = *(const unsigned*)(proj + (row0 + s) * NPROJ + 3584 + g * 128 + 2 * lane);
            const float v0 = gelu_tanh(bflo(w)), v1 = gelu_tanh(bfhi(w));
            const float ss = wave_sum(v0 * v0 + v1 * v1); const float rinv = 1.0f / sqrtf(ss * (1.0f / 128.0f) + EPS);
            Vt[(2 * lane) * MXS + s] = (bf16)f2bf(v0 * rinv * vgain[g * 128 + 2 * lane]); Vt[(2 * lane + 1) * MXS + s] = (bf16)f2bf(v1 * rinv * vgain[g * 128 + 2 * lane + 1]); }
        __syncthreads();
        { const int fr = lane & 15, fq = lane >> 4;
          f32x4 acc[8];
#pragma unroll
          for (int cb = 0; cb < 8; ++cb) acc[cb] = (f32x4){0.f, 0.f, 0.f, 0.f};
          const int nkc = (16 * (wave + 1) + 31) >> 5;
          for (int kc = 0; kc < nkc; ++kc) {
              const mm_bf16x8 af = *(const mm_bf16x8*)(Wl + (16 * wave + fr) * MXS + kc * 32 + fq * 8);
#pragma unroll
              for (int cb = 0; cb < 8; ++cb) { const mm_bf16x8 bf = *(const mm_bf16x8*)(Vt + (16 * cb + fr) * MXS + kc * 32 + fq * 8);
                  acc[cb] = __builtin_amdgcn_mfma_f32_16x16x32_bf16(bf, af, acc[cb], 0, 0, 0); } }
          const int t = 16 * wave + fr; const float bt = bs[g * 128 + t];
#pragma unroll
          for (int cb = 0; cb < 8; ++cb) { const int c = 16 * cb + 4 * fq;
              const v2u uw = *(const v2u*)(proj + (row0 + t) * NPROJ + 3072 + g * 128 + c);
              v2u o; o.x = pk2(gelu_tanh(bflo(uw.x)) * (acc[cb][0] + bt), gelu_tanh(bfhi(uw.x)) * (acc[cb][1] + bt));
              o.y = pk2(gelu_tanh(bflo(uw.y)) * (acc[cb][2] + bt), gelu_tanh(bfhi(uw.y)) * (acc[cb][3] + bt));
              *(v2u*)(mix + (row0 + t) * DM + 1024 + g * 128 + c) = o; } }
        __syncthreads();
    }
}

__device__ __forceinline__ void pool_mfma(const bf16* proj, const float* pw, const float* pscale, bf16* mix, unsigned char* lds_) {
    bf16* Wt = (bf16*)lds_;
    bf16* Dl = (bf16*)lds_ + 128 * MXS;
    const int half_ = gridDim.x >> 1;
    if ((int)blockIdx.x < half_) return;
    for (int item = blockIdx.x - half_; item < 256; item += gridDim.x - half_) {
        OPAQUE_TID();
        const int g = item & 3, tb = item >> 2; const size_t row0 = (size_t)tb * 128; const int sbase = (tb * 128) % SEQ;
        const int win = 2 << g;
        { const float* wg = pw + (size_t)g * 128 * 128;
#pragma unroll 4
          for (int i = 0; i < 8; ++i) { const int e = (i * 512 + tid) * 4, c = e >> 7, dd = e & 127;
              const f32x4 w = *(const f32x4*)(wg + e);
              Wt[(dd + 0) * MXS + c] = (bf16)f2bf(w[0]); Wt[(dd + 1) * MXS + c] = (bf16)f2bf(w[1]); Wt[(dd + 2) * MXS + c] = (bf16)f2bf(w[2]); Wt[(dd + 3) * MXS + c] = (bf16)f2bf(w[3]); } }
        { const int r0 = wave * 16; const bf16* xp = proj + 4096 + g * 128 + 2 * lane;
          float x0[31], x1[31];
#pragma unroll
          for (int k = 0; k < 31; ++k) { const int r = r0 - 15 + k; unsigned w = 0u;
              if (sbase + r >= 0) w = *(const unsigned*)(xp + (size_t)((long)row0 + r) * NPROJ);
              x0[k] = bflo(w); x1[k] = bfhi(w); }
#pragma unroll
          for (int i = 0; i < 16; ++i) { const int k = i + 15, s = sbase + r0 + i;
              float s0 = 0.f, s1 = 0.f;
#pragma unroll
              for (int j = 0; j < 16; ++j) { if (j < win) { s0 += x0[k - j]; s1 += x1[k - j]; } }
              const int cnt = (s + 1 < win) ? (s + 1) : win; const float ic = 1.0f / (float)cnt;
              *(unsigned*)(Dl + (r0 + i) * MXS + 2 * lane) = pk2(s0 * ic - x0[k], s1 * ic - x1[k]); } }
        __syncthreads();
        { const int fr = lane & 15, fq = lane >> 4;
          f32x4 acc[8];
#pragma unroll
          for (int db = 0; db < 8; ++db) acc[db] = (f32x4){0.f, 0.f, 0.f, 0.f};
#pragma unroll
          for (int kc = 0; kc < 4; ++kc) {
              const mm_bf16x8 af = *(const mm_bf16x8*)(Dl + (16 * wave + fr) * MXS + kc * 32 + fq * 8);
#pragma unroll
              for (int db = 0; db < 8; ++db) { const mm_bf16x8 bf = *(const mm_bf16x8*)(Wt + (16 * db + fr) * MXS + kc * 32 + fq * 8);
                  acc[db] = __builtin_amdgcn_mfma_f32_16x16x32_bf16(bf, af, acc[db], 0, 0, 0); } }
          const int s = 16 * wave + fr;
#pragma unroll
          for (int db = 0; db < 8; ++db) { const int dd = 16 * db + 4 * fq; const f32x4 sc = *(const f32x4*)(pscale + g * 128 + dd);
              v2u o; o.x = pk2(acc[db][0] * sc[0], acc[db][1] * sc[1]); o.y = pk2(acc[db][2] * sc[2], acc[db][3] * sc[3]);
              *(v2u*)(mix + (row0 + s) * DM + 1536 + g * 128 + dd) = o; } }
        __syncthreads();
    }
}

namespace fa {
constexpr int D = 128;
constexpr float THR = 8.f;
constexpr bool WSKIP = false;
constexpr int KVP = 4608, QP = 4608, OP = 2048;
constexpr float SCALE = 0.08838834764831845f;
constexpr int NW = 8, QBLK = 32, KVBLK = 64, QB = NW * QBLK;
constexpr int SHM_V = KVBLK * D * 2, SHM_K = KVBLK * D * 2;
constexpr int BIAS_OFF = 2 * SHM_V + 2 * SHM_K + NW * 64 * 4;
constexpr int Q_OFF = BIAS_OFF + 2048 * 4;
constexpr int FA_LDS_BYTES = Q_OFF + 8 * 8192;

typedef short bf16x8 __attribute__((ext_vector_type(8)));
typedef short s16x4 __attribute__((ext_vector_type(4)));
typedef float f32x16 __attribute__((ext_vector_type(16)));
typedef float f32x4 __attribute__((ext_vector_type(4)));
typedef unsigned u32x4 __attribute__((ext_vector_type(4)));
template <class A, class Bt> struct same_t { static constexpr bool v = false; };
template <class A> struct same_t<A, A> { static constexpr bool v = true; };

#define KSWZ(row, colB) ((row) * 256 + ((colB) ^ (((row) & 7) << 4)))
#define SBAR() __builtin_amdgcn_sched_barrier(0)
__device__ __forceinline__ int v_st(int k, int c) { const int kk = (k & ~0xC) | ((k & 4) << 1) | ((k & 8) >> 1); return ((kk >> 3) * 4 + (c >> 5)) * 512 + ((kk & 7) * 32 + (c & 31)) * 2; }
__device__ __forceinline__ int v_rd_base(int lane) { return ((lane & 3) << 3) | (((lane >> 2) & 3) << 6) | (((lane >> 4) & 1) << 5) | (((lane >> 5) & 1) << 8); }
constexpr int v_rd_off(int d0, int ks, int half) { return d0 * 512 + ks * 4096 + half * 2048; }
__device__ __forceinline__ int crow(int r, int hi) { return (r & 3) + 8 * (r >> 2) + 4 * hi; }
__device__ __forceinline__ unsigned cvtpk(float lo, float hi) {
    unsigned r; asm volatile("v_cvt_pk_bf16_f32 %0, %1, %2" : "=v"(r) : "v"(lo), "v"(hi)); return r;
}
__device__ __forceinline__ bf16x8 pack8(f32x4 a, f32x4 b) {
    u32x4 w = {cvtpk(a[0], a[1]), cvtpk(a[2], a[3]), cvtpk(b[0], b[1]), cvtpk(b[2], b[3])};
    return *reinterpret_cast<bf16x8*>(&w);
}
template <class T> __device__ __forceinline__ bf16x8 load8(const T* p) {
    if constexpr (same_t<T, float>::v) { return pack8(*(const f32x4*)p, *(const f32x4*)(p + 4)); }
    else { return *reinterpret_cast<const bf16x8*>(p); }
}
__device__ __forceinline__ void mask_tile(f32x16& p0, f32x16& p1, int dq, unsigned W) {
    const float NEG = -__builtin_inff();
#pragma unroll
    for (int r = 0; r < 16; ++r) {
        const int c = (r & 3) + 8 * (r >> 2);
        if ((unsigned)(dq - c) >= W) p0[r] = NEG;
        if ((unsigned)(dq - c - 32) >= W) p1[r] = NEG;
    }
}
__device__ __forceinline__ void partialSM(f32x16& p0, f32x16& p1, float& m_reg, float& mn, float& alpha) {
    float pmax = p0[0]; for (int r = 1; r < 16; ++r) pmax = fmaxf(pmax, p0[r]); for (int r = 0; r < 16; ++r) pmax = fmaxf(pmax, p1[r]);
    { auto rr = __builtin_amdgcn_permlane32_swap(__float_as_uint(pmax), __float_as_uint(pmax), false, false);
      pmax = fmaxf(__uint_as_float(rr[0]), __uint_as_float(rr[1])); }
    constexpr float C2 = 1.4426950408889634f * SCALE;
    if (__builtin_expect(__all((pmax - m_reg) * SCALE <= THR), 1)) { mn = m_reg; alpha = 1.f; }
    else { mn = fmaxf(m_reg, pmax); alpha = __builtin_amdgcn_exp2f((m_reg - mn) * C2); m_reg = mn; }
    const float mnL = -mn * C2;
    for (int r = 0; r < 16; ++r) p0[r] = fmaf(p0[r], C2, mnL); for (int r = 0; r < 16; ++r) p1[r] = fmaf(p1[r], C2, mnL);
    for (int r = 0; r < 16; ++r) p0[r] = __builtin_amdgcn_exp2f(p0[r]);
}
__device__ __forceinline__ void finishSM(f32x16& p0, f32x16& p1, float alpha, float& l_reg, bf16x8& pa0, bf16x8& pa1, bf16x8& pa2, bf16x8& pa3) {
    for (int r = 0; r < 16; ++r) p1[r] = __builtin_amdgcn_exp2f(p1[r]);
    float ps = 0; for (int r = 0; r < 16; ++r) ps += p0[r]; for (int r = 0; r < 16; ++r) ps += p1[r];
    { auto rr = __builtin_amdgcn_permlane32_swap(__float_as_uint(ps), __float_as_uint(ps), false, false);
      ps = __uint_as_float(rr[0]) + __uint_as_float(rr[1]); }
    l_reg = l_reg * alpha + ps;
#define PK4(P, B_, OUT) do { unsigned a0 = cvtpk(P[B_+0], P[B_+1]), a1 = cvtpk(P[B_+2], P[B_+3]);                          \
        unsigned b0 = cvtpk(P[B_+4], P[B_+5]), b1 = cvtpk(P[B_+6], P[B_+7]);                                             \
        auto r0 = __builtin_amdgcn_permlane32_swap(a0, b0, false, false); auto r1 = __builtin_amdgcn_permlane32_swap(a1, b1, false, false); \
        u32x4 w = {r0[0], r1[0], r0[1], r1[1]}; OUT = *reinterpret_cast<bf16x8*>(&w); } while (0)
    PK4(p0, 0, pa0); PK4(p0, 8, pa1); PK4(p1, 0, pa2); PK4(p1, 8, pa3);
#undef PK4
}
template <int KB, bool SK>
__device__ __forceinline__ void qkt(f32x16& p0, f32x16& p1, const char* K_lds, int r32, int hi, const char* Qw, bool act, const float* bt) {
    if (SK && !act) { const float NEG = -__builtin_inff();
#pragma unroll
        for (int r = 0; r < 16; ++r) { p0[r] = NEG; p1[r] = NEG; } return; }
#pragma unroll
    for (int g_ = 0; g_ < 4; ++g_) { const f32x4 b0_ = *(const f32x4*)(bt + 8 * g_), b1_ = *(const f32x4*)(bt + 32 + 8 * g_);
#pragma unroll
        for (int j_ = 0; j_ < 4; ++j_) { p0[4 * g_ + j_] = b0_[j_]; p1[4 * g_ + j_] = b1_[j_]; } }
    const char* kb[4];
#pragma unroll
    for (int dd = 0; dd < 4; ++dd) kb[dd] = K_lds + KB * SHM_K + KSWZ(r32, (dd * 16 + hi * 8) * 2);
#pragma unroll
    for (int d0 = 0; d0 < 8; ++d0) { const char* a = kb[d0 & 3] + (d0 >> 2) * 128;
        bf16x8 b0 = *reinterpret_cast<const bf16x8*>(a);
        bf16x8 b1 = *reinterpret_cast<const bf16x8*>(a + 32 * 256);
        const bf16x8 q_ = *reinterpret_cast<const bf16x8*>(Qw + KSWZ(r32, ((d0 & 3) * 16 + hi * 8) * 2) + (d0 >> 2) * 128);
        p0 = __builtin_amdgcn_mfma_f32_32x32x16_bf16(b0, q_, p0, 0, 0, 0);
        p1 = __builtin_amdgcn_mfma_f32_32x32x16_bf16(b1, q_, p1, 0, 0, 0); }
}
template <int VB, bool SK>
__device__ __forceinline__ void pv_tile(f32x16* o, int vb0, bf16x8 pa0, bf16x8 pa1, bf16x8 pa2, bf16x8 pa3, bool act) {
    if (SK && !act) return;
#define TRRD(dst, off) asm volatile("ds_read_b64_tr_b16 %0, %1 offset:%2" : "=&v"(dst) : "v"(vb0), "i"(off) : "memory")
#define PV_D0(d0) do { s16x4 l0, l1, l2, l3, h0, h1, h2, h3; constexpr int b_ = VB * SHM_V + v_rd_off(d0, 0, 0);     \
        TRRD(l0, b_); TRRD(h0, b_ + 2048); TRRD(l1, b_ + 4096); TRRD(h1, b_ + 6144); TRRD(l2, b_ + 8192); TRRD(h2, b_ + 10240); TRRD(l3, b_ + 12288); TRRD(h3, b_ + 14336); \
        asm volatile("s_waitcnt lgkmcnt(0)" ::: "memory"); SBAR();                 \
        o[d0] = __builtin_amdgcn_mfma_f32_32x32x16_bf16(pa0, (bf16x8){l0[0], l0[1], l0[2], l0[3], h0[0], h0[1], h0[2], h0[3]}, o[d0], 0, 0, 0);   \
        o[d0] = __builtin_amdgcn_mfma_f32_32x32x16_bf16(pa1, (bf16x8){l1[0], l1[1], l1[2], l1[3], h1[0], h1[1], h1[2], h1[3]}, o[d0], 0, 0, 0);   \
        o[d0] = __builtin_amdgcn_mfma_f32_32x32x16_bf16(pa2, (bf16x8){l2[0], l2[1], l2[2], l2[3], h2[0], h2[1], h2[2], h2[3]}, o[d0], 0, 0, 0);   \
        o[d0] = __builtin_amdgcn_mfma_f32_32x32x16_bf16(pa3, (bf16x8){l3[0], l3[1], l3[2], l3[3], h3[0], h3[1], h3[2], h3[3]}, o[d0], 0, 0, 0); } while (0)
    PV_D0(0); PV_D0(1); PV_D0(2); PV_D0(3);
#undef PV_D0
#undef TRRD
}

template <class TIn, class TOut> struct BlockRef { const TIn* Q; const TIn* K; const TIn* V; TOut* O; int P0; };
template <class TIn> struct Seam {
    bf16x8 st_v0, st_v1, st_k0, st_k1; f32x4 sf0, sf1, sf2, sf3;
    f32x4 tq[16];
};
__device__ __forceinline__ int swa_jlo(int P0, int W) { const int lowk = P0 - W + 1; return lowk > 0 ? lowk / KVBLK : 0; }
#define ROW(p, k0, rr) ((p) + (size_t)((k0) + (rr)) * KVP + sc)
#define VMW() asm volatile("s_waitcnt vmcnt(0)" ::: "memory")
#define VMWN(n) asm volatile("s_waitcnt vmcnt(%0)" :: "i"(n) : "memory")
#define SLOAD_H(Kp, Vp, k0) do { S.st_v0 = load8<TIn>(ROW(Vp, k0, sr)); S.st_v1 = load8<TIn>(ROW(Vp, k0, 32 + sr));              \
                         S.st_k0 = load8<TIn>(ROW(Kp, k0, sr)); S.st_k1 = load8<TIn>(ROW(Kp, k0, 32 + sr)); } while (0)
#define SWRITE_HK(bf) do { *(bf16x8*)(K_lds + (bf) * SHM_K + kws) = S.st_k0; *(bf16x8*)(K_lds + (bf) * SHM_K + kws + 32 * 256) = S.st_k1; } while (0)
#define SWRITE_HV(bf) do { *(bf16x8*)(V_lds + (bf) * SHM_V + vst0) = S.st_v0; *(bf16x8*)(V_lds + (bf) * SHM_V + vst1) = S.st_v1; } while (0)
#define SWRITE_H(bf) do { SWRITE_HV(bf); SWRITE_HK(bf); } while (0)
#define SLOAD_F(p, k0) do { S.sf0 = *(const f32x4*)ROW(p, k0, sr); S.sf1 = *(const f32x4*)(ROW(p, k0, sr) + 4);                \
                            S.sf2 = *(const f32x4*)ROW(p, k0, 32 + sr); S.sf3 = *(const f32x4*)(ROW(p, k0, 32 + sr) + 4); } while (0)
#define SWRITE_KF(bf) do { *(bf16x8*)(K_lds + (bf) * SHM_K + kws) = pack8(S.sf0, S.sf1); *(bf16x8*)(K_lds + (bf) * SHM_K + kws + 32 * 256) = pack8(S.sf2, S.sf3); } while (0)
#define SWRITE_VF(bf) do { *(bf16x8*)(V_lds + (bf) * SHM_V + vst0) = pack8(S.sf0, S.sf1); *(bf16x8*)(V_lds + (bf) * SHM_V + vst1) = pack8(S.sf2, S.sf3); } while (0)
template <class TIn, class TOut>
__device__ __forceinline__ void causal_swa_prime(const BlockRef<TIn, TOut>& cur, int W, char* lds, Seam<TIn>& S, int tid_in) {
    constexpr bool F32 = same_t<TIn, float>::v;
    const int tid = tid_in, wid = __builtin_amdgcn_readfirstlane(tid >> 6), lane = tid & 63, r32 = lane & 31, hi = lane >> 5;
    const int sr = tid >> 4, sc = (tid & 15) * 8, kws = KSWZ(sr, sc * 2); char* K_lds = lds + 2 * SHM_V;
    const int kb0 = swa_jlo(cur.P0, W) * KVBLK;
    { char* Qw_ = lds + Q_OFF + wid * 8192;
#pragma unroll
      for (int d0 = 0; d0 < 8; ++d0) *(bf16x8*)(Qw_ + KSWZ(r32, ((d0 & 3) * 16 + hi * 8) * 2) + (d0 >> 2) * 128) = load8<TIn>(cur.Q + (size_t)(wid * QBLK + r32) * QP + d0 * 16 + hi * 8); }
    if constexpr (F32) { SLOAD_F((const float*)cur.K, kb0); VMW(); SWRITE_KF(0); SBAR(); SLOAD_F((const float*)cur.V, kb0); }
    else { SLOAD_H(cur.K, cur.V, kb0); VMW(); SWRITE_HK(0); }
    __syncthreads();
}
template <class TIn, class TOut>
__device__ __forceinline__ void causal_swa_block(const BlockRef<TIn, TOut>& cur, const BlockRef<TIn, TOut>& nxt, int skv, int W, char* lds, Seam<TIn>& S, int tid_in) {
    constexpr bool F32 = same_t<TIn, float>::v;
    const int tid = tid_in, wid = __builtin_amdgcn_readfirstlane(tid >> 6), lane = tid & 63, r32 = lane & 31, hi = lane >> 5;
    const int j_lo = swa_jlo(cur.P0, W);
    int j_hi = (cur.P0 + QB - 1) / KVBLK + 1; if (j_hi > skv / KVBLK) j_hi = skv / KVBLK;
    const int NT = j_hi - j_lo;
    const int kbn = swa_jlo(nxt.P0, W) * KVBLK;
    const int qlo = cur.P0 + wid * QBLK, qm = qlo + r32 - 4 * hi;
    char* V_lds = lds; char* K_lds = lds + 2 * SHM_V;
    float* ws = (float*)(lds + 2 * SHM_V + 2 * SHM_K) + wid * 64; float* li_l = ws, * al_l = ws + 32;
    const float* bias_l = (const float*)(lds + BIAS_OFF) + 4 * hi;
    const char* Qw_lds = lds + Q_OFF + wid * 8192;
    float m_reg = -1e30f, l_reg = 0; f32x16 o[4] = {};
    const int sr = tid >> 4, sc = (tid & 15) * 8, vst0 = v_st(sr, sc), vst1 = v_st(32 + sr, sc), kws = KSWZ(sr, sc * 2);
    const int vb0 = (int)(uintptr_t)V_lds + v_rd_base(lane);
    const TIn* Kh = cur.K; const TIn* Vh = cur.V;
#define RESC(a) do { if (__any((a) < 1.f)) { if (hi == 0) al_l[r32] = (a); asm volatile("s_waitcnt lgkmcnt(0)" ::: "memory");              \
                     for (int d_ = 0; d_ < 4; ++d_) for (int r = 0; r < 16; ++r) o[d_][r] *= al_l[crow(r, hi)]; } } while (0)
#define KBASE(t) ((j_lo + (t)) * KVBLK)
#define ACT(t) (KBASE(t) <= qlo + QBLK - 1 && KBASE(t) + KVBLK - 1 >= qlo - W + 1)
#define MASKT(P0_, P1_, t) do { const int kb_ = KBASE(t); if ((!SK || ACT(t)) && (kb_ + KVBLK - 1 > qlo || kb_ <= qlo + QBLK - 1 - W)) mask_tile(P0_, P1_, qm - kb_, (unsigned)W); } while (0)
    constexpr int NQL = F32 ? 16 : 0;
    constexpr bool SK = WSKIP && !F32;
#define SEAM_K0() do { VMWN(NQL); if constexpr (F32) { SWRITE_KF(0); SBAR(); SLOAD_F((const float*)nxt.V, kbn); } else { SWRITE_HK(0); } SBAR(); } while (0)
    f32x16 pA0, pA1, pB0, pB1; float mnA, mnB, alA, alB; bf16x8 pa0, pa1, pa2, pa3;
    if constexpr (F32) { VMW(); SWRITE_VF(0); SBAR(); } else { SWRITE_HV(0); SBAR(); }
    if (NT > 1) { if constexpr (F32) SLOAD_F((const float*)Kh, KBASE(1)); else SLOAD_H(Kh, Vh, KBASE(1)); }
    SBAR(); qkt<0, SK>(pA0, pA1, K_lds, r32, hi, Qw_lds, ACT(0), bias_l + KBASE(0));
    if constexpr (F32) { if (NT > 1) { VMW(); SWRITE_KF(1); SBAR(); SLOAD_F((const float*)Vh, KBASE(1)); } }
    MASKT(pA0, pA1, 0); partialSM(pA0, pA1, m_reg, mnA, alA);
    if (NT > 1) { VMW(); if constexpr (F32) { SWRITE_VF(1); SBAR(); if (NT > 2) SLOAD_F((const float*)Kh, KBASE(2)); } else SWRITE_H(1); }
    __syncthreads();
#define HALF_STEP(PX0, PX1, mnX, alX, PY0, PY1, alY, t, KB, VB, SB) do {                                                      \
        SBAR(); qkt<KB, SK>(PX0, PX1, K_lds, r32, hi, Qw_lds, ACT(t), bias_l + KBASE(t));                                             \
        finishSM(PY0, PY1, alY, l_reg, pa0, pa1, pa2, pa3); SBAR();                                                           \
        if ((t) + 1 < NT) { if constexpr (F32) { VMW(); SWRITE_KF(SB); SBAR(); SLOAD_F((const float*)Vh, KBASE((t) + 1)); }  \
                            else { SLOAD_H(Kh, Vh, KBASE((t) + 1)); } SBAR(); }                                               \
        pv_tile<VB, SK>(o, vb0, pa0, pa1, pa2, pa3, ACT((t) - 1)); MASKT(PX0, PX1, (t)); partialSM(PX0, PX1, m_reg, mnX, alX);                                        \
        __syncthreads();                                                                                                      \
        if ((t) + 1 < NT) { VMW(); if constexpr (F32) { SWRITE_VF(SB); SBAR(); if ((t) + 2 < NT) SLOAD_F((const float*)Kh, KBASE((t) + 2)); } \
                            else { SWRITE_H(SB); } }                                                                          \
        RESC(alX); __syncthreads(); } while (0)
    for (int t = 1; t + 1 < NT; t += 2) {
        HALF_STEP(pB0, pB1, mnB, alB, pA0, pA1, alA, t, 1, 0, 0);
        HALF_STEP(pA0, pA1, mnA, alA, pB0, pB1, alB, t + 1, 0, 1, 1);
    }
    const bool even = (NT & 1) == 0;
    if (even) { SBAR(); qkt<1, SK>(pB0, pB1, K_lds, r32, hi, Qw_lds, ACT(NT - 1), bias_l + KBASE(NT - 1)); SBAR(); }
#define QROW(e) (nxt.Q + (size_t)(wid * QBLK + r32) * QP + ((e) >> 1) * 16 + hi * 8 + ((e) & 1) * 4)
    if constexpr (F32) { SLOAD_F((const float*)nxt.K, kbn); SBAR();
#pragma unroll
        for (int e = 0; e < 8; ++e) S.tq[e] = *(const f32x4*)QROW(e); }
    else { SLOAD_H(nxt.K, nxt.V, kbn); SBAR(); }
    SBAR();
    finishSM(pA0, pA1, alA, l_reg, pa0, pa1, pa2, pa3); SBAR();
    if constexpr (F32) {
#pragma unroll
        for (int e = 8; e < 16; ++e) S.tq[e] = *(const f32x4*)QROW(e); SBAR(); }
#undef QROW
    pv_tile<0, SK>(o, vb0, pa0, pa1, pa2, pa3, ACT(even ? NT - 2 : NT - 1));
    if (even) { MASKT(pB0, pB1, NT - 1); partialSM(pB0, pB1, m_reg, mnB, alB); __syncthreads(); RESC(alB);
        finishSM(pB0, pB1, alB, l_reg, pa0, pa1, pa2, pa3); SBAR(); pv_tile<1, SK>(o, vb0, pa0, pa1, pa2, pa3, ACT(NT - 1)); }
    SBAR(); SEAM_K0();
    if (hi == 0) li_l[r32] = l_reg; asm volatile("s_waitcnt lgkmcnt(0)" ::: "memory");
    float rli[16];
#pragma unroll
    for (int r = 0; r < 16; ++r) rli[r] = __builtin_amdgcn_rcpf(li_l[crow(r, hi)]);
    TOut* Ow = cur.O + (size_t)(wid * QBLK) * OP;
#pragma unroll
    for (int r = 0; r < 16; ++r) { const int orow = crow(r, hi);
#pragma unroll
        for (int d0 = 0; d0 < 4; ++d0) { const float v = o[d0][r] * rli[r];
            if constexpr (same_t<TOut, float>::v) { Ow[(size_t)orow * OP + d0 * 32 + r32] = v; }
            else { const float vn = __shfl_xor(v, 1);
                   if ((r32 & 1) == 0) *(unsigned*)(Ow + (size_t)orow * OP + d0 * 32 + r32) = cvtpk(v, vn); } } }
    if constexpr (F32) {
#pragma unroll
        for (int d0 = 0; d0 < 8; ++d0) (void)S.tq[2 * d0]; }
    __syncthreads();
#undef RESC
#undef KBASE
#undef ACT
#undef MASKT
#undef SEAM_K0
#undef HALF_STEP
}
#undef ROW
#undef VMW
#undef VMWN
#undef SLOAD_H
#undef SWRITE_HK
#undef SWRITE_HV
#undef SWRITE_H
#undef SLOAD_F
#undef SWRITE_KF
#undef SWRITE_VF

#undef KSWZ
#undef SBAR
}

__device__ __forceinline__ void attn_phase(const bf16* proj, const float* logf, bf16* mix, unsigned char* lds_) {
    char* lds = (char*)lds_;
    for (int item = blockIdx.x; item < 256; item += gridDim.x) {
        OPAQUE_TID();
        const int bh = (item & 7) * 4 + ((item >> 3) & 3), qb = 7 - (item >> 5);
        const int b = bh >> 3, hh = bh & 7;
        float* bias = (float*)(lds + fa::BIAS_OFF);
        const int nk = (qb + 1) * 256;
        { float* scanw = (float*)(lds + 2 * fa::SHM_V + 2 * fa::SHM_K);
          const int s0 = 4 * tid; float l0 = 0.f, l1 = 0.f, l2 = 0.f, l3 = 0.f;
          if (s0 < nk) { const float* lf = logf + ((size_t)(b * SEQ + s0)) * 8 + hh; l0 = lf[0]; l1 = lf[8]; l2 = lf[16]; l3 = lf[24]; }
          l1 += l0; l2 += l1; l3 += l2;
          float inc = l3;
#pragma unroll
          for (int o = 1; o < 64; o <<= 1) { const float t = __shfl_up(inc, o); if (lane >= o) inc += t; }
          if (lane == 63) scanw[wave] = inc;
          __syncthreads();
          float off = inc - l3;
#pragma unroll
          for (int w = 0; w < 8; ++w) off += (w < wave) ? scanw[w] : 0.f;
          const float k = -1.0f / fa::SCALE;
          if (s0 < nk) { bias[s0] = (off + l0) * k; bias[s0 + 1] = (off + l1) * k; bias[s0 + 2] = (off + l2) * k; bias[s0 + 3] = (off + l3) * k; } }
        fa::BlockRef<bf16, bf16> cur;
        cur.Q = proj + (size_t)(b * SEQ + qb * 256) * NPROJ + hh * 128; cur.K = proj + (size_t)(b * SEQ) * NPROJ + 1024 + hh * 128; cur.V = cur.K + 1024;
        cur.O = mix + (size_t)(b * SEQ + qb * 256) * DM + hh * 128; cur.P0 = qb * 256;
        fa::Seam<bf16> S;
        fa::causal_swa_prime<bf16, bf16>(cur, SEQ, lds, S, tid);
        fa::causal_swa_block<bf16, bf16>(cur, cur, SEQ, SEQ, lds, S, tid);
    }
}

__global__ void __launch_bounds__(512, 2) fwd(Args a) {
    extern __shared__ __attribute__((aligned(16))) unsigned char lds[];
    cg::grid_group grid = cg::this_grid();
#define OPQ_WS() opq_ptr(a.ws)
#define XN ((bf16*)(OPQ_WS() + WS_XN))
#define PROJ ((bf16*)(OPQ_WS() + WS_PROJ))
#define MIX ((bf16*)(OPQ_WS() + WS_MIX))
#define ACT ((bf16*)(OPQ_WS() + WS_ACT))
#define PP ((bf16*)(OPQ_WS() + WS_PP))
#define PBF ((bf16*)(OPQ_WS() + WS_PBF))
#define LOGF ((float*)(OPQ_WS() + WS_LOGF))
#define CUM ((float*)(OPQ_WS() + WS_CUM))
#define H ((float*)opq_ptr((unsigned char*)a.out))
    PG8_LAS unsigned char* ring = (PG8_LAS unsigned char*)lds;
    const int G = gridDim.x, bx = blockIdx.x;
    { volatile LAS unsigned* st0 = (volatile LAS unsigned*)((LAS unsigned char*)lds + XB_LDS_OFF); if (threadIdx.x < 2) st0[threadIdx.x] = 0u; }
    __syncthreads();
    const XcdBarrier xbar = xcd_barrier_post((unsigned*)(a.ws + WS_BAR), (volatile LAS unsigned*)((LAS unsigned char*)lds + XB_LDS_OFF));
#define GRID_SYNC() xcd_barrier(xbar)
    constexpr int CONV_SPLIT = 1940;

    convert_weights(a, (LAS unsigned char*)lds, 0, I_LAYER, bx, G);
    convert_p(a);
    norm_phase(a.in[I_X], a.in[I_NORM_MIX], XN, true, a.in[I_W_IN], a.in[I_FBIAS], LOGF, lds);
    grid.sync();

#pragma unroll 1
    for (int L = 0; L < DEPTH; ++L) {
#define WL(off) ((const bf16*)(OPQ_WS() + WS_W + (size_t)L * SZ_LAYER + (off)))
#define Win WL(OFF_WIN)
#define Wout WL(OFF_WOUT)
#define Wgu WL(OFF_WGU)
#define Wdn WL(OFF_WDN)
#define Wpg WL(OFF_WPG)
#define Wpp WL(OFF_WPP)
        for (int rep_ = 0; rep_ < REP_A; ++rep_) {
        { pg8::Gemm g{XN, Win, M, NPROJ, DM}; pg8::StaticOrder S; S.init(M, NPROJ, G, bx);
          pg8::EpiProjQK E{PROJ, NPROJ, a.in[I_Q_NORM] + L * 128, a.in[I_K_NORM] + L * 128, (PG8_LAS float*)(ring + 131072)};
          pg8::gemm_phase<pg8::EpiProjQK, pg8::StaticOrder, true, true>(ring, g, S, E); }
        { pg8::Gemm g{PBF + (size_t)L * M * DPLE, Wpp, M, DM, DPLE}; pg8::StaticOrder S; S.init(M, DM, G, bx);
          pg8::EpiBf16<0> E{PP, DM, nullptr, 0, 0, 1.f};
          pg8::gemm_phase<pg8::EpiBf16<0>, pg8::StaticOrder, true, true>(ring, g, S, E); }
        }
        if (L + 1 < DEPTH) {
            const int ntile = (M / 256) * (NPROJ / 256), maxu = (ntile + G - 1) / G, rem = ntile - (maxu - 1) * G, first_idle = (rem >= G) ? 0 : rem;
            if (bx >= first_idle) convert_weights(a, (LAS unsigned char*)lds, (L + 1) * I_LAYER, (L + 1) * I_LAYER + CONV_SPLIT, bx - first_idle, G - first_idle);
        }
        GRID_SYNC();
        for (int rep_ = 0; rep_ < REP_C; ++rep_) {
        gmlp_mfma(PROJ, a.in[I_GV_NORM] + L * 512, a.in[I_G_WS] + (size_t)L * 4 * 128 * 128, a.in[I_G_BS] + L * 512, MIX, lds);
        pool_mfma(PROJ, a.in[I_POOL_W] + (size_t)L * 4 * 128 * 128, a.in[I_POOL_SCALE] + L * 512, MIX, lds);
        for (int rep2_ = 0; rep2_ < REP_ATT; ++rep2_) attn_phase(PROJ, LOGF, MIX, lds);
        }
        for (int rep_ = 0; rep_ < REP_SYNC; ++rep_) GRID_SYNC();
        { pg8::Gemm g{MIX, Wout, M, DM, DM}; pg8::StaticOrder S; S.init(M, DM, G, bx);
          pg8::EpiRes E{L == 0 ? a.in[I_X] : H, H, DM};
          pg8::gemm_phase<pg8::EpiRes, pg8::StaticOrder, true, true>(ring, g, S, E); }
        GRID_SYNC();
        for (int rep_ = 0; rep_ < REP_N; ++rep_) norm_phase(H, a.in[I_NORM_FFN] + L * DM, XN, false, nullptr, nullptr, nullptr, lds);
        GRID_SYNC();
        for (int rep_ = 0; rep_ < REP_F; ++rep_) { pg8::Gemm g{XN, Wgu, M, NGU, DM}; pg8::StaticOrder S; S.init(M, NGU, G, bx);
          pg8::EpiSwiglu E{ACT, DFF};
          pg8::gemm_phase<pg8::EpiSwiglu, pg8::StaticOrder, true, true>(ring, g, S, E); }
        if (L + 1 < DEPTH) {
            const int ntile = (M / 256) * (NGU / 256), maxu = (ntile + G - 1) / G, rem = ntile - (maxu - 1) * G, first_idle = (rem >= G) ? 0 : rem;
            if (bx >= first_idle) convert_weights(a, (LAS unsigned char*)lds, (L + 1) * I_LAYER + CONV_SPLIT, (L + 2) * I_LAYER, bx - first_idle, G - first_idle);
        }
        GRID_SYNC();
        { pg8::Gemm g{ACT, Wdn, M, DM, DFF}; pg8::StaticOrder S; S.init(M, DM, G, bx);
          pg8::EpiRes E{H, H, DM};
          pg8::gemm_phase<pg8::EpiRes, pg8::StaticOrder, true, true>(ring, g, S, E); }
        GRID_SYNC();
        for (int rep_ = 0; rep_ < REP_N; ++rep_) norm_phase(H, a.in[I_NORM_PLE] + L * DM, XN, false, nullptr, nullptr, nullptr, lds);
        GRID_SYNC();
        { pg8::Gemm g{XN, Wpg, M, DM, DM}; pg8::StaticOrder S; S.init(M, DM, G, bx);
          pg8::EpiPle E{H, H, PP, DM};
          pg8::gemm_phase<pg8::EpiPle, pg8::StaticOrder, true, true>(ring, g, S, E); }
        if (L + 1 < DEPTH) {
            GRID_SYNC();
            norm_phase(H, a.in[I_NORM_MIX] + (L + 1) * DM, XN, true, a.in[I_W_IN] + (size_t)(L + 1) * DM * DPROJ_SRC, a.in[I_FBIAS] + (L + 1) * 8, LOGF, lds);
            GRID_SYNC();
        }
    }
}

extern "C" void kernel_launch(void* const* d_in, const int* in_sizes, int n_in, void* d_out, int out_size, void* d_ws, size_t ws_size, hipStream_t stream) {
    static int grid = 0;
    if (grid == 0) {
        if (n_in != 20 || out_size != M * DM || ws_size < WS_END) { fprintf(stderr, "kernel_launch: unexpected shapes (n_in %d out %d ws %zu, need %zu)\n", n_in, out_size, ws_size, (size_t)WS_END); grid = -1; return; }
        int dev = 0, cus = 0, per_cu = 0;
        (void)hipGetDevice(&dev); (void)hipDeviceGetAttribute(&cus, hipDeviceAttributeMultiprocessorCount, dev);
        if (hipFuncSetAttribute((const void*)fwd, hipFuncAttributeMaxDynamicSharedMemorySize, LDS_BYTES) != hipSuccess) fprintf(stderr, "kernel_launch: hipFuncSetAttribute failed\n");
        if (hipOccupancyMaxActiveBlocksPerMultiprocessor(&per_cu, (const void*)fwd, 512, LDS_BYTES) != hipSuccess || per_cu < 1) { fprintf(stderr, "kernel_launch: occupancy query gave %d\n", per_cu); per_cu = 1; }
        (void)hipGetLastError();
        if (cus <= 0) cus = 256;
        grid = cus * per_cu;
    }
    if (grid < 0) return;
    Args a{};
    for (int i = 0; i < 20; ++i) a.in[i] = (const float*)d_in[i];
    a.out = (float*)d_out; a.ws = (unsigned char*)d_ws;
    if (hipMemsetAsync((char*)d_ws + WS_BAR, 0, XCD_BAR_WORDS * 4, stream) != hipSuccess) fprintf(stderr, "kernel_launch: memset of barrier words failed\n");
    void* args[] = {&a};
    hipError_t e = hipLaunchCooperativeKernel((void*)fwd, dim3(grid), dim3(512), args, LDS_BYTES, stream);
    if (e != hipSuccess) fprintf(stderr, "cooperative launch failed: %s (grid %d)\n", hipGetErrorString(e), grid);
}
```
